# Optimizing an MI355X kernel written in HIP

```python
import math, functools
import jax, jax.numpy as jnp
from jax import lax
import numpy as np

D_MODEL = 4096
BATCH = 1
SEQ = 8192
DEPTH = 1
DEC_BATCH = 128
DEC_SEQ = 8
PAST_LEN = 8192
PAGE_SIZE = 128

HEAD_DIM = 128
ATTN_DIM = D_MODEL // 2
N_HEADS = ATTN_DIM // HEAD_DIM
N_KV_HEADS = 4
GQA_GROUP = N_HEADS // N_KV_HEADS
KV_DIM = N_KV_HEADS * HEAD_DIM
CONV_DIM = D_MODEL - ATTN_DIM
CONV_GROUPS = CONV_DIM // HEAD_DIM
CONV_WIDTH = 3
WINDOW = 128
BLOCK = 128
N_BUCKETS = 32
MAX_DISTANCE = 128
D_FF = 11008
N_MOD = 9
PROJ_DIM = ATTN_DIM + 2 * KV_DIM + 3 * CONV_DIM
EPS = 1e-6
NEG = -1e30

kernel_name = "hymba_swa_sink_shortconv_macaron_step"


def _rmsnorm(x, g):
    xf = x.astype(jnp.float32)
    y = xf * lax.rsqrt(jnp.mean(xf * xf, axis=-1, keepdims=True) + EPS)
    return (y * g.astype(jnp.float32)).astype(x.dtype)


def _modulate(h, shift, scale):
    return h * (1 + scale) + shift


def _swiglu(h, w1, w3, w2):
    return (jax.nn.silu(h @ w1) * (h @ w3)) @ w2


def _t5_bucket(dist):
    n = jnp.maximum(dist, 0)
    max_exact = N_BUCKETS // 2
    nf = jnp.maximum(n, 1).astype(jnp.float32)
    large = max_exact + (jnp.log(nf / max_exact) / math.log(MAX_DISTANCE / max_exact)
                         * (N_BUCKETS - max_exact)).astype(jnp.int32)
    large = jnp.minimum(large, N_BUCKETS - 1)
    return jnp.where(n < max_exact, n, large)


def _rel_bias(dist, table):
    b = jnp.moveaxis(table[_t5_bucket(dist)].astype(jnp.float32), -1, 0)
    return b.reshape(N_KV_HEADS, GQA_GROUP, *dist.shape)


def _sink_attention(q, k, v, bias, valid, sinks):
    s = jnp.einsum('...qhgd,...khd->...hgqk', q, k).astype(jnp.float32) * (HEAD_DIM ** -0.5) + bias
    s = jnp.where(valid, s, NEG)
    sk = sinks.astype(jnp.float32).reshape(N_KV_HEADS, GQA_GROUP, 1, 1)
    m = jnp.maximum(jnp.max(s, axis=-1, keepdims=True), sk)
    p = jnp.exp(s - m)
    denom = jnp.sum(p, axis=-1, keepdims=True) + jnp.exp(sk - m)
    p = (p / denom).astype(v.dtype)
    return jnp.einsum('...hgqk,...khd->...qhgd', p, v)


def _split(proj):
    cuts = [ATTN_DIM, ATTN_DIM + KV_DIM, ATTN_DIM + 2 * KV_DIM,
            ATTN_DIM + 2 * KV_DIM + CONV_DIM, ATTN_DIM + 2 * KV_DIM + 2 * CONV_DIM]
    return jnp.split(proj, cuts, axis=-1)


def _causal_conv(ucat, conv_w, s_len):
    y = ucat[:, 0:s_len] * conv_w[0]
    for j in range(1, CONV_WIDTH):
        y = y + ucat[:, j:j + s_len] * conv_w[j]
    return y


def _prompt_mixer(proj, sinks, conv_w, rel_bias):
    bp, s_len, _ = proj.shape
    q, k, v, gb, gc, hc = _split(proj)
    nb = s_len // BLOCK
    q = q.reshape(bp, nb, BLOCK, N_KV_HEADS, GQA_GROUP, HEAD_DIM)
    k = k.reshape(bp, s_len, N_KV_HEADS, HEAD_DIM)
    v = v.reshape(bp, s_len, N_KV_HEADS, HEAD_DIM)
    pad = ((0, 0), (1, 0), (0, 0), (0, 0), (0, 0))
    kb = k.reshape(bp, nb, BLOCK, N_KV_HEADS, HEAD_DIM)
    vb = v.reshape(bp, nb, BLOCK, N_KV_HEADS, HEAD_DIM)
    kk = jnp.concatenate([jnp.pad(kb, pad)[:, :-1], kb], axis=2)
    vv = jnp.concatenate([jnp.pad(vb, pad)[:, :-1], vb], axis=2)
    r = jnp.arange(BLOCK)
    cidx = jnp.arange(2 * BLOCK)
    dist = BLOCK + r[:, None] - cidx[None, :]
    kpos = (jnp.arange(nb)[:, None] - 1) * BLOCK + cidx[None, :]
    valid = ((dist >= 0) & (dist <= WINDOW))[None] & (kpos >= 0)[:, None, :]
    valid = valid[:, None, None]
    o = _sink_attention(q, kk, vv, _rel_bias(dist, rel_bias), valid, sinks)
    o = o.reshape(bp, s_len, ATTN_DIM)
    u = gc * hc
    upad = jnp.pad(u, ((0, 0), (CONV_WIDTH - 1, 0), (0, 0)))
    yc = gb * _causal_conv(upad, conv_w, s_len)
    wb = min(WINDOW, s_len)
    state = (k[:, s_len - wb:], v[:, s_len - wb:], u[:, s_len - (CONV_WIDTH - 1):])
    return jnp.concatenate([o, yc], axis=-1), state


def _sample_mixer(proj, ck, cv, cconv, sinks, conv_w, rel_bias):
    bd, s_len, _ = proj.shape
    wb = ck.shape[1]
    q, k, v, gb, gc, hc = _split(proj)
    q = q.reshape(bd, s_len, N_KV_HEADS, GQA_GROUP, HEAD_DIM)
    k = k.reshape(bd, s_len, N_KV_HEADS, HEAD_DIM)
    v = v.reshape(bd, s_len, N_KV_HEADS, HEAD_DIM)
    kk = jnp.concatenate([ck.astype(k.dtype), k], axis=1)
    vv = jnp.concatenate([cv.astype(v.dtype), v], axis=1)
    qpos = PAST_LEN + jnp.arange(s_len)
    kpos = jnp.concatenate([PAST_LEN - wb + jnp.arange(wb), qpos])
    dist = qpos[:, None] - kpos[None, :]
    valid = (dist >= 0) & (dist <= WINDOW) & (kpos >= 0)[None, :]
    o = _sink_attention(q, kk, vv, _rel_bias(dist, rel_bias), valid, sinks)
    o = o.reshape(bd, s_len, ATTN_DIM)
    u = gc * hc
    ucat = jnp.concatenate([cconv.astype(u.dtype), u], axis=1)
    yc = gb * _causal_conv(ucat, conv_w, s_len)
    state = (kk[:, -wb:], vv[:, -wb:], ucat[:, -(CONV_WIDTH - 1):])
    return jnp.concatenate([o, yc], axis=-1), state


def _layer(x, c, mix_fn, g1, w1a, w3a, w2a, g_mix, w_in, w_out, g2, w1b, w3b, w2b, w_ada, b_ada):
    mod = (jax.nn.silu(c) @ w_ada + b_ada).reshape(c.shape[0], N_MOD, D_MODEL)[:, :, None, :]
    h = _modulate(_rmsnorm(x, g1), mod[:, 0], mod[:, 1])
    x = x + 0.5 * mod[:, 2] * _swiglu(h, w1a, w3a, w2a)
    h = _modulate(_rmsnorm(x, g_mix), mod[:, 3], mod[:, 4])
    mixed, state = mix_fn(h @ w_in)
    x = x + mod[:, 5] * (mixed @ w_out)
    h = _modulate(_rmsnorm(x, g2), mod[:, 6], mod[:, 7])
    x = x + 0.5 * mod[:, 8] * _swiglu(h, w1b, w3b, w2b)
    return x, state


def setup_inputs(seed: int = 0) -> dict:
    key = jax.random.key(seed)
    ks = jax.random.split(key, 32)
    f32 = jnp.float32
    wb = min(WINDOW, PAST_LEN)
    nrm = lambda k, shape, s: jax.random.normal(k, shape, f32) * s
    gain = lambda k: 1.0 + 0.05 * jax.random.normal(k, (DEPTH, D_MODEL), f32)
    sd, sf = D_MODEL ** -0.5, D_FF ** -0.5
    return {
        "x_prompt": nrm(ks[0], (BATCH, SEQ, D_MODEL), 1.0),
        "x_sample": nrm(ks[1], (DEC_BATCH, DEC_SEQ, D_MODEL), 1.0),
        "c_prompt": nrm(ks[2], (BATCH, D_MODEL), 1.0),
        "c_sample": nrm(ks[3], (DEC_BATCH, D_MODEL), 1.0),
        "cache_k": nrm(ks[4], (DEPTH, DEC_BATCH, wb, N_KV_HEADS, HEAD_DIM), 1.0),
        "cache_v": nrm(ks[5], (DEPTH, DEC_BATCH, wb, N_KV_HEADS, HEAD_DIM), 1.0),
        "state_conv": nrm(ks[6], (DEPTH, DEC_BATCH, CONV_WIDTH - 1, CONV_DIM), 1.0),
        "rel_bias": nrm(ks[7], (N_BUCKETS, N_HEADS), 0.5),
        "g_ffn1": gain(ks[8]),
        "w1_ffn1": nrm(ks[9], (DEPTH, D_MODEL, D_FF), sd),
        "w3_ffn1": nrm(ks[10], (DEPTH, D_MODEL, D_FF), sd),
        "w2_ffn1": nrm(ks[11], (DEPTH, D_FF, D_MODEL), sf),
        "g_mix": gain(ks[12]),
        "w_in": nrm(ks[13], (DEPTH, D_MODEL, PROJ_DIM), sd),
        "sinks": nrm(ks[14], (DEPTH, N_HEADS), 1.0),
        "conv_w": nrm(ks[15], (DEPTH, CONV_WIDTH, CONV_DIM), CONV_WIDTH ** -0.5),
        "w_out": nrm(ks[16], (DEPTH, D_MODEL, D_MODEL), sd),
        "g_ffn2": gain(ks[17]),
        "w1_ffn2": nrm(ks[18], (DEPTH, D_MODEL, D_FF), sd),
        "w3_ffn2": nrm(ks[19], (DEPTH, D_MODEL, D_FF), sd),
        "w2_ffn2": nrm(ks[20], (DEPTH, D_FF, D_MODEL), sf),
        "w_ada": nrm(ks[21], (DEPTH, D_MODEL, N_MOD * D_MODEL), 0.5 * sd),
        "b_ada": nrm(ks[22], (DEPTH, N_MOD * D_MODEL), 0.02),
        "g_final": 1.0 + 0.05 * jax.random.normal(ks[23], (D_MODEL,), f32),
    }


def reference(x_prompt, x_sample, c_prompt, c_sample, cache_k, cache_v, state_conv, rel_bias,
              g_ffn1, w1_ffn1, w3_ffn1, w2_ffn1, g_mix, w_in, sinks, conv_w, w_out,
              g_ffn2, w1_ffn2, w3_ffn2, w2_ffn2, w_ada, b_ada, g_final):
    xp, xs = x_prompt, x_sample
    kp, vp, cp, ksn, vsn, csn = [], [], [], [], [], []
    for l in range(DEPTH):
        w = (g_ffn1[l], w1_ffn1[l], w3_ffn1[l], w2_ffn1[l], g_mix[l], w_in[l], w_out[l],
             g_ffn2[l], w1_ffn2[l], w3_ffn2[l], w2_ffn2[l], w_ada[l], b_ada[l])
        pmix = functools.partial(_prompt_mixer, sinks=sinks[l], conv_w=conv_w[l], rel_bias=rel_bias)
        smix = functools.partial(_sample_mixer, ck=cache_k[l], cv=cache_v[l], cconv=state_conv[l],
                                 sinks=sinks[l], conv_w=conv_w[l], rel_bias=rel_bias)
        xp, sp = _layer(xp, c_prompt, pmix, *w)
        xs, ss = _layer(xs, c_sample, smix, *w)
        kp.append(sp[0]); vp.append(sp[1]); cp.append(sp[2])
        ksn.append(ss[0]); vsn.append(ss[1]); csn.append(ss[2])
    y_prompt = _rmsnorm(xp, g_final)
    y_sample = _rmsnorm(xs, g_final)
    k_win_prompt, v_win_prompt, conv_prompt = jnp.stack(kp), jnp.stack(vp), jnp.stack(cp)
    k_win_sample, v_win_sample, conv_sample = jnp.stack(ksn), jnp.stack(vsn), jnp.stack(csn)
    return (y_prompt, y_sample, k_win_prompt, v_win_prompt, conv_prompt, k_win_sample, v_win_sample, conv_sample)
```

```cpp
#include <hip/hip_runtime.h>
#include <cstdio>
#include <cstdint>
#ifndef PG8_LOADPRIO
#define PG8_LOADPRIO 0
#endif
namespace pg8 {
#define PG8_LAS __attribute__((address_space(3)))
typedef unsigned short bf16_t;
typedef short bf16x8 __attribute__((ext_vector_type(8)));
typedef float f32x4 __attribute__((ext_vector_type(4)));
typedef unsigned u32x4 __attribute__((ext_vector_type(4)));
typedef unsigned u32x2 __attribute__((ext_vector_type(2)));
typedef int i32x4 __attribute__((ext_vector_type(4)));
typedef int i32x8 __attribute__((ext_vector_type(8)));
__device__ __forceinline__ i32x8 cat8(bf16x8 lo, bf16x8 hi) { return __builtin_shufflevector(__builtin_bit_cast(i32x4, lo), __builtin_bit_cast(i32x4, hi), 0, 1, 2, 3, 4, 5, 6, 7); }
__device__ __forceinline__ unsigned cvt4_fp8(float a, float b, float c, float d) {
    a = __builtin_fminf(__builtin_fmaxf(a, -448.f), 448.f); b = __builtin_fminf(__builtin_fmaxf(b, -448.f), 448.f);
    c = __builtin_fminf(__builtin_fmaxf(c, -448.f), 448.f); d = __builtin_fminf(__builtin_fmaxf(d, -448.f), 448.f);
    int w = 0; w = __builtin_amdgcn_cvt_pk_fp8_f32(a, b, w, false); w = __builtin_amdgcn_cvt_pk_fp8_f32(c, d, w, true); return (unsigned)w; }
constexpr int BM = 256, BK = 64, HALF = 128, HTB = HALF * BK * 2  , STAGE_BYTES = 8 * HTB, NXCD = 8, WGM = 8;

__host__ __device__ __forceinline__ int lds_byte(int r, int c) { const int st = (r >> 4) * 2 + (c >> 5), rr = r & 15, cc = c & 31, ob = rr * 64 + cc * 2; return st * 1024 + (ob ^ (((ob >> 9) & 1) << 5)); }
__host__ __device__ __forceinline__ void stage_rc(int b, int& R, int& C) { const int st = b / 1024, sb = b % 1024, swz = sb ^ (((sb >> 9) & 1) << 5); R = (st >> 1) * 16 + swz / 64; C = (st & 1) * 32 + (swz % 64) / 2; }
__host__ __device__ __forceinline__ int perm32(int rho) { const int n = rho >> 4, i = rho & 15; return 8 * (i >> 2) + 4 * n + (i & 3); }

struct Unit { int pm, pn, kb, ke, kind, slot; };
struct Gemm { const bf16_t* A; const bf16_t* Bt; int M, N, K; };

struct StaticOrder {
    static constexpr bool SK = false;
    int nM, nN, nwg, G, c, base, lim;
    __host__ __device__ void init(int M, int N, int G_, int c_) { nM = M / BM; nN = N / BM; nwg = nM * nN; G = G_; c = c_; base = 0; lim = nwg; }
    __host__ __device__ void sub(int b, int l) { base = b; lim = l < nwg ? l : nwg; }
    __host__ __device__ bool next(int i, Unit& u) const {
        const long L = (long)base + (long)i * G + c; if (L >= lim) return false;
        int wgid = (int)L; { const int q = nwg / NXCD, r = nwg % NXCD, xcd = wgid % NXCD, off = wgid / NXCD; wgid = (xcd < r ? xcd * (q + 1) : r * (q + 1) + (xcd - r) * q) + off; }
        const int nig = WGM * nN, gid = wgid / nig, fm = gid * WGM, gsz = (nM - fm) < WGM ? (nM - fm) : WGM;
        u.pm = fm + ((wgid % nig) % gsz); u.pn = (wgid % nig) / gsz; return true;
    }
    __device__ __forceinline__ void a_ready(const Unit&) const {}
    __device__ __forceinline__ void done(const Unit&) const {}
};

struct DegenOrder {
    static constexpr bool SK = false;
    int nwg, G, c;
    __device__ __forceinline__ void init(int M, int N, int G_, int c_) { nwg = (M / BM) * (N / BM); G = G_; c = c_; }
    __device__ __forceinline__ bool next(int i, Unit& u) const { if ((long)i * G + c >= nwg) return false; u.pm = 0; u.pn = 0; return true; }
    __device__ __forceinline__ void a_ready(const Unit&) const {}
    __device__ __forceinline__ void done(const Unit&) const {}
};
struct SkOrder {
    int nM, nN, nwg, G, c, Rs, cnt8, qq, nt, np, q, ufirst, ulast, nsk; long s, e;
    __device__ __forceinline__ void init(int M, int N, int Kbf, int G_, int c_) {
        nM = M / BM; nN = N / BM; nwg = nM * nN; G = G_; c = c_; nt = Kbf / BK; np = nt / 2;
        if (G != 256 || (nwg % 8) != 0 || nwg < 2 * G) { Rs = (nwg + G - 1) / G; nsk = 0; qq = nwg / 8; cnt8 = 0; q = 0; s = e = 0; ufirst = ulast = 0; return; }
        Rs = nwg / G - 1; const int usk = nwg - Rs * G; cnt8 = usk / 8; qq = nwg / 8; q = (c % 8) * 32 + c / 8;
        const long P = (long)usk * np; s = (long)q * P / G; e = (long)(q + 1) * P / G;
        ufirst = (int)(s / np); ulast = (int)((e - 1) / np); nsk = ulast - ufirst + 1;
    }
    __device__ __forceinline__ void tile_of(int wgid, Unit& u) const { const int nig = WGM * nN, gid = wgid / nig, fm = gid * WGM, gsz = (nM - fm) < WGM ? (nM - fm) : WGM; u.pm = fm + ((wgid % nig) % gsz); u.pn = (wgid % nig) / gsz; }
    __device__ __forceinline__ bool next(int i, Unit& u) const {
        if (i < Rs) { const long L = (long)i * G + c; if (L >= nwg) return false;
            int wgid = (int)L; { const int qv = nwg / NXCD, r = nwg % NXCD, xcd = wgid % NXCD, off = wgid / NXCD; wgid = (xcd < r ? xcd * (qv + 1) : r * (qv + 1) + (xcd - r) * qv) + off; }
            tile_of(wgid, u); u.kb = 0; u.ke = nt; u.kind = 0; u.slot = 0; return true; }
        const int j = i - Rs; if (j >= nsk) return false;
        const int un = ufirst + j; tile_of((un / cnt8) * qq + 32 * Rs + (un % cnt8), u);
        u.kb = (j == 0) ? 2 * (int)(s - (long)ufirst * np) : 0; u.ke = (un == ulast) ? 2 * (int)(e - (long)ulast * np) : nt;
        u.kind = (u.kb > 0) ? 1 : ((u.ke < nt) ? 2 : 0); u.slot = (u.kind == 1) ? q : q + 1; return true;
    }
    __device__ __forceinline__ int count() const { return Rs + nsk; }
};

struct ListOrder {
    static constexpr bool SK = true;
    const PG8_LAS int* list; int n;
    float* slots; unsigned* counters;
    __device__ __forceinline__ bool next(int i, Unit& u) const {
        if (i >= n) return false; const PG8_LAS int* p = list + 8 * i;
        u.pm = __builtin_amdgcn_readfirstlane(p[0]); u.pn = __builtin_amdgcn_readfirstlane(p[1]); u.kb = __builtin_amdgcn_readfirstlane(p[2]);
        u.ke = __builtin_amdgcn_readfirstlane(p[3]); u.kind = __builtin_amdgcn_readfirstlane(p[4]); u.slot = __builtin_amdgcn_readfirstlane(p[5]); return true;
    }
    __device__ __forceinline__ void a_ready(const Unit&) const {}
    __device__ __forceinline__ void done(const Unit&) const {}
    __device__ __forceinline__ void store_partial(const f32x4 (&acc)[2][2][4][2], const Unit& u, int tid) const {
        const __amdgpu_buffer_rsrc_t rs = __builtin_amdgcn_make_buffer_rsrc((void*)(slots + (size_t)u.slot * 65536), (short)0, 262144, 0x00020000);
#pragma unroll
        for (int a = 0; a < 2; ++a)
#pragma unroll
            for (int b = 0; b < 2; ++b)
#pragma unroll
                for (int m = 0; m < 4; ++m)
#pragma unroll
                    for (int n = 0; n < 2; ++n) __builtin_amdgcn_raw_buffer_store_b128(__builtin_bit_cast(u32x4, acc[a][b][m][n]), rs, ((((a * 2 + b) * 4 + m) * 2 + n) * 512 + tid) * 16, 0, 16);
        asm volatile("s_waitcnt vmcnt(0)" ::: "memory");
        if ((tid & 63) == 0) __hip_atomic_fetch_add(counters + 64 * u.slot, 1u, __ATOMIC_RELAXED, __HIP_MEMORY_SCOPE_AGENT);
    }
    __device__ __forceinline__ void add_partial(f32x4 (&acc)[2][2][4][2], const Unit& u, int tid, int wid) const {
        if (wid == 0) {
            unsigned spins = 0;
            while ((unsigned)__builtin_amdgcn_readfirstlane(__hip_atomic_load(counters + 64 * u.slot, __ATOMIC_RELAXED, __HIP_MEMORY_SCOPE_AGENT)) < 8u) { __builtin_amdgcn_s_sleep(2); if (++spins > (1u << 22)) break; }
            __builtin_amdgcn_fence(__ATOMIC_ACQUIRE, "agent");
            asm volatile("s_waitcnt vmcnt(0)" ::: "memory");
        }
        asm volatile("" ::: "memory"); __builtin_amdgcn_s_barrier(); asm volatile("" ::: "memory");
        const float* sp = slots + (size_t)u.slot * 65536;
#pragma unroll
        for (int a = 0; a < 2; ++a)
#pragma unroll
            for (int b = 0; b < 2; ++b)
#pragma unroll
                for (int m = 0; m < 4; ++m)
                {
#pragma unroll
                  for (int n = 0; n < 2; ++n) acc[a][b][m][n] += *(const f32x4*)(sp + ((size_t)((((a * 2 + b) * 4 + m) * 2 + n) * 512 + tid)) * 4);
                  if (m & 1) asm volatile("" : "+v"(acc[a][b][m - 1][0]), "+v"(acc[a][b][m - 1][1]), "+v"(acc[a][b][m][0]), "+v"(acc[a][b][m][1]) :: "memory"); }
    }
};
__device__ __forceinline__ int sk_build_list(const SkOrder& S, PG8_LAS int* list) {
    const int n = S.count();
    if ((int)threadIdx.x < n && threadIdx.x < 32) { Unit u; S.next((int)threadIdx.x, u); PG8_LAS int* p = list + 8 * threadIdx.x; p[0] = u.pm; p[1] = u.pn; p[2] = u.kb; p[3] = u.ke; p[4] = u.kind; p[5] = u.slot; }
    __syncthreads();
    return n < 32 ? n : 32;
}

__device__ __forceinline__ unsigned cvt_pk_bf16(float lo, float hi) { unsigned r; asm volatile("v_cvt_pk_bf16_f32 %0, %1, %2" : "=v"(r) : "v"(lo), "v"(hi)); return r; }
typedef float f32x2 __attribute__((ext_vector_type(2)));

struct EpiNull {
    static constexpr bool PERM = true, AFTER_DRAIN = false;
    float* sink;
    __device__ __forceinline__ void operator()(const f32x4 (&acc)[2][2][4][2], const Unit& u, int wr, int wc, int fr, int fq) const {
        f32x4 s = acc[0][0][0][0];
#pragma unroll
        for (int a = 0; a < 2; ++a)
#pragma unroll
            for (int b = 0; b < 2; ++b)
#pragma unroll
                for (int m = 0; m < 4; ++m)
#pragma unroll
                    for (int n = 0; n < 2; ++n) s += acc[a][b][m][n];
        if (s[0] + s[1] + s[2] + s[3] == 1.2345e37f) *sink = s[0];
    }
};
struct EpiF32 {
    static constexpr bool PERM = false, AFTER_DRAIN = false;
    float* C; int ldc; const float* bias;
    __device__ __forceinline__ void operator()(const f32x4 (&acc)[2][2][4][2], const Unit& u, int wr, int wc, int fr, int fq) const {
        const int row0 = u.pm * BM + wr * 64 + fr, col0 = u.pn * BM + wc * 32 + 4 * fq;
        f32x4 bv[2][2];
#pragma unroll
        for (int bj = 0; bj < 2; ++bj)
#pragma unroll
            for (int n = 0; n < 2; ++n) bv[bj][n] = *(const f32x4*)(bias + col0 + bj * HALF + n * 16);
#pragma unroll
        for (int ai = 0; ai < 2; ++ai)
#pragma unroll
            for (int m = 0; m < 4; ++m) { float* rowp = C + (size_t)(row0 + ai * HALF + m * 16) * ldc + col0;
#pragma unroll
                for (int bj = 0; bj < 2; ++bj)
#pragma unroll
                    for (int n = 0; n < 2; ++n) *(f32x4*)(rowp + bj * HALF + n * 16) = acc[ai][bj][m][n] + bv[bj][n]; }
    }
};
struct EpiBf16 {
    static constexpr bool PERM = true, AFTER_DRAIN = false;
    bf16_t* O; int ldc;
    __device__ __forceinline__ void operator()(const f32x4 (&acc)[2][2][4][2], const Unit& u, int wr, int wc, int fr, int fq) const {
        const int row0 = u.pm * BM + wr * 64 + fr, col0 = u.pn * BM + wc * 32 + 8 * fq;
#pragma unroll
        for (int ai = 0; ai < 2; ++ai)
#pragma unroll
            for (int m = 0; m < 4; ++m) { bf16_t* rowp = O + (size_t)(row0 + ai * HALF + m * 16) * ldc + col0;
#pragma unroll
                for (int bj = 0; bj < 2; ++bj) { const f32x4 v0 = acc[ai][bj][m][0], v1 = acc[ai][bj][m][1];
                    u32x4 w; w.x = cvt_pk_bf16(v0[0], v0[1]); w.y = cvt_pk_bf16(v0[2], v0[3]); w.z = cvt_pk_bf16(v1[0], v1[1]); w.w = cvt_pk_bf16(v1[2], v1[3]);
                    *(u32x4*)(rowp + bj * HALF) = w; } }
    }
};
__device__ __forceinline__ float silu_mul(float a, float b) { return a * b * __builtin_amdgcn_rcpf(1.0f + __expf(-a)); }
struct EpiSwiGLU {
    static constexpr bool PERM = true, AFTER_DRAIN = false;
    bf16_t* O; int ldc;
    __device__ __forceinline__ void operator()(const f32x4 (&acc)[2][2][4][2], const Unit& u, int wr, int wc, int fr, int fq) const {
        const int row0 = u.pm * BM + wr * 64 + fr, col0 = u.pn * HALF + wc * 32 + 8 * fq;
#pragma unroll
        for (int ai = 0; ai < 2; ++ai)
#pragma unroll
            for (int m = 0; m < 4; ++m) { bf16_t* rowp = O + (size_t)(row0 + ai * HALF + m * 16) * ldc + col0;
                const f32x4 a0 = acc[ai][0][m][0], a1 = acc[ai][0][m][1], b0 = acc[ai][1][m][0], b1 = acc[ai][1][m][1];
                u32x4 w;
                w.x = cvt_pk_bf16(silu_mul(a0[0], b0[0]), silu_mul(a0[1], b0[1])); w.y = cvt_pk_bf16(silu_mul(a0[2], b0[2]), silu_mul(a0[3], b0[3]));
                w.z = cvt_pk_bf16(silu_mul(a1[0], b1[0]), silu_mul(a1[1], b1[1])); w.w = cvt_pk_bf16(silu_mul(a1[2], b1[2]), silu_mul(a1[3], b1[3]));
                *(u32x4*)rowp = w; }
    }
};
struct EpiSwiGLU8 {
    static constexpr bool PERM = true, AFTER_DRAIN = false;
    unsigned char* O; int ldc; float inv, st;
    __device__ __forceinline__ void operator()(const f32x4 (&acc)[2][2][4][2], const Unit& u, int wr, int wc, int fr, int fq) const {
        const int row0 = u.pm * BM + wr * 64 + fr, col0 = u.pn * HALF + wc * 32 + 8 * fq;
        const float ib = inv * st;
#pragma unroll
        for (int ai = 0; ai < 2; ++ai)
#pragma unroll
            for (int m = 0; m < 4; ++m) { unsigned char* rowp = O + (size_t)(row0 + ai * HALF + m * 16) * ldc + col0;
                const f32x4 a0 = acc[ai][0][m][0] * inv, a1 = acc[ai][0][m][1] * inv, b0 = acc[ai][1][m][0] * ib, b1 = acc[ai][1][m][1] * ib;
                u32x2 w;
                w.x = cvt4_fp8(silu_mul(a0[0], b0[0]), silu_mul(a0[1], b0[1]), silu_mul(a0[2], b0[2]), silu_mul(a0[3], b0[3]));
                w.y = cvt4_fp8(silu_mul(a1[0], b1[0]), silu_mul(a1[1], b1[1]), silu_mul(a1[2], b1[2]), silu_mul(a1[3], b1[3]));
                *(u32x2*)rowp = w; }
    }
};
template <bool PIPE, bool BASE_BF16, bool OUT_BF16 = true> struct EpiResid {
    static constexpr bool PERM = false, AFTER_DRAIN = false;
    const void* base_p; const void* base_s; void* out; const float* mod; int ldc, modld, goff, split_rows; float gs;
    static __device__ __forceinline__ f32x4 ldb(const void* rowp, int c) {
        if constexpr (BASE_BF16) { const u32x2 q = *(const u32x2*)((const bf16_t*)rowp + c);
            return (f32x4){__builtin_bit_cast(float, q.x << 16), __builtin_bit_cast(float, q.x & 0xffff0000u), __builtin_bit_cast(float, q.y << 16), __builtin_bit_cast(float, q.y & 0xffff0000u)}; }
        else return *(const f32x4*)((const float*)rowp + c);
    }
    static __device__ __forceinline__ const void* rowptr(const void* b, size_t r, int ldc) { if constexpr (BASE_BF16) return (const bf16_t*)b + r * ldc; else return (const float*)b + r * ldc; }
    static __device__ __forceinline__ void stq(void* orow, int c, f32x4 v) {
        if constexpr (OUT_BF16) { u32x2 w; w.x = cvt_pk_bf16(v[0], v[1]); w.y = cvt_pk_bf16(v[2], v[3]); *(u32x2*)((bf16_t*)orow + c) = w; }
        else *(f32x4*)((float*)orow + c) = v; }
    static __device__ __forceinline__ void* orowp(void* o, size_t r, int ldc) { if constexpr (OUT_BF16) return (bf16_t*)o + r * ldc; else return (float*)o + r * ldc; }
    __device__ __forceinline__ void operator()(const f32x4 (&acc)[2][2][4][2], const Unit& u, int wr, int wc, int fr, int fq) const {
        const int col0 = u.pn * BM + wc * 32 + 4 * fq;
        if (PIPE && u.pm * BM < split_rows) {
            f32x4 gq[2][2], bc[2][2], bn[2][2];
            { const void* rp = rowptr(base_p, (size_t)(u.pm * BM + wr * 64 + fr), ldc);
#pragma unroll
            for (int bj = 0; bj < 2; ++bj)
#pragma unroll
                for (int n = 0; n < 2; ++n) { gq[bj][n] = *(const f32x4*)(mod + goff + col0 + bj * HALF + n * 16) * gs; bc[bj][n] = ldb(rp, col0 + bj * HALF + n * 16); } }
#pragma unroll
            for (int gi = 0; gi < 8; ++gi) { const int ai = gi >> 2, m = gi & 3; const int r = u.pm * BM + ai * HALF + wr * 64 + m * 16 + fr;
                if (gi < 7) { const void* rp = rowptr(base_p, (size_t)(u.pm * BM + ((gi + 1) >> 2) * HALF + wr * 64 + ((gi + 1) & 3) * 16 + fr), ldc);
#pragma unroll
                    for (int bj = 0; bj < 2; ++bj)
#pragma unroll
                        for (int n = 0; n < 2; ++n) bn[bj][n] = ldb(rp, col0 + bj * HALF + n * 16); }
                void* orow = orowp(out, (size_t)r, ldc);
#pragma unroll
                for (int bj = 0; bj < 2; ++bj)
#pragma unroll
                    for (int n = 0; n < 2; ++n) { stq(orow, col0 + bj * HALF + n * 16, bc[bj][n] + gq[bj][n] * acc[ai][bj][m][n]); bc[bj][n] = bn[bj][n]; }
                asm volatile("" ::: "memory"); }
        } else {
#pragma unroll
            for (int ai = 0; ai < 2; ++ai)
#pragma unroll
                for (int m = 0; m < 4; ++m) { const int r = u.pm * BM + ai * HALF + wr * 64 + m * 16 + fr;
                    const void* brow = (r < split_rows) ? rowptr(base_p, (size_t)r, ldc) : rowptr(base_s, (size_t)(r - split_rows), ldc);
                    const float* grow = mod + (size_t)((r < split_rows) ? 0 : 1 + ((r - split_rows) >> 3)) * modld + goff;
                    void* orow = orowp(out, (size_t)r, ldc);
#pragma unroll
                    for (int bj = 0; bj < 2; ++bj)
#pragma unroll
                        for (int n = 0; n < 2; ++n) { const int c = col0 + bj * HALF + n * 16;
                            const f32x4 b = ldb(brow, c), g = *(const f32x4*)(grow + c);
                            stq(orow, c, b + (g * gs) * acc[ai][bj][m][n]); }
                    asm volatile("" ::: "memory"); }
        }
    }
};
template <class Epi, class Sched, bool ALIGN_EPI = false, bool SP2 = false, bool FP8 = false, int DIAG = 0>
__device__ __forceinline__ void gemm_phase(PG8_LAS unsigned char* lds, const Gemm g, const Sched& S, const Epi& E) {
    const int tid = threadIdx.x, wid = __builtin_amdgcn_readfirstlane(tid >> 6), lane = tid & 63, wr = wid >> 2, wc = wid & 3, fr = lane & 15, fq = lane >> 4;
    const int K = g.K, nt = K / BK;
    unsigned voffA[2], voffB[2];
#pragma unroll
    for (int i = 0; i < 2; ++i) { int R, C; stage_rc(tid * 16 + i * 8192, R, C); const int Rb = Epi::PERM ? ((R & ~31) + perm32(R & 31)) : R;
        voffA[i] = (unsigned)(R * K + C) * 2u; voffB[i] = (unsigned)(Rb * K + C) * 2u; }
    const size_t kstep = (size_t)(BK * 2);
    const size_t hstep = (size_t)HALF * K * 2;
    const size_t tstep = 2 * hstep;
    const unsigned ldsw = (unsigned)wid * 1024u;
    const int aoff = lds_byte(wr * 64 + fr, fq * 8), boff = lds_byte(wc * 32 + fr, fq * 8);
#define PG8_SA(b, h) (((b) * 2 + (h)) * HTB)
#define PG8_SB(b, h) ((4 + (b) * 2 + (h)) * HTB)
#define PG8_STAGE(bufoff, gbase, voff) do { if constexpr (DIAG >= 1) break; _Pragma("unroll") for (int _i = 0; _i < 2; ++_i) \
        __builtin_amdgcn_global_load_lds((const unsigned*)((const char*)(gbase) + (voff)[_i]), (PG8_LAS unsigned*)(lds + (bufoff) + ldsw + _i * 8192), 16, 0, 0); } while (0)
#define PG8_LDA(dst, b, h) do { if constexpr (DIAG >= 2) break; _Pragma("unroll") for (int m = 0; m < 4; ++m) _Pragma("unroll") for (int k = 0; k < 2; ++k) dst[m][k] = *(const PG8_LAS bf16x8*)(lds + PG8_SA(b, h) + aoff + m * 2048 + k * 1024); } while (0)
#define PG8_LDB(dst, b, h) do { if constexpr (DIAG >= 2) break; _Pragma("unroll") for (int n = 0; n < 2; ++n) _Pragma("unroll") for (int k = 0; k < 2; ++k) dst[n][k] = *(const PG8_LAS bf16x8*)(lds + PG8_SB(b, h) + boff + n * 2048 + k * 1024); } while (0)
#define PG8_MMA(ai, bj, At, Bt) do { __builtin_amdgcn_s_setprio(1); _Pragma("unroll") for (int m = 0; m < 4; ++m) _Pragma("unroll") for (int n = 0; n < 2; ++n) { \
        if constexpr (FP8) { asm volatile("v_mfma_f32_16x16x128_f8f6f4 %0, %1, %2, %0" : "+v"(acc[ai][bj][m][n]) : "v"(cat8(Bt[n][0], Bt[n][1])), "v"(cat8(At[m][0], At[m][1]))); } \
        else { _Pragma("unroll") for (int k = 0; k < 2; ++k) acc[ai][bj][m][n] = __builtin_amdgcn_mfma_f32_16x16x32_bf16(Bt[n][k], At[m][k], acc[ai][bj][m][n], 0, 0, 0); } } __builtin_amdgcn_s_setprio(0); } while (0)
#define PG8_WAIT_V(n) asm volatile("s_waitcnt vmcnt(" #n ")" ::: "memory")
#define PG8_WAIT_L(n) asm volatile("s_waitcnt lgkmcnt(" #n ")" ::: "memory")
#define PG8_BAR __builtin_amdgcn_s_barrier()
#if PG8_LOADPRIO
#define PG8_LP_ON __builtin_amdgcn_s_setprio(PG8_LOADPRIO)
#define PG8_LP_OFF __builtin_amdgcn_s_setprio(0)
#else
#define PG8_LP_ON do {} while (0)
#define PG8_LP_OFF do {} while (0)
#endif
#define PG8_SCHED __builtin_amdgcn_sched_barrier(0)
    Unit cur, nxt; int ui = 0;
    if (!S.next(0, cur)) return;
    f32x4 acc[2][2][4][2];
#pragma unroll
    for (int a = 0; a < 2; ++a)
#pragma unroll
        for (int b = 0; b < 2; ++b)
#pragma unroll
            for (int m = 0; m < 4; ++m)
#pragma unroll
                for (int n = 0; n < 2; ++n) acc[a][b][m][n] = (f32x4){0.f, 0.f, 0.f, 0.f};
    bf16x8 At[4][2], B0[2][2], B1[2][2];
    if constexpr (DIAG >= 2) { _Pragma("unroll") for (int i = 0; i < 4; ++i) _Pragma("unroll") for (int k = 0; k < 2; ++k) At[i][k] = (bf16x8){0,0,0,0,0,0,0,0}; _Pragma("unroll") for (int i = 0; i < 2; ++i) _Pragma("unroll") for (int k = 0; k < 2; ++k) { B0[i][k] = (bf16x8){0,0,0,0,0,0,0,0}; B1[i][k] = (bf16x8){0,0,0,0,0,0,0,0}; } }
    const char* cA = (const char*)g.A + (size_t)cur.pm * tstep; const char* cB = (const char*)g.Bt + (size_t)cur.pn * tstep;
    int kb = 0, ke = nt; if constexpr (Sched::SK) { kb = cur.kb; ke = cur.ke; }
    const char* pA = cA + (size_t)kb * kstep; const char* pB = cB + (size_t)kb * kstep;
    S.a_ready(cur);
    if constexpr (SP2) {
        PG8_STAGE(PG8_SB(0, 0), pB, voffB); PG8_STAGE(PG8_SB(0, 1), pB + hstep, voffB); PG8_STAGE(PG8_SA(0, 0), pA, voffA); PG8_STAGE(PG8_SA(0, 1), pA + hstep, voffA);
        if (wr == 1) PG8_BAR;
        PG8_WAIT_V(2); PG8_BAR;
        PG8_STAGE(PG8_SB(1, 0), pB + kstep, voffB); PG8_STAGE(PG8_SA(1, 0), pA + kstep, voffA); PG8_STAGE(PG8_SB(1, 1), pB + hstep + kstep, voffB);
        PG8_WAIT_V(6); PG8_BAR;
    } else {
        PG8_STAGE(PG8_SB(0, 0), pB, voffB); PG8_STAGE(PG8_SA(0, 0), pA, voffA); PG8_STAGE(PG8_SB(0, 1), pB + hstep, voffB); PG8_STAGE(PG8_SA(0, 1), pA + hstep, voffA);
        if (wr == 1) PG8_BAR;
        PG8_WAIT_V(4); PG8_BAR;
        PG8_STAGE(PG8_SB(1, 0), pB + kstep, voffB); PG8_STAGE(PG8_SA(1, 0), pA + kstep, voffA); PG8_STAGE(PG8_SB(1, 1), pB + hstep + kstep, voffB);
        PG8_WAIT_V(6); PG8_BAR;
    }
    for (;;) {
        const bool has_next = S.next(ui + 1, nxt);
        const char* nA0 = has_next ? (const char*)g.A + (size_t)nxt.pm * tstep : cA; const char* nB0 = has_next ? (const char*)g.Bt + (size_t)nxt.pn * tstep : cB;
        int nkb = 0; if constexpr (Sched::SK) { if (has_next) nkb = nxt.kb; }
        const char* nA = nA0 + (size_t)nkb * kstep; const char* nB = nB0 + (size_t)nkb * kstep;
        for (int t = kb; t < ke; t += 2) {
            const bool last = (t == ke - 2);
            const char* a1 = cA + (size_t)(t + 1) * kstep;
            const char* a2 = last ? nA : cA + (size_t)(t + 2) * kstep; const char* b2 = last ? nB : cB + (size_t)(t + 2) * kstep;
            const char* a3 = a2 + kstep; const char* b3 = b2 + kstep;
            if (last && has_next) S.a_ready(nxt);
            if constexpr (SP2) {
            PG8_LP_ON; PG8_LDB(B0, 0, 0); PG8_LDB(B1, 0, 1); PG8_SCHED; PG8_LDA(At, 0, 0); PG8_STAGE(PG8_SA(1, 1), a1 + hstep, voffA);
            PG8_LP_OFF; PG8_WAIT_V(8); PG8_WAIT_L(0); PG8_BAR; PG8_MMA(0, 0, At, B0); PG8_MMA(0, 1, At, B1); PG8_BAR; PG8_SCHED;
            PG8_LP_ON; PG8_LDA(At, 0, 1); PG8_STAGE(PG8_SB(0, 0), b2, voffB); PG8_STAGE(PG8_SB(0, 1), b2 + hstep, voffB); PG8_STAGE(PG8_SA(0, 0), a2, voffA);
            PG8_LP_OFF; PG8_WAIT_V(8); PG8_WAIT_L(0); PG8_BAR; PG8_MMA(1, 0, At, B0); PG8_MMA(1, 1, At, B1); PG8_BAR; PG8_SCHED;
            PG8_LP_ON; PG8_LDB(B0, 1, 0); PG8_LDB(B1, 1, 1); PG8_SCHED; PG8_LDA(At, 1, 0); PG8_STAGE(PG8_SA(0, 1), a2 + hstep, voffA);
            PG8_LP_OFF; PG8_WAIT_V(8); PG8_WAIT_L(0); PG8_BAR; PG8_MMA(0, 0, At, B0); PG8_MMA(0, 1, At, B1); PG8_BAR; PG8_SCHED;
            PG8_LP_ON; PG8_LDA(At, 1, 1); PG8_STAGE(PG8_SB(1, 0), b3, voffB); PG8_STAGE(PG8_SB(1, 1), b3 + hstep, voffB); PG8_STAGE(PG8_SA(1, 0), a3, voffA);
            PG8_LP_OFF; PG8_WAIT_V(8); PG8_WAIT_L(0); PG8_BAR; PG8_MMA(1, 0, At, B0); PG8_MMA(1, 1, At, B1); PG8_BAR; PG8_SCHED;
            } else {
            PG8_LDB(B0, 0, 0); PG8_SCHED; PG8_LDA(At, 0, 0); PG8_STAGE(PG8_SA(1, 1), a1 + hstep, voffA);
            PG8_WAIT_L(8); PG8_BAR; PG8_WAIT_L(0); PG8_MMA(0, 0, At, B0); PG8_BAR; PG8_SCHED;
            PG8_LDB(B1, 0, 1); PG8_STAGE(PG8_SB(0, 0), b2, voffB);
            PG8_BAR; PG8_WAIT_L(0); PG8_MMA(0, 1, At, B1); PG8_BAR;
            PG8_LDA(At, 0, 1); PG8_STAGE(PG8_SA(0, 0), a2, voffA);
            PG8_BAR; PG8_WAIT_L(0); PG8_MMA(1, 0, At, B0); PG8_BAR; PG8_SCHED;
            PG8_STAGE(PG8_SB(0, 1), b2 + hstep, voffB);
            PG8_WAIT_V(6); PG8_BAR; PG8_MMA(1, 1, At, B1); PG8_BAR;
            PG8_LDB(B0, 1, 0); PG8_SCHED; PG8_LDA(At, 1, 0); PG8_STAGE(PG8_SA(0, 1), a2 + hstep, voffA);
            PG8_WAIT_L(8); PG8_BAR; PG8_WAIT_L(0); PG8_MMA(0, 0, At, B0); PG8_BAR; PG8_SCHED;
            PG8_LDB(B1, 1, 1); PG8_STAGE(PG8_SB(1, 0), b3, voffB);
            PG8_BAR; PG8_WAIT_L(0); PG8_MMA(0, 1, At, B1); PG8_BAR;
            PG8_LDA(At, 1, 1); PG8_STAGE(PG8_SA(1, 0), a3, voffA);
            PG8_BAR; PG8_WAIT_L(0); PG8_MMA(1, 0, At, B0); PG8_BAR; PG8_SCHED;
            PG8_STAGE(PG8_SB(1, 1), b3 + hstep, voffB);
            PG8_WAIT_V(6); PG8_BAR; PG8_MMA(1, 1, At, B1); PG8_BAR;
            }
        }
        if constexpr (FP8) { asm volatile("s_nop 7\n\ts_nop 7" ::: "memory"); PG8_SCHED; }
        if constexpr (ALIGN_EPI) { if (wr == 0) PG8_BAR; }
        if constexpr (Sched::SK) {
            if (cur.kind == 1) S.store_partial(acc, cur, tid);
            else if (cur.kind == 0) { E(acc, cur, wr, wc, fr, fq); S.done(cur); }
        } else
        if constexpr (!Epi::AFTER_DRAIN) { E(acc, cur, wr, wc, fr, fq); S.done(cur); }
        if (!has_next) break;
#pragma unroll
        for (int a = 0; a < 2; ++a)
#pragma unroll
            for (int b = 0; b < 2; ++b)
#pragma unroll
                for (int m = 0; m < 4; ++m)
#pragma unroll
                    for (int n = 0; n < 2; ++n) acc[a][b][m][n] = (f32x4){0.f, 0.f, 0.f, 0.f};
        cur = nxt; cA = nA0; cB = nB0; ++ui; if constexpr (Sched::SK) { kb = cur.kb; ke = cur.ke; }
        if constexpr (ALIGN_EPI) { if (wr == 1) PG8_BAR; }
    }
    PG8_WAIT_V(0);
    if constexpr (!ALIGN_EPI) { if (wr == 0) PG8_BAR; }
    PG8_BAR;
    if constexpr (Epi::AFTER_DRAIN) { E.fused(acc, cur, wr, wc, fr, fq, lds, wid, lane); S.done(cur); }
    if constexpr (Sched::SK) { if (cur.kind == 2) { S.add_partial(acc, cur, tid, wid); E(acc, cur, wr, wc, fr, fq); S.done(cur); } }
#undef PG8_SA
#undef PG8_SB
#undef PG8_STAGE
#undef PG8_LDA
#undef PG8_LDB
#undef PG8_MMA
#undef PG8_WAIT_V
#undef PG8_WAIT_L
#undef PG8_BAR
#undef PG8_LP_ON
#undef PG8_LP_OFF
#undef PG8_SCHED
}
}

#ifndef PG8_SP2
#define PG8_SP2 true
#endif
#ifndef PG8_ALIGN
#define PG8_ALIGN true
#endif
#ifndef PROBE_GEMM
#define PROBE_GEMM 0
#endif
#ifndef UP_CUT
#define UP_CUT 0
#endif
#ifndef MK_PER_PHASE
#define MK_PER_PHASE 0
#endif

constexpr int NWAVES = 8;
constexpr int D = 4096, SEQ = 8192, DBATCH = 128, DSEQ = 8, MS = DBATCH * DSEQ, M = SEQ + MS;
constexpr int FF = 11008, NPROJ = 9216, NMOD = 9, MODW = NMOD * D, MODROWS = 256;
constexpr int C_K = 2048, C_V = 2560, C_GB = 3072, C_GC = 5120, C_HC = 7168;
constexpr int WIN = 128, NHEAD = 16;
constexpr float EPS = 1e-6f;
constexpr float S_H = 8.f, S_W13 = 512.f, S_T = 8.f, S_W2 = 512.f;
constexpr size_t O_YP = 0, O_YS = 33554432, O_KWP = 37748736, O_VWP = 37814272, O_CP = 37879808, O_KWS = 37883904, O_VWS = 46272512, O_CS = 54661120, O_END = 55185408;
enum { I_XP = 0, I_XS, I_CP, I_CS, I_CK, I_CV, I_SC, I_RB, I_G1, I_W1A, I_W3A, I_W2A, I_GM, I_WIN, I_SINK, I_CW, I_WOUT, I_G2, I_W1B, I_W3B, I_W2B, I_WADA, I_BADA, I_GF, N_IN };

constexpr size_t MiB = 1u << 20;
constexpr size_t al(size_t x) { return (x + MiB - 1) / MiB * MiB; }
constexpr size_t WS_CTL = 0, CTL_ZERO_BYTES = 1 * MiB;
constexpr size_t WS_W13A = 1 * MiB;
constexpr size_t WS_W2A  = WS_W13A + al((size_t)2 * FF * D * 2);
constexpr size_t WS_WIN  = WS_W2A + al((size_t)D * FF * 2);
constexpr size_t WS_WOUT = WS_WIN + al((size_t)NPROJ * D * 2);
constexpr size_t WS_W13B = WS_WOUT + al((size_t)D * D * 2);
constexpr size_t WS_W2B  = WS_W13B + al((size_t)2 * FF * D * 2);
constexpr size_t WS_WADA = WS_W2B + al((size_t)D * FF * 2);
constexpr size_t WS_CSI  = WS_WADA + al((size_t)MODW * D * 2);
constexpr size_t WS_MOD  = WS_CSI + al((size_t)MODROWS * D * 2);
constexpr size_t WS_X1   = WS_MOD + al((size_t)MODROWS * MODW * 4);
constexpr size_t WS_H    = WS_X1 + al((size_t)M * D * 4);
constexpr size_t WS_T    = WS_H + al((size_t)M * D * 2);
constexpr size_t WS_PROJ = WS_T + al((size_t)M * FF * 2);
constexpr size_t WS_MIX  = WS_PROJ + al((size_t)M * NPROJ * 2);
constexpr size_t WS_PART = WS_MIX + al((size_t)M * D * 2);
constexpr size_t WS_SKS  = WS_PART + al((size_t)4 * (DBATCH + 1) * 12288 * 4);
constexpr size_t WS_SKS2 = WS_SKS + (size_t)256 * 262144;
constexpr size_t WS_END  = WS_SKS2 + (size_t)256 * 262144;
constexpr int CW_TMO = 0, CW_CODE = 1, CW_BAR = 4096;
constexpr int CW_SK = 16384, CW_SK_STRIDE = 16384;
static_assert((size_t)(CW_SK + 8 * CW_SK_STRIDE) * 4 <= CTL_ZERO_BYTES, "stream-K counters inside the zeroed control region");

constexpr int RING_OFF = 0, RING_BYTES = 131072;
constexpr int SKLIST_OFF = 131072;
constexpr int LDSCTL_OFF = 143360, MISC_OFF = LDSCTL_OFF + 320;
constexpr int LDS_BYTES = 147456;
static_assert(MISC_OFF + 128 <= LDS_BYTES, "LDS map");

#define GAS __attribute__((address_space(1)))
#define LAS __attribute__((address_space(3)))
typedef unsigned short bf16;
typedef unsigned v4u __attribute__((ext_vector_type(4)));
typedef unsigned v2u __attribute__((ext_vector_type(2)));
typedef float f32x4 __attribute__((ext_vector_type(4)));
typedef float f32x16 __attribute__((ext_vector_type(16)));
typedef short bf16x8 __attribute__((ext_vector_type(8)));
typedef GAS unsigned gu32;
#define RLX_AGENT __ATOMIC_RELAXED, __HIP_MEMORY_SCOPE_AGENT
#define LDS_WAIT() asm volatile("s_waitcnt lgkmcnt(0)" ::: "memory")
#define VM_WAIT() asm volatile("s_waitcnt vmcnt(0)" ::: "memory")
__device__ __forceinline__ unsigned f2bf(float f) { unsigned u = __builtin_bit_cast(unsigned, f); return (u + 0x7fffu + ((u >> 16) & 1u)) >> 16; }
__device__ __forceinline__ unsigned pk2(float lo, float hi) { return f2bf(lo) | (f2bf(hi) << 16); }
__device__ __forceinline__ float bf_lo(unsigned w) { return __builtin_bit_cast(float, w << 16); }
__device__ __forceinline__ float bf_hi(unsigned w) { return __builtin_bit_cast(float, w & 0xffff0000u); }

#define XB_TMO      128
#define XB_XCNT(j)  (256  + 64 * (j))
#define XB_XSUB(j)  (1280 + 64 * (j))
#define XB_XGEN(j)  (2304 + 64 * (j))
#define XB_TOP      3328
#define XB_TOPGEN   3392
#define XCD_BAR_WORDS 3456
#define XB_SPIN_CAP (1u << 18)

__device__ __forceinline__ unsigned xb_ld(unsigned* p)              { return __hip_atomic_load(p, __ATOMIC_RELAXED, __HIP_MEMORY_SCOPE_AGENT); }
__device__ __forceinline__ unsigned xb_add(unsigned* p, unsigned v) { return __hip_atomic_fetch_add(p, v, __ATOMIC_RELAXED, __HIP_MEMORY_SCOPE_AGENT); }
__device__ __forceinline__ unsigned xb_xcc_id() { return (unsigned)__builtin_amdgcn_s_getreg((3 << 11) | 20) & 0xFu; }
#define XB_SPIN(cond, bar) do { unsigned _sp = 0; while (cond) { __builtin_amdgcn_s_sleep(1); \
    if ((++_sp & 255u) == 0u) { if (xb_ld(&(bar)[XB_TMO])) break; if (_sp > XB_SPIN_CAP) { atomicAdd(&(bar)[XB_TMO], 1u); break; } } } } while (0)

struct XcdBarrier {
    unsigned* bar; unsigned x;
    volatile LAS unsigned* st;
};

__device__ __forceinline__ XcdBarrier xcd_barrier_post(unsigned* bar, volatile LAS unsigned* st) {
    XcdBarrier b; b.bar = bar; b.x = xb_xcc_id(); b.st = st;
    if (threadIdx.x == 0) (void)xb_add(&bar[XB_XCNT(b.x)], 1u);
    return b;
}
__device__ __forceinline__ void xcd_barrier_complete(unsigned* bar, unsigned x, unsigned& nloc, unsigned& nx) {
    const unsigned G = gridDim.x * gridDim.y * gridDim.z;
    unsigned sum, cnt, mine, sp = 0u;
    for (;;) {
        sum = 0u; cnt = 0u; mine = 0u;
#pragma unroll
        for (unsigned j = 0; j < 16; ++j) { const unsigned c = xb_ld(&bar[XB_XCNT(j)]); sum += c; cnt += (c > 0u) ? 1u : 0u; mine = (j == x) ? c : mine; }
        if (sum == G) break;
        __builtin_amdgcn_s_sleep(1);
        if ((++sp & 255u) == 0u) { if (xb_ld(&bar[XB_TMO])) break; if (sp > XB_SPIN_CAP) { atomicAdd(&bar[XB_TMO], 1u); break; } }
    }
    nloc = mine > 0u ? mine : 1u; nx = cnt > 0u ? cnt : 1u;
}

__device__ __forceinline__ void xcd_barrier(const XcdBarrier& b) {
    asm volatile("s_waitcnt vmcnt(0)" ::: "memory");
    __syncthreads();
    if (threadIdx.x == 0) {
        unsigned* bar = b.bar;
        __builtin_amdgcn_s_waitcnt(0);
        unsigned nloc = b.st[0], nx = b.st[1];
        if (nloc == 0u) { xcd_barrier_complete(bar, b.x, nloc, nx); b.st[0] = nloc; b.st[1] = nx; }
        const unsigned old = xb_add(&bar[XB_XSUB(b.x)], 1u);
        const unsigned gen = old / nloc;
        if (old + 1u == (gen + 1u) * nloc) {
            __builtin_amdgcn_fence(__ATOMIC_RELEASE, "agent");
            asm volatile("s_waitcnt vmcnt(0)" ::: "memory");
            const unsigned og = xb_add(&bar[XB_TOP], 1u);
            const unsigned tg = og / nx;
            if (og + 1u == (tg + 1u) * nx) xb_add(&bar[XB_TOPGEN], 1u);
            else XB_SPIN(xb_ld(&bar[XB_TOPGEN]) == tg, bar);
            __builtin_amdgcn_fence(__ATOMIC_ACQUIRE, "agent");
            xb_add(&bar[XB_XGEN(b.x)], 1u);
            asm volatile("s_waitcnt vmcnt(0)" ::: "memory");
        } else {
            XB_SPIN(xb_ld(&bar[XB_XGEN(b.x)]) == gen, bar);
            __builtin_amdgcn_fence(__ATOMIC_ACQUIRE, "agent");
            asm volatile("s_waitcnt vmcnt(0)" ::: "memory");
        }
    }
    __syncthreads();
}


struct Frame {
    LAS unsigned char* lds;
    volatile LAS unsigned* MISC;
    gu32* ctl;
    int tid, lane, wave;
    int vcu, G;
};
__device__ __forceinline__ float wave_sum(float v) {
#pragma unroll
    for (int o = 1; o < 64; o <<= 1) v += __shfl_xor(v, o);
    return v;
}
template <int MODE>
__device__ __forceinline__ void p0_transpose_item(const float* W, int K, int N, bf16* WT, LAS float* scr, int item, int lane) {
    const int nblk = N / 32, kb = item / nblk, nb = item % nblk, k0 = 64 * kb, n0 = 32 * nb;
    const GAS float* Wg = (const GAS float*)W;
    float ld[32];
#pragma unroll
    for (int i = 0; i < 32; ++i) { const int kk = 2 * i + (lane >> 5); ld[i] = __builtin_nontemporal_load(&Wg[(size_t)(k0 + kk) * N + n0 + (lane & 31)]); }
#pragma unroll
    for (int i = 0; i < 32; ++i) { const int kk = 2 * i + (lane >> 5); scr[kk * 33 + (lane & 31)] = ld[i]; }
    LDS_WAIT(); asm volatile("" ::: "memory");
    const int c = lane & 7;
    const int r0 = (MODE == 0) ? n0 : (n0 / 128) * 256 + (n0 % 128) + (MODE == 2 ? 128 : 0);
#pragma unroll
    for (int j = 0; j < 4; ++j) { const int n = (lane >> 3) + 8 * j; const LAS float* s = scr + (8 * c) * 33 + n;
        v4u o; o.x = pg8::cvt_pk_bf16(s[0 * 33], s[1 * 33]); o.y = pg8::cvt_pk_bf16(s[2 * 33], s[3 * 33]); o.z = pg8::cvt_pk_bf16(s[4 * 33], s[5 * 33]); o.w = pg8::cvt_pk_bf16(s[6 * 33], s[7 * 33]);
        *(GAS v4u*)(WT + (size_t)(r0 + n) * K + k0 + 8 * c) = o; }
    LDS_WAIT(); asm volatile("" ::: "memory");
}

template <int MODE>
__device__ __forceinline__ void p0_transpose_item8(const float* W, int K, int N, unsigned char* WT, float scale, LAS float* scr, int item, int lane) {
    const int nblk = N / 32, kb = item / nblk, nb = item % nblk, k0 = 128 * kb, n0 = 32 * nb;
    const GAS float* Wg = (const GAS float*)W;
#pragma unroll
    for (int h2 = 0; h2 < 2; ++h2) { float ld[32];
#pragma unroll
        for (int i = 0; i < 32; ++i) { const int kk = 2 * (i + 32 * h2) + (lane >> 5); ld[i] = __builtin_nontemporal_load(&Wg[(size_t)(k0 + kk) * N + n0 + (lane & 31)]); }
#pragma unroll
        for (int i = 0; i < 32; ++i) { const int kk = 2 * (i + 32 * h2) + (lane >> 5); scr[kk * 33 + (lane & 31)] = ld[i]; } }
    LDS_WAIT(); asm volatile("" ::: "memory");
    const int n = lane & 31, hf = lane >> 5;
    const int r0 = (MODE == 0) ? n0 : (n0 / 128) * 256 + (n0 % 128) + (MODE == 2 ? 128 : 0);
#pragma unroll
    for (int p = 0; p < 4; ++p) { const int q = 2 * p + hf; const LAS float* s = scr + (16 * q) * 33 + n;
        v4u o;
        o.x = pg8::cvt4_fp8(s[0 * 33] * scale, s[1 * 33] * scale, s[2 * 33] * scale, s[3 * 33] * scale);
        o.y = pg8::cvt4_fp8(s[4 * 33] * scale, s[5 * 33] * scale, s[6 * 33] * scale, s[7 * 33] * scale);
        o.z = pg8::cvt4_fp8(s[8 * 33] * scale, s[9 * 33] * scale, s[10 * 33] * scale, s[11 * 33] * scale);
        o.w = pg8::cvt4_fp8(s[12 * 33] * scale, s[13 * 33] * scale, s[14 * 33] * scale, s[15 * 33] * scale);
        *(GAS v4u*)(WT + (size_t)(r0 + n) * K + k0 + 16 * q) = o; }
    LDS_WAIT(); asm volatile("" ::: "memory");
}

struct Args { const float* in[N_IN]; float* out; unsigned char* ws; int ph_lo, ph_hi; };

enum { JOB_W1A = 0, JOB_W3A, JOB_W2A, JOB_WIN, JOB_WOUT, JOB_W1B, JOB_W3B, JOB_W2B };
template <int JOB>
__device__ __forceinline__ void conv_job(Frame& F, const Args& A, int rank, int nw) {
    LAS float* scr = (LAS float*)(F.lds + RING_OFF + F.wave * 16896);
    unsigned char* ws = A.ws;
    constexpr int I_13 = (D / 128) * (FF / 32), I_2 = (FF / 128) * (D / 32), I_IN = (D / 64) * (NPROJ / 32), I_OUT = (D / 64) * (D / 32);
    constexpr int N = (JOB == JOB_W1A || JOB == JOB_W3A || JOB == JOB_W1B || JOB == JOB_W3B) ? I_13 : (JOB == JOB_W2A || JOB == JOB_W2B) ? I_2 : (JOB == JOB_WIN) ? I_IN : I_OUT;
    for (int it = rank; it < N; it += nw) {
        if constexpr (JOB == JOB_W1A) p0_transpose_item8<1>(A.in[I_W1A], D, FF, ws + WS_W13A, S_W13, scr, it, F.lane);
        if constexpr (JOB == JOB_W3A) p0_transpose_item8<2>(A.in[I_W3A], D, FF, ws + WS_W13A, S_W13, scr, it, F.lane);
        if constexpr (JOB == JOB_W2A) p0_transpose_item8<0>(A.in[I_W2A], FF, D, ws + WS_W2A, S_W2, scr, it, F.lane);
        if constexpr (JOB == JOB_WIN) p0_transpose_item<0>(A.in[I_WIN], D, NPROJ, (bf16*)(ws + WS_WIN), scr, it, F.lane);
        if constexpr (JOB == JOB_WOUT) p0_transpose_item<0>(A.in[I_WOUT], D, D, (bf16*)(ws + WS_WOUT), scr, it, F.lane);
        if constexpr (JOB == JOB_W1B) p0_transpose_item8<1>(A.in[I_W1B], D, FF, ws + WS_W13B, S_W13, scr, it, F.lane);
        if constexpr (JOB == JOB_W3B) p0_transpose_item8<2>(A.in[I_W3B], D, FF, ws + WS_W13B, S_W13, scr, it, F.lane);
        if constexpr (JOB == JOB_W2B) p0_transpose_item8<0>(A.in[I_W2B], FF, D, ws + WS_W2B, S_W2, scr, it, F.lane);
    }
}
__device__ __forceinline__ void csilu_phase(Frame& F, const Args& A) {
    const int gt = (F.vcu * NWAVES + F.wave) * 64 + F.lane, NGT = F.G * NWAVES * 64;
    bf16* cs = (bf16*)(A.ws + WS_CSI);
    for (int it = gt; it < 144 * D / 8; it += NGT) {
        const int row = it / (D / 8), c8 = (it % (D / 8)) * 8;
        v4u o = (v4u){0u, 0u, 0u, 0u};
        if (row <= DBATCH) {
            const float* src = (row == 0) ? A.in[I_CP] + c8 : A.in[I_CS] + (size_t)(row - 1) * D + c8;
            const f32x4 a = *(const GAS f32x4*)src, b = *(const GAS f32x4*)(src + 4);
            float v[8] = {a[0], a[1], a[2], a[3], b[0], b[1], b[2], b[3]};
#pragma unroll
            for (int j = 0; j < 8; ++j) v[j] = v[j] / (1.0f + __expf(-v[j]));
            o.x = pk2(v[0], v[1]); o.y = pk2(v[2], v[3]); o.z = pk2(v[4], v[5]); o.w = pk2(v[6], v[7]);
        }
        *(GAS v4u*)(cs + ((size_t)((c8 >> 5) * 9 + (row >> 4)) * 64 + ((c8 & 31) >> 3) * 16 + (row & 15)) * 8) = o;
    }
}
constexpr int MODI_SB = 2560, MODI_A_OFF = 8 * MODI_SB, MODI_A_BYTES = 9216;
__device__ __forceinline__ void mod_item256(Frame& F, const Args& A, int cg, int k0, int nsteps, float* dst, int ldd, int dcol0, const float* bias) {
    const int lane = F.lane, w = F.wave, n0 = 256 * cg + 32 * w, tid = F.tid;
    LAS unsigned char* sb = F.lds + w * MODI_SB;
    LAS unsigned char* la = F.lds + MODI_A_OFF;
    const bf16* CS = (const bf16*)(A.ws + WS_CSI);
    const int kp = lane >> 3, a8 = lane & 7, n4 = 4 * a8;
    const GAS char* Wb = (const GAS char*)(A.in[I_WADA] + (size_t)k0 * MODW + n0);
    const unsigned wlo = (unsigned)((2 * kp) * MODW + n4) * 4u;
    const GAS char* Cb = (const GAS char*)CS + (size_t)(k0 / 32) * 9216;
    const unsigned c1 = (unsigned)tid * 16u, c2 = (unsigned)(512 + (tid & 63)) * 16u;
    f32x4 acc[9][2];
#pragma unroll
    for (int mt = 0; mt < 9; ++mt)
#pragma unroll
        for (int j = 0; j < 2; ++j) acc[mt][j] = (f32x4){0.f, 0.f, 0.f, 0.f};
    f32x4 buf[4][4];
    v4u ar[2][2];
#define MODI_LOAD(b, s) do { _Pragma("unroll") for (int i = 0; i < 4; ++i) buf[b][i] = __builtin_nontemporal_load((const GAS f32x4*)(Wb + (size_t)(32 * (s) + 16 * (i >> 1) + (i & 1)) * (MODW * 4) + wlo)); } while (0)
#define MODI_ALOAD(r, s) do { const int s_ = (s) < nsteps ? (s) : nsteps - 1; ar[r][0] = *(const GAS v4u*)(Cb + (size_t)s_ * 9216 + c1); ar[r][1] = *(const GAS v4u*)(Cb + (size_t)s_ * 9216 + c2); } while (0)
#define MODI_AWRITE(r, s) do { *(LAS v4u*)(la + ((s) & 1) * MODI_A_BYTES + c1) = ar[r][0]; *(LAS v4u*)(la + ((s) & 1) * MODI_A_BYTES + c2) = ar[r][1]; } while (0)
    __syncthreads();
    MODI_ALOAD(0, 0); MODI_ALOAD(1, 1);
    MODI_LOAD(0, 0); MODI_LOAD(1, 1); MODI_LOAD(2, 2); MODI_LOAD(3, 3);
    MODI_AWRITE(0, 0);
    MODI_ALOAD(0, 2);
    __syncthreads();
#pragma unroll 1
    for (int s4 = 0; s4 < nsteps; s4 += 4) {
#pragma unroll
        for (int b = 0; b < 4; ++b) { const int s = s4 + b;
#pragma unroll
            for (int ip = 0; ip < 2; ++ip)
#pragma unroll
                for (int e = 0; e < 4; ++e) { const int n = n4 + e, k = 2 * kp + 16 * ip;
                    *(LAS unsigned*)(sb + n * 80 + (((k >> 3) ^ (a8 & 3)) * 16) + (k & 7) * 2) = pg8::cvt_pk_bf16(buf[b][2 * ip][e], buf[b][2 * ip + 1][e]); }
            asm volatile("" ::: "memory");
            { const int sn = (s + 4 < nsteps) ? s + 4 : nsteps - 1; MODI_LOAD(b, sn); }
            asm volatile("" ::: "memory");
            bf16x8 bfr[2];
#pragma unroll
            for (int j = 0; j < 2; ++j) { const int n = 16 * j + (lane & 15); bfr[j] = *(const LAS bf16x8*)(sb + n * 80 + (((lane >> 4) ^ ((n >> 2) & 3)) * 16)); }
#pragma unroll
            for (int mg = 0; mg < 3; ++mg) { bf16x8 af[3];
#pragma unroll
                for (int i = 0; i < 3; ++i) af[i] = *(const LAS bf16x8*)(la + (s & 1) * MODI_A_BYTES + (3 * mg + i) * 1024 + lane * 16);
#pragma unroll
                for (int i = 0; i < 3; ++i)
#pragma unroll
                    for (int j = 0; j < 2; ++j) acc[3 * mg + i][j] = __builtin_amdgcn_mfma_f32_16x16x32_bf16(af[i], bfr[j], acc[3 * mg + i][j], 0, 0, 0);
                asm volatile("" ::: "memory"); }
            MODI_AWRITE((b + 1) & 1, s + 1);
            asm volatile("" ::: "memory");
            MODI_ALOAD((b + 1) & 1, s + 3);
            __syncthreads();
        }
    }
#undef MODI_LOAD
#undef MODI_ALOAD
#undef MODI_AWRITE
    const int c0 = 32 * w + (lane & 15);
#pragma unroll
    for (int j = 0; j < 2; ++j) { const float bv = bias ? bias[256 * cg + c0 + 16 * j] : 0.f;
#pragma unroll
        for (int mt = 0; mt < 9; ++mt)
#pragma unroll
            for (int r = 0; r < 4; ++r) { const int row = 16 * mt + 4 * (lane >> 4) + r;
                if (row <= DBATCH) dst[(size_t)row * ldd + dcol0 + c0 + 16 * j] = acc[mt][j][r] + bv; } }
    LDS_WAIT();
}
__device__ __forceinline__ void mod_chunk_partials(Frame& F, const Args& A, int chunk, int rank, int nwg) {
    float* PART = (float*)(A.ws + WS_PART);
    for (int it = rank; it < 192; it += nwg) { const int cg = it >> 2, q = it & 3;
        mod_item256(F, A, 48 * chunk + cg, 1024 * q, 32, PART + (size_t)q * (DBATCH + 1) * 12288, 12288, 256 * cg, nullptr); }
}
__device__ __forceinline__ void mod_combine(Frame& F, const Args& A, int chunk) {
    const float* PART = (const float*)(A.ws + WS_PART); float* MOD = (float*)(A.ws + WS_MOD);
    const int gt = (F.vcu * NWAVES + F.wave) * 64 + F.lane, NGT = F.G * NWAVES * 64;
    constexpr int PS = (DBATCH + 1) * 12288;
    for (int i = gt; i < PS / 4; i += NGT) { const int r = (4 * i) / 12288, c = (4 * i) % 12288;
        const f32x4 s = (*(const GAS f32x4*)(PART + 4 * (size_t)i) + *(const GAS f32x4*)(PART + PS + 4 * (size_t)i)) + (*(const GAS f32x4*)(PART + 2 * (size_t)PS + 4 * (size_t)i) + *(const GAS f32x4*)(PART + 3 * (size_t)PS + 4 * (size_t)i));
        *(GAS f32x4*)(MOD + (size_t)r * MODW + 12288 * chunk + c) = s + *(const GAS f32x4*)(A.in[I_BADA] + 12288 * chunk + c); }
}

template <bool FP8OUT>
__device__ __forceinline__ void normmod_store(bf16* H, int m, int lane, int j, f32x4 h) {
    if constexpr (FP8OUT) { ((GAS unsigned*)((unsigned char*)H + (size_t)m * D) + lane)[64 * j] = pg8::cvt4_fp8(h.x * S_H, h.y * S_H, h.z * S_H, h.w * S_H); }
    else { v2u w; w.x = pg8::cvt_pk_bf16(h.x, h.y); w.y = pg8::cvt_pk_bf16(h.z, h.w); ((GAS v2u*)(H + (size_t)m * D) + lane)[64 * j] = w; }
}
template <bool XBF16> __device__ __forceinline__ f32x4 ldx4(const void* rowp, int q) {
    if constexpr (XBF16) { const v2u w = ((const GAS v2u*)rowp)[q]; return (f32x4){bf_lo(w.x), bf_hi(w.x), bf_lo(w.y), bf_hi(w.y)}; }
    else return ((const GAS f32x4*)rowp)[q];
}
template <bool XBF16> __device__ __forceinline__ const void* xrowp(const void* base, size_t r) { if constexpr (XBF16) return (const bf16*)base + r * D; else return (const float*)base + r * D; }
template <bool FP8OUT, bool XBF16>
__device__ __forceinline__ void normmod_phase(Frame& F, const void* xp, const void* xs, const float* g, const float* mod, int ish, int isc, bf16* H) {
    const int gw = F.vcu * NWAVES + F.wave, NGW = F.G * NWAVES, lane = F.lane;
    LAS f32x4* lgs = (LAS f32x4*)F.lds; LAS f32x4* lsh = (LAS f32x4*)(F.lds + D * 4);
    for (int i = F.tid; i < D / 4; i += NWAVES * 64) { const f32x4 gg = *((const GAS f32x4*)g + i), sc = *((const GAS f32x4*)(mod + (size_t)isc * D) + i);
        lgs[i] = gg * (sc + 1.0f); lsh[i] = *((const GAS f32x4*)(mod + (size_t)ish * D) + i); }
    __syncthreads();
    if (gw < SEQ) {
        f32x4 cur[16], nx[16];
#pragma unroll
        for (int j = 0; j < 16; ++j) cur[j] = ldx4<XBF16>(xrowp<XBF16>(xp, (size_t)gw), lane + 64 * j);
#pragma unroll 1
        for (int m = gw; m < SEQ; m += NGW) {
            asm volatile("" ::: "memory");
            const int mn = (m + NGW < SEQ) ? m + NGW : m;
#pragma unroll
            for (int j = 0; j < 16; ++j) nx[j] = ldx4<XBF16>(xrowp<XBF16>(xp, (size_t)mn), lane + 64 * j);
            float s = 0.f;
#pragma unroll
            for (int j = 0; j < 16; ++j) s += (cur[j].x * cur[j].x + cur[j].y * cur[j].y) + (cur[j].z * cur[j].z + cur[j].w * cur[j].w);
            const float rstd = 1.0f / sqrtf(wave_sum(s) * (1.f / D) + EPS);
#pragma unroll
            for (int j = 0; j < 16; ++j) normmod_store<FP8OUT>(H, m, lane, j, (cur[j] * rstd) * lgs[lane + 64 * j] + lsh[lane + 64 * j]);
#pragma unroll
            for (int j = 0; j < 16; ++j) cur[j] = nx[j];
        }
    }
    for (int m = SEQ + gw; m < M; m += NGW) {
        const float* mrow = mod + (size_t)(1 + ((m - SEQ) >> 3)) * MODW;
        const void* xr = xrowp<XBF16>(xs, (size_t)(m - SEQ));
        f32x4 v[16]; float s = 0.f;
#pragma unroll
        for (int j = 0; j < 16; ++j) { v[j] = ldx4<XBF16>(xr, lane + 64 * j); s += (v[j].x * v[j].x + v[j].y * v[j].y) + (v[j].z * v[j].z + v[j].w * v[j].w); }
        const float rstd = 1.0f / sqrtf(wave_sum(s) * (1.f / D) + EPS);
        const GAS f32x4* gr = (const GAS f32x4*)g + lane;
        const GAS f32x4* shr = (const GAS f32x4*)(mrow + (size_t)ish * D) + lane;
        const GAS f32x4* scr = (const GAS f32x4*)(mrow + (size_t)isc * D) + lane;
#pragma unroll
        for (int j = 0; j < 16; ++j) { const f32x4 gg = gr[64 * j], sh = shr[64 * j], sc = scr[64 * j];
            normmod_store<FP8OUT>(H, m, lane, j, (v[j] * rstd) * gg * (sc + 1.0f) + sh); }
    }
    __syncthreads();
}
__device__ __forceinline__ void final_norm_phase(Frame& F, const bf16* X1, const float* g, float* out) {
    const int gw = F.vcu * NWAVES + F.wave, NGW = F.G * NWAVES, lane = F.lane;
    LAS f32x4* lg = (LAS f32x4*)F.lds;
    for (int i = F.tid; i < D / 4; i += NWAVES * 64) lg[i] = *((const GAS f32x4*)g + i);
    __syncthreads();
    if (gw >= M) return;
    f32x4 cur[16], nx[16];
#pragma unroll
    for (int j = 0; j < 16; ++j) cur[j] = ldx4<true>(X1 + (size_t)gw * D, lane + 64 * j);
#pragma unroll 1
    for (int m = gw; m < M; m += NGW) {
        asm volatile("" ::: "memory");
        const int mn = (m + NGW < M) ? m + NGW : m;
#pragma unroll
        for (int j = 0; j < 16; ++j) nx[j] = ldx4<true>(X1 + (size_t)mn * D, lane + 64 * j);
        float s = 0.f;
#pragma unroll
        for (int j = 0; j < 16; ++j) s += (cur[j].x * cur[j].x + cur[j].y * cur[j].y) + (cur[j].z * cur[j].z + cur[j].w * cur[j].w);
        const float rstd = 1.0f / sqrtf(wave_sum(s) * (1.f / D) + EPS);
        GAS f32x4* o = (GAS f32x4*)(out + ((m < SEQ) ? O_YP + (size_t)m * D : O_YS + (size_t)(m - SEQ) * D)) + lane;
#pragma unroll
        for (int j = 0; j < 16; ++j) o[64 * j] = (cur[j] * rstd) * lg[lane + 64 * j];
#pragma unroll
        for (int j = 0; j < 16; ++j) cur[j] = nx[j];
    }
}

namespace att {
constexpr int KROW = 272, VROW = 528;
constexpr int K_OFF = 0, V_OFF = 256 * KROW, LUT_OFF = V_OFF + 128 * VROW, LUT_STRIDE = 132;
constexpr int ATT_LDS = LUT_OFF + 4 * LUT_STRIDE * 4;
static_assert(ATT_LDS <= LDSCTL_OFF, "attention LDS image below the control words");
constexpr float SCALE = 0.08838834764831845f;
__device__ __forceinline__ int t5_bucket(int n) {
    if (n < 16) return n;
    int b = 16;
    b += (n >= 19); b += (n >= 21); b += (n >= 24); b += (n >= 27); b += (n >= 31); b += (n >= 35); b += (n >= 40); b += (n >= 46);
    b += (n >= 52); b += (n >= 59); b += (n >= 67); b += (n >= 77); b += (n >= 87); b += (n >= 99); b += (n >= 113);
    return b;
}
__device__ __forceinline__ int vslot(int kidx) { return (kidx & ~15) | (8 * ((kidx >> 2) & 1) + 4 * ((kidx >> 3) & 1) + (kidx & 3)); }
__device__ __forceinline__ void fill_lut(LAS unsigned char* lds, const float* rel_bias, int hk, int tid) {
    LAS float* lut = (LAS float*)(lds + LUT_OFF);
    for (int i = tid; i < 4 * 129; i += NWAVES * 64) { const int g = i / 129, dist = i % 129; lut[g * LUT_STRIDE + dist] = rel_bias[t5_bucket(dist) * NHEAD + 4 * hk + g]; }
}
template <int NT>
__device__ __forceinline__ void attn_qtile(const LAS unsigned char* lds, int ktile0, const bf16x8 (&Q)[8], int r, int kmin, int kmax, int g, float sink, bf16* orow, int lane) {
    const int c = lane & 31, h = lane >> 5;
    f32x16 X[NT];
#pragma unroll
    for (int t = 0; t < NT; ++t) {
#pragma unroll
        for (int i = 0; i < 16; ++i) X[t][i] = 0.f;
#pragma unroll
        for (int ks = 0; ks < 8; ++ks) { const bf16x8 kf = *(const LAS bf16x8*)(lds + K_OFF + (32 * (ktile0 + t) + c) * KROW + (16 * ks + 8 * h) * 2);
            X[t] = __builtin_amdgcn_mfma_f32_32x32x16_bf16(kf, Q[ks], X[t], 0, 0, 0); }
    }
    const LAS float* lut = (const LAS float*)(lds + LUT_OFF) + g * LUT_STRIDE;
    float mx = sink;
#pragma unroll
    for (int t = 0; t < NT; ++t)
#pragma unroll
        for (int i = 0; i < 16; ++i) { const int kidx = 32 * (ktile0 + t) + (i & 3) + 8 * (i >> 2) + 4 * h; const int dist = 128 + r - kidx;
            const bool valid = (dist >= 0) && (dist <= 128) && (kidx >= kmin) && (kidx < kmax);
            const int di = dist < 0 ? 0 : (dist > 128 ? 128 : dist);
            float s = X[t][i] * SCALE + lut[di]; s = valid ? s : -1e30f; X[t][i] = s; mx = fmaxf(mx, s); }
    mx = fmaxf(mx, __shfl_xor(mx, 32));
    float sum = 0.f;
#pragma unroll
    for (int t = 0; t < NT; ++t)
#pragma unroll
        for (int i = 0; i < 16; ++i) { const float p = __expf(X[t][i] - mx); X[t][i] = p; sum += p; }
    sum += __shfl_xor(sum, 32);
    const float inv = 1.0f / (sum + __expf(sink - mx));
    f32x16 O[4];
#pragma unroll
    for (int dt = 0; dt < 4; ++dt)
#pragma unroll
        for (int i = 0; i < 16; ++i) O[dt][i] = 0.f;
#pragma unroll
    for (int t = 0; t < NT; ++t)
#pragma unroll
        for (int s = 0; s < 2; ++s) {
            v4u pw; pw.x = pg8::cvt_pk_bf16(X[t][8 * s + 0], X[t][8 * s + 1]); pw.y = pg8::cvt_pk_bf16(X[t][8 * s + 2], X[t][8 * s + 3]);
            pw.z = pg8::cvt_pk_bf16(X[t][8 * s + 4], X[t][8 * s + 5]); pw.w = pg8::cvt_pk_bf16(X[t][8 * s + 6], X[t][8 * s + 7]);
            const bf16x8 pf = __builtin_bit_cast(bf16x8, pw);
#pragma unroll
            for (int dt = 0; dt < 4; ++dt) { const bf16x8 vf = *(const LAS bf16x8*)(lds + V_OFF + (32 * dt + c) * VROW + (32 * (ktile0 + t) + 16 * s + 8 * h) * 2);
                O[dt] = __builtin_amdgcn_mfma_f32_32x32x16_bf16(vf, pf, O[dt], 0, 0, 0); }
        }
#pragma unroll
    for (int dt = 0; dt < 4; ++dt)
#pragma unroll
        for (int i = 0; i < 4; ++i) { v2u w; w.x = pk2(O[dt][4 * i + 0] * inv, O[dt][4 * i + 1] * inv); w.y = pk2(O[dt][4 * i + 2] * inv, O[dt][4 * i + 3] * inv);
            *(GAS v2u*)(orow + 32 * dt + 8 * i + 4 * h) = w; }
}
__device__ __forceinline__ void stage_kv(LAS unsigned char* lds, int kidx, int ch, v4u kq, v4u vq) {
    *(LAS v4u*)(lds + K_OFF + kidx * KROW + ch * 16) = kq;
    LAS unsigned short* vt = (LAS unsigned short*)(lds + V_OFF + (8 * ch) * VROW) + vslot(kidx);
    vt[0 * (VROW / 2)] = (unsigned short)(vq.x & 0xffffu); vt[1 * (VROW / 2)] = (unsigned short)(vq.x >> 16);
    vt[2 * (VROW / 2)] = (unsigned short)(vq.y & 0xffffu); vt[3 * (VROW / 2)] = (unsigned short)(vq.y >> 16);
    vt[4 * (VROW / 2)] = (unsigned short)(vq.z & 0xffffu); vt[5 * (VROW / 2)] = (unsigned short)(vq.z >> 16);
    vt[6 * (VROW / 2)] = (unsigned short)(vq.w & 0xffffu); vt[7 * (VROW / 2)] = (unsigned short)(vq.w >> 16);
}
__device__ __forceinline__ void store8_f32(float* dst, v4u q) {
    *(GAS f32x4*)dst = (f32x4){bf_lo(q.x), bf_hi(q.x), bf_lo(q.y), bf_hi(q.y)};
    *(GAS f32x4*)(dst + 4) = (f32x4){bf_lo(q.z), bf_hi(q.z), bf_lo(q.w), bf_hi(q.w)};
}
__device__ __forceinline__ void prompt_unit(Frame& F, const Args& A, int b, int hk) {
    const bf16* PROJ = (const bf16*)(A.ws + WS_PROJ); bf16* MIX = (bf16*)(A.ws + WS_MIX);
    LAS unsigned char* lds = F.lds;
    fill_lut(lds, A.in[I_RB], hk, F.tid);
    v4u kqa[8], vqa[8];
#pragma unroll
    for (int i = 0; i < 8; ++i) { const int cid = F.tid + 512 * i, kidx = cid >> 4, ch = cid & 15; const int row = 128 * (b - 1) + kidx, rowc = row < 0 ? 0 : row;
        const bf16* p = PROJ + (size_t)rowc * NPROJ + 128 * hk + 8 * ch; kqa[i] = *(const GAS v4u*)(p + C_K); vqa[i] = *(const GAS v4u*)(p + C_V); }
#pragma unroll
    for (int i = 0; i < 8; ++i) { const int cid = F.tid + 512 * i, kidx = cid >> 4, ch = cid & 15; const int row = 128 * (b - 1) + kidx;
        v4u kq = kqa[i], vq = vqa[i];
        if (row < 0) { kq = (v4u){0u, 0u, 0u, 0u}; vq = (v4u){0u, 0u, 0u, 0u}; }
        stage_kv(lds, kidx, ch, kq, vq);
        if (b == SEQ / 128 - 1 && kidx >= 128) {
            store8_f32(A.out + O_KWP + (size_t)(kidx - 128) * 512 + 128 * hk + 8 * ch, kq);
            store8_f32(A.out + O_VWP + (size_t)(kidx - 128) * 512 + 128 * hk + 8 * ch, vq); }
    }
    __syncthreads();
    const int g = F.wave >> 1, half = F.wave & 1, c = F.lane & 31, h = F.lane >> 5, head = 4 * hk + g;
    const float sink = A.in[I_SINK][head];
#pragma unroll 1
    for (int qt = 0; qt < 2; ++qt) { const int r = 64 * half + 32 * qt + c, row = 128 * b + r;
        bf16x8 Q[8];
#pragma unroll
        for (int ks = 0; ks < 8; ++ks) Q[ks] = *(const GAS bf16x8*)(PROJ + (size_t)row * NPROJ + 128 * head + 16 * ks + 8 * h);
        attn_qtile<5>(lds, 2 * half + qt, Q, r, b == 0 ? 128 : 0, 256, g, sink, MIX + (size_t)row * D + 128 * head, F.lane);
    }
    __syncthreads();
}
__device__ __forceinline__ void sample_unit(Frame& F, const Args& A, int s, int hk) {
    const bf16* PROJ = (const bf16*)(A.ws + WS_PROJ); bf16* MIX = (bf16*)(A.ws + WS_MIX);
    LAS unsigned char* lds = F.lds;
    fill_lut(lds, A.in[I_RB], hk, F.tid);
    {
        const int ch = F.tid & 15, kb0 = F.tid >> 4;
        f32x4 ck[4][2], cv[4][2];
#pragma unroll
        for (int i = 0; i < 4; ++i) { const size_t off = (((size_t)s * 128 + kb0 + 32 * i) * 4 + hk) * 128 + 8 * ch;
            ck[i][0] = *(const GAS f32x4*)(A.in[I_CK] + off); ck[i][1] = *(const GAS f32x4*)(A.in[I_CK] + off + 4);
            cv[i][0] = *(const GAS f32x4*)(A.in[I_CV] + off); cv[i][1] = *(const GAS f32x4*)(A.in[I_CV] + off + 4); }
        const int kn = 128 + kb0, knc = kn < 136 ? kn : 135;
        const bf16* pn = PROJ + (size_t)(SEQ + 8 * s + (knc - 128)) * NPROJ + 128 * hk + 8 * ch;
        v4u nkq = *(const GAS v4u*)(pn + C_K), nvq = *(const GAS v4u*)(pn + C_V);
#pragma unroll
        for (int i = 0; i < 4; ++i) { const int kidx = kb0 + 32 * i; const f32x4 k0 = ck[i][0], k1 = ck[i][1], v0 = cv[i][0], v1 = cv[i][1];
            const v4u kq = (v4u){pg8::cvt_pk_bf16(k0[0], k0[1]), pg8::cvt_pk_bf16(k0[2], k0[3]), pg8::cvt_pk_bf16(k1[0], k1[1]), pg8::cvt_pk_bf16(k1[2], k1[3])};
            const v4u vq = (v4u){pg8::cvt_pk_bf16(v0[0], v0[1]), pg8::cvt_pk_bf16(v0[2], v0[3]), pg8::cvt_pk_bf16(v1[0], v1[1]), pg8::cvt_pk_bf16(v1[2], v1[3])};
            if (kidx >= 8) {
                float* ko = A.out + O_KWS + (((size_t)s * 128 + (kidx - 8)) * 4 + hk) * 128 + 8 * ch; *(GAS f32x4*)ko = k0; *(GAS f32x4*)(ko + 4) = k1;
                float* vo = A.out + O_VWS + (((size_t)s * 128 + (kidx - 8)) * 4 + hk) * 128 + 8 * ch; *(GAS f32x4*)vo = v0; *(GAS f32x4*)(vo + 4) = v1; }
            stage_kv(lds, kidx, ch, kq, vq); }
        if (kn < 136) {
            store8_f32(A.out + O_KWS + (((size_t)s * 128 + (kn - 8)) * 4 + hk) * 128 + 8 * ch, nkq);
            store8_f32(A.out + O_VWS + (((size_t)s * 128 + (kn - 8)) * 4 + hk) * 128 + 8 * ch, nvq);
        } else { nkq = (v4u){0u, 0u, 0u, 0u}; nvq = (v4u){0u, 0u, 0u, 0u}; }
        stage_kv(lds, kn, ch, nkq, nvq);
    }
    __syncthreads();
    if (F.wave == 0) {
        const int c = F.lane & 31, h = F.lane >> 5, g = c >> 3, t = c & 7, head = 4 * hk + g, row = SEQ + 8 * s + t;
        const float sink = A.in[I_SINK][head];
        bf16x8 Q[8];
#pragma unroll
        for (int ks = 0; ks < 8; ++ks) Q[ks] = *(const GAS bf16x8*)(PROJ + (size_t)row * NPROJ + 128 * head + 16 * ks + 8 * h);
        attn_qtile<5>(lds, 0, Q, t, 0, 136, g, sink, MIX + (size_t)row * D + 128 * head, F.lane);
    }
    __syncthreads();
}
__device__ __forceinline__ f32x4 ld4bf(const bf16* p) { const v2u q = *(const GAS v2u*)p; return (f32x4){bf_lo(q.x), bf_hi(q.x), bf_lo(q.y), bf_hi(q.y)}; }
__device__ __forceinline__ void conv_item(Frame& F, const Args& A, int item) {
    const bf16* PROJ = (const bf16*)(A.ws + WS_PROJ); bf16* MIX = (bf16*)(A.ws + WS_MIX);
    const int sl = item >> 3, r0 = 8 * sl, c0 = 256 * (item & 7) + 4 * F.lane;
    const f32x4 w0 = *(const GAS f32x4*)(A.in[I_CW] + c0), w1 = *(const GAS f32x4*)(A.in[I_CW] + 2048 + c0), w2 = *(const GAS f32x4*)(A.in[I_CW] + 4096 + c0);
#define load4(row, col) ld4bf(PROJ + (size_t)(row) * NPROJ + (col) + c0)
    f32x4 u[10], gb[8];
    if (r0 >= SEQ) { const int s = (r0 - SEQ) >> 3;
        u[0] = *(const GAS f32x4*)(A.in[I_SC] + ((size_t)s * 2 + 0) * 2048 + c0); u[1] = *(const GAS f32x4*)(A.in[I_SC] + ((size_t)s * 2 + 1) * 2048 + c0); }
    else if (r0 == 0) { u[0] = (f32x4){0.f, 0.f, 0.f, 0.f}; u[1] = u[0]; }
    else { u[0] = load4(r0 - 2, C_GC) * load4(r0 - 2, C_HC); u[1] = load4(r0 - 1, C_GC) * load4(r0 - 1, C_HC); }
#pragma unroll
    for (int i = 0; i < 8; ++i) { u[2 + i] = load4(r0 + i, C_GC) * load4(r0 + i, C_HC); gb[i] = load4(r0 + i, C_GB); }
#pragma unroll
    for (int i = 0; i < 8; ++i) { const int row = r0 + i;
        const f32x4 y = gb[i] * (w0 * u[i] + w1 * u[i + 1] + w2 * u[i + 2]);
        v2u w; w.x = pg8::cvt_pk_bf16(y.x, y.y); w.y = pg8::cvt_pk_bf16(y.z, y.w); *(GAS v2u*)(MIX + (size_t)row * D + 2048 + c0) = w;
        if (i >= 6) {
            if (r0 == SEQ - 8) *(GAS f32x4*)(A.out + O_CP + (size_t)(i - 6) * 2048 + c0) = u[2 + i];
            if (r0 >= SEQ) *(GAS f32x4*)(A.out + O_CS + ((size_t)((r0 - SEQ) >> 3) * 2 + (i - 6)) * 2048 + c0) = u[2 + i]; } }
#undef load4
}
__device__ __forceinline__ void mixer_phase(Frame& F, const Args& A) {
#ifndef PROBE_P7
#define PROBE_P7 0
#endif
    for (int u = F.vcu; u < 256 * (PROBE_P7 == 1 ? 2 : 1); u += F.G) prompt_unit(F, A, (u & 255) >> 2, u & 3);
    for (int u = F.vcu; u < 512 * (PROBE_P7 == 2 ? 2 : 1); u += F.G) sample_unit(F, A, (u & 511) >> 2, u & 3);
    for (int u = F.vcu * NWAVES + F.wave; u < (M / 8) * 8 * (PROBE_P7 == 3 ? 2 : 1); u += F.G * NWAVES) conv_item(F, A, u % ((M / 8) * 8));
}
}

constexpr int N_PHASES = 13;
__global__ void __launch_bounds__(NWAVES * 64, 2) mk_fwd(Args args) {
    extern __shared__ __attribute__((aligned(16))) unsigned char lds[];
    Frame F;
    F.lds = (LAS unsigned char*)lds;
    F.MISC = (volatile LAS unsigned*)(F.lds + MISC_OFF);
    F.tid = threadIdx.x; F.lane = F.tid & 63; F.wave = __builtin_amdgcn_readfirstlane(F.tid >> 6);
    F.G = gridDim.x; { const int bx = blockIdx.x; F.vcu = (F.G % 8 == 0) ? (bx % 8) * (F.G / 8) + bx / 8 : bx; }
    unsigned char* ws = args.ws;
    F.ctl = (gu32*)(ws + WS_CTL);
    for (int u = F.tid; u < (LDS_BYTES - LDSCTL_OFF) / 4; u += NWAVES * 64) ((LAS unsigned*)(F.lds + LDSCTL_OFF))[u] = 0u;
    __syncthreads();
    XcdBarrier bar = xcd_barrier_post((unsigned*)(F.ctl + CW_BAR), F.MISC + 8);
    const int lo = args.ph_lo, hi = args.ph_hi;
#define IN(k) (lo <= (k) && (k) < hi)
#ifndef PROBE_PHASE
#define PROBE_PHASE -1
#endif
#define REPS(k) ((PROBE_PHASE == (k)) ? 2 : 1)
#define SEAM(k) do { if (IN(k) && IN((k) + 1)) xcd_barrier(bar); } while (0)
    bf16* W13A = (bf16*)(ws + WS_W13A); bf16* W2A = (bf16*)(ws + WS_W2A); bf16* WINT = (bf16*)(ws + WS_WIN); bf16* WOUT = (bf16*)(ws + WS_WOUT);
    bf16* W13B = (bf16*)(ws + WS_W13B); bf16* W2B = (bf16*)(ws + WS_W2B); bf16* WADA = (bf16*)(ws + WS_WADA); bf16* CSI = (bf16*)(ws + WS_CSI);
    float* MOD = (float*)(ws + WS_MOD); float* X1F = (float*)(ws + WS_X1);     bf16* X1 = (bf16*)(ws + WS_WADA);     bf16* H = (bf16*)(ws + WS_H); bf16* T = (bf16*)(ws + WS_T);
    bf16* PROJ = (bf16*)(ws + WS_PROJ); bf16* MIX = (bf16*)(ws + WS_MIX);
    const int cb = (int)blockIdx.x;

    if (IN(0)) {
#pragma unroll
        for (int rep = 0; rep < REPS(0); ++rep) { if (rep) xcd_barrier(bar);  csilu_phase(F, args); { const int rank = F.vcu * NWAVES + F.wave, nw = F.G * NWAVES; conv_job<JOB_W1A>(F, args, rank, nw); conv_job<JOB_W3A>(F, args, rank, nw); conv_job<JOB_WIN>(F, args, rank, nw); }  } } SEAM(0);
    if (IN(1)) {
#pragma unroll
        for (int rep = 0; rep < REPS(1); ++rep) { if (rep) xcd_barrier(bar); mod_chunk_partials(F, args, 0, F.vcu, F.G); } } SEAM(1);
    if (IN(2)) {
#pragma unroll
        for (int rep = 0; rep < REPS(2); ++rep) { if (rep) xcd_barrier(bar);  mod_combine(F, args, 0); xcd_barrier(bar); normmod_phase<true, false>(F, args.in[I_XP], args.in[I_XS], args.in[I_G1], MOD, 0, 1, H);  } } SEAM(2);
    if (IN(3)) {
#pragma unroll
        for (int rep = 0; rep < REPS(3); ++rep) { if (rep) xcd_barrier(bar);  pg8::Gemm g{H, W13A, M, 2 * FF, D / 2}; pg8::StaticOrder S; S.init(M, 2 * FF, F.G, cb);
        pg8::EpiSwiGLU8 E{(unsigned char*)T, FF, 1.0f / (S_H * S_W13), S_T};
        #if UP_CUT
#pragma unroll 1
        for (int sb = 0; sb < S.nwg; sb += UP_CUT) { if (sb) xcd_barrier(bar); S.sub(sb, (sb + 2 * UP_CUT > S.nwg) ? S.nwg : sb + UP_CUT);
            pg8::gemm_phase<pg8::EpiSwiGLU8, pg8::StaticOrder, PG8_ALIGN, PG8_SP2, true>(F.lds + RING_OFF, g, S, E); if (sb + 2 * UP_CUT > S.nwg) break; }
#else
        pg8::gemm_phase<pg8::EpiSwiGLU8, pg8::StaticOrder, PG8_ALIGN, PG8_SP2, true>(F.lds + RING_OFF, g, S, E);
#endif
#if PROBE_GEMM
        { xcd_barrier(bar); pg8::DegenOrder S2; S2.init(M, 2 * FF, F.G, cb); pg8::EpiNull E2{(float*)(ws + WS_PART)};
          pg8::gemm_phase<pg8::EpiNull, pg8::DegenOrder, PG8_ALIGN, PG8_SP2, true, PROBE_GEMM - 1>(F.lds + RING_OFF, g, S2, E2); xcd_barrier(bar); }
#endif
        if (rep == 0) { const int left = ((M / 256) * (2 * FF / 256)) % F.G;
            if (cb >= left) { const int rank = (cb - left) * NWAVES + F.wave, nw = (F.G - left) * NWAVES; conv_job<JOB_W2A>(F, args, rank, nw); } } } } SEAM(3);
    if (IN(4)) {
#pragma unroll
        for (int rep = 0; rep < REPS(4); ++rep) { if (rep) xcd_barrier(bar);  pg8::Gemm g{T, W2A, M, D, FF / 2}; pg8::StaticOrder S; S.init(M, D, F.G, cb);
        pg8::EpiResid<true, false, false> E{args.in[I_XP], args.in[I_XS], X1F, MOD, D, MODW, 2 * D, SEQ, 0.5f / (S_T * S_W2)};
        pg8::gemm_phase<pg8::EpiResid<true, false, false>, pg8::StaticOrder, PG8_ALIGN, PG8_SP2, true>(F.lds + RING_OFF, g, S, E);
        if (rep == 0) { const int left = ((M / 256) * (D / 256)) % F.G;
            if (cb >= left) { const int ir = cb - left, ni = F.G - left;
                mod_chunk_partials(F, args, 1, ir, ni); __syncthreads(); {     const int rank = ir * NWAVES + F.wave, nw = ni * NWAVES; conv_job<JOB_W1B>(F, args, rank, nw); } } } } } SEAM(4);
    if (IN(5)) { mod_combine(F, args, 1); xcd_barrier(bar); normmod_phase<false, false>(F, X1F, X1F + (size_t)SEQ * D, args.in[I_GM], MOD, 3, 4, H); } SEAM(5);
    if (IN(6)) {
#pragma unroll
        for (int rep = 0; rep < REPS(6); ++rep) { if (rep) xcd_barrier(bar);  pg8::Gemm g{H, WINT, M, NPROJ, D}; pg8::StaticOrder S; S.init(M, NPROJ, F.G, cb);
        pg8::EpiBf16 E{PROJ, NPROJ};
        pg8::gemm_phase<pg8::EpiBf16, pg8::StaticOrder, PG8_ALIGN, PG8_SP2>(F.lds + RING_OFF, g, S, E);
        if (rep == 0) { const int left = ((M / 256) * (NPROJ / 256)) % F.G;
            if (cb >= left) { const int ir = cb - left, ni = F.G - left;
                mod_chunk_partials(F, args, 2, ir, ni); __syncthreads(); { const int rank = ir * NWAVES + F.wave, nw = ni * NWAVES; conv_job<JOB_WOUT>(F, args, rank, nw); conv_job<JOB_W3B>(F, args, rank, nw); } } } } } SEAM(6);
    if (IN(7)) {
#pragma unroll
        for (int rep = 0; rep < REPS(7); ++rep) { if (rep) xcd_barrier(bar);  att::mixer_phase(F, args);  } } SEAM(7);
    if (IN(8)) { pg8::Gemm g{MIX, WOUT, M, D, D}; pg8::StaticOrder S; S.init(M, D, F.G, cb);
        pg8::EpiResid<true, false, true> E{X1F, X1F + (size_t)SEQ * D, X1, MOD, D, MODW, 5 * D, SEQ, 1.0f};
        pg8::gemm_phase<pg8::EpiResid<true, false, true>, pg8::StaticOrder, PG8_ALIGN, PG8_SP2>(F.lds + RING_OFF, g, S, E);
        { const int left = ((M / 256) * (D / 256)) % F.G;
            if (cb >= left) { const int rank = (cb - left) * NWAVES + F.wave, nw = (F.G - left) * NWAVES; conv_job<JOB_W2B>(F, args, rank, nw); } } } SEAM(8);
    if (IN(9)) { mod_combine(F, args, 2); xcd_barrier(bar); normmod_phase<true, true>(F, X1, X1 + (size_t)SEQ * D, args.in[I_G2], MOD, 6, 7, H); } SEAM(9);
    if (IN(10)) { pg8::Gemm g{H, W13B, M, 2 * FF, D / 2}; pg8::ListOrder S; { pg8::SkOrder K; K.init(M, 2 * FF, D / 2, F.G, cb); S.list = (const LAS int*)(F.lds + SKLIST_OFF); S.n = pg8::sk_build_list(K, (LAS int*)(F.lds + SKLIST_OFF)); }
        S.slots = (float*)(ws + WS_SKS); S.counters = (unsigned*)(F.ctl + CW_SK + 0 * CW_SK_STRIDE);
        pg8::EpiSwiGLU8 E{(unsigned char*)T, FF, 1.0f / (S_H * S_W13), S_T};
        pg8::gemm_phase<pg8::EpiSwiGLU8, pg8::ListOrder, PG8_ALIGN, PG8_SP2, true>(F.lds + RING_OFF, g, S, E); } SEAM(10);
    if (IN(11)) { pg8::Gemm g{T, W2B, M, D, FF / 2}; pg8::ListOrder S; { pg8::SkOrder K; K.init(M, D, FF / 2, F.G, cb); S.list = (const LAS int*)(F.lds + SKLIST_OFF); S.n = pg8::sk_build_list(K, (LAS int*)(F.lds + SKLIST_OFF)); }
        S.slots = (float*)(ws + WS_SKS2); S.counters = (unsigned*)(F.ctl + CW_SK + 1 * CW_SK_STRIDE);
        pg8::EpiResid<false, true> E{X1, X1 + (size_t)SEQ * D, X1, MOD, D, MODW, 8 * D, SEQ, 0.5f / (S_T * S_W2)};
        pg8::gemm_phase<pg8::EpiResid<false, true>, pg8::ListOrder, PG8_ALIGN, PG8_SP2, true>(F.lds + RING_OFF, g, S, E); } SEAM(11);
    if (IN(12)) { final_norm_phase(F, X1, args.in[I_GF], args.out); }
#undef IN
#undef SEAM
}

extern "C" void kernel_launch(void* const* d_in, const int* in_sizes, int n_in, void* d_out, int out_size, void* d_ws, size_t ws_size, hipStream_t stream) {
    static int grid = 0;
    if (grid == 0) {
        if (n_in != N_IN || (size_t)out_size != O_END || ws_size < WS_END) { fprintf(stderr, "kernel_launch: unexpected shapes: n_in %d out %d ws %zu (need %zu)\n", n_in, out_size, ws_size, (size_t)WS_END); grid = -1; return; }
        int dev = 0, cus = 0, per_cu = 0;
        if (hipGetDevice(&dev) != hipSuccess || hipDeviceGetAttribute(&cus, hipDeviceAttributeMultiprocessorCount, dev) != hipSuccess) { grid = -1; return; }
        if (hipFuncSetAttribute((const void*)mk_fwd, hipFuncAttributeMaxDynamicSharedMemorySize, LDS_BYTES) != hipSuccess) { fprintf(stderr, "kernel_launch: hipFuncSetAttribute failed\n"); grid = -1; return; }
        if (hipOccupancyMaxActiveBlocksPerMultiprocessor(&per_cu, (const void*)mk_fwd, NWAVES * 64, LDS_BYTES) != hipSuccess || per_cu < 1) { fprintf(stderr, "kernel_launch: occupancy query says %d\n", per_cu); }
        (void)hipGetLastError();
        grid = cus;
    }
    if (grid < 0) return;
    if (hipMemsetAsync((char*)d_ws + WS_CTL, 0, CTL_ZERO_BYTES, stream) != hipSuccess) return;
    Args a{};
    for (int i = 0; i < N_IN; ++i) a.in[i] = (const float*)d_in[i];
    a.out = (float*)d_out; a.ws = (unsigned char*)d_ws;
#if MK_PER_PHASE
    for (int p = 0; p < N_PHASES; ++p) { a.ph_lo = p; a.ph_hi = p + 1; hipLaunchKernelGGL(mk_fwd, dim3(grid), dim3(NWAVES * 64), LDS_BYTES, stream, a); }
#else
    a.ph_lo = 0; a.ph_hi = N_PHASES;
    hipLaunchKernelGGL(mk_fwd, dim3(grid), dim3(NWAVES * 64), LDS_BYTES, stream, a);
#endif
    const hipError_t le = hipPeekAtLastError();
    if (le != hipSuccess) fprintf(stderr, "kernel_launch: launch failed: %s\n", hipGetErrorName(le));
}
```

```cpp
#include <hip/hip_runtime.h>
#include <cstdio>
#include <cstdint>
#ifndef PG8_LOADPRIO
#define PG8_LOADPRIO 0
#endif
namespace pg8 {
#define PG8_LAS __attribute__((address_space(3)))
typedef unsigned short bf16_t;
typedef short bf16x8 __attribute__((ext_vector_type(8)));
typedef float f32x4 __attribute__((ext_vector_type(4)));
typedef unsigned u32x4 __attribute__((ext_vector_type(4)));
typedef unsigned u32x2 __attribute__((ext_vector_type(2)));
typedef int i32x4 __attribute__((ext_vector_type(4)));
typedef int i32x8 __attribute__((ext_vector_type(8)));
__device__ __forceinline__ i32x8 cat8(bf16x8 lo, bf16x8 hi) { return __builtin_shufflevector(__builtin_bit_cast(i32x4, lo), __builtin_bit_cast(i32x4, hi), 0, 1, 2, 3, 4, 5, 6, 7); }
__device__ __forceinline__ unsigned cvt4_fp8(float a, float b, float c, float d) {
    a = __builtin_fminf(__builtin_fmaxf(a, -448.f), 448.f); b = __builtin_fminf(__builtin_fmaxf(b, -448.f), 448.f);
    c = __builtin_fminf(__builtin_fmaxf(c, -448.f), 448.f); d = __builtin_fminf(__builtin_fmaxf(d, -448.f), 448.f);
    int w = 0; w = __builtin_amdgcn_cvt_pk_fp8_f32(a, b, w, false); w = __builtin_amdgcn_cvt_pk_fp8_f32(c, d, w, true); return (unsigned)w; }
constexpr int BM = 256, BK = 64, HALF = 128, HTB = HALF * BK * 2  , STAGE_BYTES = 8 * HTB, NXCD = 8, WGM = 8;

__host__ __device__ __forceinline__ int lds_byte(int r, int c) { const int st = (r >> 4) * 2 + (c >> 5), rr = r & 15, cc = c & 31, ob = rr * 64 + cc * 2; return st * 1024 + (ob ^ (((ob >> 9) & 1) << 5)); }
__host__ __device__ __forceinline__ void stage_rc(int b, int& R, int& C) { const int st = b / 1024, sb = b % 1024, swz = sb ^ (((sb >> 9) & 1) << 5); R = (st >> 1) * 16 + swz / 64; C = (st & 1) * 32 + (swz % 64) / 2; }
__host__ __device__ __forceinline__ int perm32(int rho) { const int n = rho >> 4, i = rho & 15; return 8 * (i >> 2) + 4 * n + (i & 3); }

struct Unit { int pm, pn, kb, ke, kind, slot; };
struct Gemm { const bf16_t* A; const bf16_t* Bt; int M, N, K; };

struct StaticOrder {
    static constexpr bool SK = false;
    int nM, nN, nwg, G, c, base, lim;
    __host__ __device__ void init(int M, int N, int G_, int c_) { nM = M / BM; nN = N / BM; nwg = nM * nN; G = G_; c = c_; base = 0; lim = nwg; }
    __host__ __device__ void sub(int b, int l) { base = b; lim = l < nwg ? l : nwg; }
    __host__ __device__ bool next(int i, Unit& u) const {
        const long L = (long)base + (long)i * G + c; if (L >= lim) return false;
        int wgid = (int)L; { const int q = nwg / NXCD, r = nwg % NXCD, xcd = wgid % NXCD, off = wgid / NXCD; wgid = (xcd < r ? xcd * (q + 1) : r * (q + 1) + (xcd - r) * q) + off; }
        const int nig = WGM * nN, gid = wgid / nig, fm = gid * WGM, gsz = (nM - fm) < WGM ? (nM - fm) : WGM;
        u.pm = fm + ((wgid % nig) % gsz); u.pn = (wgid % nig) / gsz; return true;
    }
    __device__ __forceinline__ void a_ready(const Unit&) const {}
    __device__ __forceinline__ void done(const Unit&) const {}
};

struct DegenOrder {
    static constexpr bool SK = false;
    int nwg, G, c;
    __device__ __forceinline__ void init(int M, int N, int G_, int c_) { nwg = (M / BM) * (N / BM); G = G_; c = c_; }
    __device__ __forceinline__ bool next(int i, Unit& u) const { if ((long)i * G + c >= nwg) return false; u.pm = 0; u.pn = 0; return true; }
    __device__ __forceinline__ void a_ready(const Unit&) const {}
    __device__ __forceinline__ void done(const Unit&) const {}
};
struct SkOrder {
    int nM, nN, nwg, G, c, Rs, cnt8, qq, nt, np, q, ufirst, ulast, nsk; long s, e;
    __device__ __forceinline__ void init(int M, int N, int Kbf, int G_, int c_) {
        nM = M / BM; nN = N / BM; nwg = nM * nN; G = G_; c = c_; nt = Kbf / BK; np = nt / 2;
        if (G != 256 || (nwg % 8) != 0 || nwg < 2 * G) { Rs = (nwg + G - 1) / G; nsk = 0; qq = nwg / 8; cnt8 = 0; q = 0; s = e = 0; ufirst = ulast = 0; return; }
        Rs = nwg / G - 1; const int usk = nwg - Rs * G; cnt8 = usk / 8; qq = nwg / 8; q = (c % 8) * 32 + c / 8;
        const long P = (long)usk * np; s = (long)q * P / G; e = (long)(q + 1) * P / G;
        ufirst = (int)(s / np); ulast = (int)((e - 1) / np); nsk = ulast - ufirst + 1;
    }
    __device__ __forceinline__ void tile_of(int wgid, Unit& u) const { const int nig = WGM * nN, gid = wgid / nig, fm = gid * WGM, gsz = (nM - fm) < WGM ? (nM - fm) : WGM; u.pm = fm + ((wgid % nig) % gsz); u.pn = (wgid % nig) / gsz; }
    __device__ __forceinline__ bool next(int i, Unit& u) const {
        if (i < Rs) { const long L = (long)i * G + c; if (L >= nwg) return false;
            int wgid = (int)L; { const int qv = nwg / NXCD, r = nwg % NXCD, xcd = wgid % NXCD, off = wgid / NXCD; wgid = (xcd < r ? xcd * (qv + 1) : r * (qv + 1) + (xcd - r) * qv) + off; }
            tile_of(wgid, u); u.kb = 0; u.ke = nt; u.kind = 0; u.slot = 0; return true; }
        const int j = i - Rs; if (j >= nsk) return false;
        const int un = ufirst + j; tile_of((un / cnt8) * qq + 32 * Rs + (un % cnt8), u);
        u.kb = (j == 0) ? 2 * (int)(s - (long)ufirst * np) : 0; u.ke = (un == ulast) ? 2 * (int)(e - (long)ulast * np) : nt;
        u.kind = (u.kb > 0) ? 1 : ((u.ke < nt) ? 2 : 0); u.slot = (u.kind == 1) ? q : q + 1; return true;
    }
    __device__ __forceinline__ int count() const { return Rs + nsk; }
};

struct ListOrder {
    static constexpr bool SK = true;
    const PG8_LAS int* list; int n;
    float* slots; unsigned* counters;
    __device__ __forceinline__ bool next(int i, Unit& u) const {
        if (i >= n) return false; const PG8_LAS int* p = list + 8 * i;
        u.pm = __builtin_amdgcn_readfirstlane(p[0]); u.pn = __builtin_amdgcn_readfirstlane(p[1]); u.kb = __builtin_amdgcn_readfirstlane(p[2]);
        u.ke = __builtin_amdgcn_readfirstlane(p[3]); u.kind = __builtin_amdgcn_readfirstlane(p[4]); u.slot = __builtin_amdgcn_readfirstlane(p[5]); return true;
    }
    __device__ __forceinline__ void a_ready(const Unit&) const {}
    __device__ __forceinline__ void done(const Unit&) const {}
    __device__ __forceinline__ void store_partial(const f32x4 (&acc)[2][2][4][2], const Unit& u, int tid) const {
        const __amdgpu_buffer_rsrc_t rs = __builtin_amdgcn_make_buffer_rsrc((void*)(slots + (size_t)u.slot * 65536), (short)0, 262144, 0x00020000);
#pragma unroll
        for (int a = 0; a < 2; ++a)
#pragma unroll
            for (int b = 0; b < 2; ++b)
#pragma unroll
                for (int m = 0; m < 4; ++m)
#pragma unroll
                    for (int n = 0; n < 2; ++n) __builtin_amdgcn_raw_buffer_store_b128(__builtin_bit_cast(u32x4, acc[a][b][m][n]), rs, ((((a * 2 + b) * 4 + m) * 2 + n) * 512 + tid) * 16, 0, 16);
        asm volatile("s_waitcnt vmcnt(0)" ::: "memory");
        if ((tid & 63) == 0) __hip_atomic_fetch_add(counters + 64 * u.slot, 1u, __ATOMIC_RELAXED, __HIP_MEMORY_SCOPE_AGENT);
    }
    __device__ __forceinline__ void add_partial(f32x4 (&acc)[2][2][4][2], const Unit& u, int tid, int wid) const {
        if (wid == 0) {
            unsigned spins = 0;
            while ((unsigned)__builtin_amdgcn_readfirstlane(__hip_atomic_load(counters + 64 * u.slot, __ATOMIC_RELAXED, __HIP_MEMORY_SCOPE_AGENT)) < 8u) { __builtin_amdgcn_s_sleep(2); if (++spins > (1u << 22)) break; }
            __builtin_amdgcn_fence(__ATOMIC_ACQUIRE, "agent");
            asm volatile("s_waitcnt vmcnt(0)" ::: "memory");
        }
        asm volatile("" ::: "memory"); __builtin_amdgcn_s_barrier(); asm volatile("" ::: "memory");
        const float* sp = slots + (size_t)u.slot * 65536;
#pragma unroll
        for (int a = 0; a < 2; ++a)
#pragma unroll
            for (int b = 0; b < 2; ++b)
#pragma unroll
                for (int m = 0; m < 4; ++m)
                {
#pragma unroll
                  for (int n = 0; n < 2; ++n) acc[a][b][m][n] += *(const f32x4*)(sp + ((size_t)((((a * 2 + b) * 4 + m) * 2 + n) * 512 + tid)) * 4);
                  if (m & 1) asm volatile("" : "+v"(acc[a][b][m - 1][0]), "+v"(acc[a][b][m - 1][1]), "+v"(acc[a][b][m][0]), "+v"(acc[a][b][m][1]) :: "memory"); }
    }
};
__device__ __forceinline__ int sk_build_list(const SkOrder& S, PG8_LAS int* list) {
    const int n = S.count();
    if ((int)threadIdx.x < n && threadIdx.x < 32) { Unit u; S.next((int)threadIdx.x, u); PG8_LAS int* p = list + 8 * threadIdx.x; p[0] = u.pm; p[1] = u.pn; p[2] = u.kb; p[3] = u.ke; p[4] = u.kind; p[5] = u.slot; }
    __syncthreads();
    return n < 32 ? n : 32;
}

__device__ __forceinline__ unsigned cvt_pk_bf16(float lo, float hi) { unsigned r; asm volatile("v_cvt_pk_bf16_f32 %0, %1, %2" : "=v"(r) : "v"(lo), "v"(hi)); return r; }
typedef float f32x2 __attribute__((ext_vector_type(2)));

struct EpiNull {
    static constexpr bool PERM = true, AFTER_DRAIN = false;
    float* sink;
    __device__ __forceinline__ void operator()(const f32x4 (&acc)[2][2][4][2], const Unit& u, int wr, int wc, int fr, int fq) const {
        f32x4 s = acc[0][0][0][0];
#pragma unroll
        for (int a = 0; a < 2; ++a)
#pragma unroll
            for (int b = 0; b < 2; ++b)
#pragma unroll
                for (int m = 0; m < 4; ++m)
#pragma unroll
                    for (int n = 0; n < 2; ++n) s += acc[a][b][m][n];
        if (s[0] + s[1] + s[2] + s[3] == 1.2345e37f) *sink = s[0];
    }
};
struct EpiF32 {
    static constexpr bool PERM = false, AFTER_DRAIN = false;
    float* C; int ldc; const float* bias;
    __device__ __forceinline__ void operator()(const f32x4 (&acc)[2][2][4][2], const Unit& u, int wr, int wc, int fr, int fq) const {
        const int row0 = u.pm * BM + wr * 64 + fr, col0 = u.pn * BM + wc * 32 + 4 * fq;
        f32x4 bv[2][2];
#pragma unroll
        for (int bj = 0; bj < 2; ++bj)
#pragma unroll
            for (int n = 0; n < 2; ++n) bv[bj][n] = *(const f32x4*)(bias + col0 + bj * HALF + n * 16);
#pragma unroll
        for (int ai = 0; ai < 2; ++ai)
#pragma unroll
            for (int m = 0; m < 4; ++m) { float* rowp = C + (size_t)(row0 + ai * HALF + m * 16) * ldc + col0;
#pragma unroll
                for (int bj = 0; bj < 2; ++bj)
#pragma unroll
                    for (int n = 0; n < 2; ++n) *(f32x4*)(rowp + bj * HALF + n * 16) = acc[ai][bj][m][n] + bv[bj][n]; }
    }
};
struct EpiBf16 {
    static constexpr bool PERM = true, AFTER_DRAIN = false;
    bf16_t* O; int ldc;
    __device__ __forceinline__ void operator()(const f32x4 (&acc)[2][2][4][2], const Unit& u, int wr, int wc, int fr, int fq) const {
        const int row0 = u.pm * BM + wr * 64 + fr, col0 = u.pn * BM + wc * 32 + 8 * fq;
#pragma unroll
        for (int ai = 0; ai < 2; ++ai)
#pragma unroll
            for (int m = 0; m < 4; ++m) { bf16_t* rowp = O + (size_t)(row0 + ai * HALF + m * 16) * ldc + col0;
#pragma unroll
                for (int bj = 0; bj < 2; ++bj) { const f32x4 v0 = acc[ai][bj][m][0], v1 = acc[ai][bj][m][1];
                    u32x4 w; w.x = cvt_pk_bf16(v0[0], v0[1]); w.y = cvt_pk_bf16(v0[2], v0[3]); w.z = cvt_pk_bf16(v1[0], v1[1]); w.w = cvt_pk_bf16(v1[2], v1[3]);
                    *(u32x4*)(rowp + bj * HALF) = w; } }
    }
};
__device__ __forceinline__ float silu_mul(float a, float b) { return a * b * __builtin_amdgcn_rcpf(1.0f + __expf(-a)); }
struct EpiSwiGLU {
    static constexpr bool PERM = true, AFTER_DRAIN = false;
    bf16_t* O; int ldc;
    __device__ __forceinline__ void operator()(const f32x4 (&acc)[2][2][4][2], const Unit& u, int wr, int wc, int fr, int fq) const {
        const int row0 = u.pm * BM + wr * 64 + fr, col0 = u.pn * HALF + wc * 32 + 8 * fq;
#pragma unroll
        for (int ai = 0; ai < 2; ++ai)
#pragma unroll
            for (int m = 0; m < 4; ++m) { bf16_t* rowp = O + (size_t)(row0 + ai * HALF + m * 16) * ldc + col0;
                const f32x4 a0 = acc[ai][0][m][0], a1 = acc[ai][0][m][1], b0 = acc[ai][1][m][0], b1 = acc[ai][1][m][1];
                u32x4 w;
                w.x = cvt_pk_bf16(silu_mul(a0[0], b0[0]), silu_mul(a0[1], b0[1])); w.y = cvt_pk_bf16(silu_mul(a0[2], b0[2]), silu_mul(a0[3], b0[3]));
                w.z = cvt_pk_bf16(silu_mul(a1[0], b1[0]), silu_mul(a1[1], b1[1])); w.w = cvt_pk_bf16(silu_mul(a1[2], b1[2]), silu_mul(a1[3], b1[3]));
                *(u32x4*)rowp = w; }
    }
};
struct EpiSwiGLU8 {
    static constexpr bool PERM = true, AFTER_DRAIN = false;
    unsigned char* O; int ldc; float inv, st;
    __device__ __forceinline__ void operator()(const f32x4 (&acc)[2][2][4][2], const Unit& u, int wr, int wc, int fr, int fq) const {
        const int row0 = u.pm * BM + wr * 64 + fr, col0 = u.pn * HALF + wc * 32 + 8 * fq;
        const float ib = inv * st;
#pragma unroll
        for (int ai = 0; ai < 2; ++ai)
#pragma unroll
            for (int m = 0; m < 4; ++m) { unsigned char* rowp = O + (size_t)(row0 + ai * HALF + m * 16) * ldc + col0;
                const f32x4 a0 = acc[ai][0][m][0] * inv, a1 = acc[ai][0][m][1] * inv, b0 = acc[ai][1][m][0] * ib, b1 = acc[ai][1][m][1] * ib;
                u32x2 w;
                w.x = cvt4_fp8(silu_mul(a0[0], b0[0]), silu_mul(a0[1], b0[1]), silu_mul(a0[2], b0[2]), silu_mul(a0[3], b0[3]));
                w.y = cvt4_fp8(silu_mul(a1[0], b1[0]), silu_mul(a1[1], b1[1]), silu_mul(a1[2], b1[2]), silu_mul(a1[3], b1[3]));
                *(u32x2*)rowp = w; }
    }
};
template <bool PIPE, bool BASE_BF16> struct EpiResid {
    static constexpr bool PERM = false, AFTER_DRAIN = false;
    const void* base_p; const void* base_s; bf16_t* out; const float* mod; int ldc, modld, goff, split_rows; float gs;
    static __device__ __forceinline__ f32x4 ldb(const void* rowp, int c) {
        if constexpr (BASE_BF16) { const u32x2 q = *(const u32x2*)((const bf16_t*)rowp + c);
            return (f32x4){__builtin_bit_cast(float, q.x << 16), __builtin_bit_cast(float, q.x & 0xffff0000u), __builtin_bit_cast(float, q.y << 16), __builtin_bit_cast(float, q.y & 0xffff0000u)}; }
        else return *(const f32x4*)((const float*)rowp + c);
    }
    static __device__ __forceinline__ const void* rowptr(const void* b, size_t r, int ldc) { if constexpr (BASE_BF16) return (const bf16_t*)b + r * ldc; else return (const float*)b + r * ldc; }
    static __device__ __forceinline__ void stq(bf16_t* p, f32x4 v) { u32x2 w; w.x = cvt_pk_bf16(v[0], v[1]); w.y = cvt_pk_bf16(v[2], v[3]); *(u32x2*)p = w; }
    __device__ __forceinline__ void operator()(const f32x4 (&acc)[2][2][4][2], const Unit& u, int wr, int wc, int fr, int fq) const {
        const int col0 = u.pn * BM + wc * 32 + 4 * fq;
        if (PIPE && u.pm * BM < split_rows) {
            f32x4 gq[2][2], bc[2][2], bn[2][2];
            { const void* rp = rowptr(base_p, (size_t)(u.pm * BM + wr * 64 + fr), ldc);
#pragma unroll
            for (int bj = 0; bj < 2; ++bj)
#pragma unroll
                for (int n = 0; n < 2; ++n) { gq[bj][n] = *(const f32x4*)(mod + goff + col0 + bj * HALF + n * 16) * gs; bc[bj][n] = ldb(rp, col0 + bj * HALF + n * 16); } }
#pragma unroll
            for (int gi = 0; gi < 8; ++gi) { const int ai = gi >> 2, m = gi & 3; const int r = u.pm * BM + ai * HALF + wr * 64 + m * 16 + fr;
                if (gi < 7) { const void* rp = rowptr(base_p, (size_t)(u.pm * BM + ((gi + 1) >> 2) * HALF + wr * 64 + ((gi + 1) & 3) * 16 + fr), ldc);
#pragma unroll
                    for (int bj = 0; bj < 2; ++bj)
#pragma unroll
                        for (int n = 0; n < 2; ++n) bn[bj][n] = ldb(rp, col0 + bj * HALF + n * 16); }
                bf16_t* orow = out + (size_t)r * ldc;
#pragma unroll
                for (int bj = 0; bj < 2; ++bj)
#pragma unroll
                    for (int n = 0; n < 2; ++n) { stq(orow + col0 + bj * HALF + n * 16, bc[bj][n] + gq[bj][n] * acc[ai][bj][m][n]); bc[bj][n] = bn[bj][n]; }
                asm volatile("" ::: "memory"); }
        } else {
#pragma unroll
            for (int ai = 0; ai < 2; ++ai)
#pragma unroll
                for (int m = 0; m < 4; ++m) { const int r = u.pm * BM + ai * HALF + wr * 64 + m * 16 + fr;
                    const void* brow = (r < split_rows) ? rowptr(base_p, (size_t)r, ldc) : rowptr(base_s, (size_t)(r - split_rows), ldc);
                    const float* grow = mod + (size_t)((r < split_rows) ? 0 : 1 + ((r - split_rows) >> 3)) * modld + goff;
                    bf16_t* orow = out + (size_t)r * ldc;
#pragma unroll
                    for (int bj = 0; bj < 2; ++bj)
#pragma unroll
                        for (int n = 0; n < 2; ++n) { const int c = col0 + bj * HALF + n * 16;
                            const f32x4 b = ldb(brow, c), g = *(const f32x4*)(grow + c);
                            stq(orow + c, b + (g * gs) * acc[ai][bj][m][n]); }
                    asm volatile("" ::: "memory"); }
        }
    }
};
template <class Epi, class Sched, bool ALIGN_EPI = false, bool SP2 = false, bool FP8 = false, int DIAG = 0>
__device__ __forceinline__ void gemm_phase(PG8_LAS unsigned char* lds, const Gemm g, const Sched& S, const Epi& E) {
    const int tid = threadIdx.x, wid = __builtin_amdgcn_readfirstlane(tid >> 6), lane = tid & 63, wr = wid >> 2, wc = wid & 3, fr = lane & 15, fq = lane >> 4;
    const int K = g.K, nt = K / BK;
    unsigned voffA[2], voffB[2];
#pragma unroll
    for (int i = 0; i < 2; ++i) { int R, C; stage_rc(tid * 16 + i * 8192, R, C); const int Rb = Epi::PERM ? ((R & ~31) + perm32(R & 31)) : R;
        voffA[i] = (unsigned)(R * K + C) * 2u; voffB[i] = (unsigned)(Rb * K + C) * 2u; }
    const size_t kstep = (size_t)(BK * 2);
    const size_t hstep = (size_t)HALF * K * 2;
    const size_t tstep = 2 * hstep;
    const unsigned ldsw = (unsigned)wid * 1024u;
    const int aoff = lds_byte(wr * 64 + fr, fq * 8), boff = lds_byte(wc * 32 + fr, fq * 8);
#define PG8_SA(b, h) (((b) * 2 + (h)) * HTB)
#define PG8_SB(b, h) ((4 + (b) * 2 + (h)) * HTB)
#define PG8_STAGE(bufoff, gbase, voff) do { if constexpr (DIAG >= 1) break; _Pragma("unroll") for (int _i = 0; _i < 2; ++_i) \
        __builtin_amdgcn_global_load_lds((const unsigned*)((const char*)(gbase) + (voff)[_i]), (PG8_LAS unsigned*)(lds + (bufoff) + ldsw + _i * 8192), 16, 0, 0); } while (0)
#define PG8_LDA(dst, b, h) do { if constexpr (DIAG >= 2) break; _Pragma("unroll") for (int m = 0; m < 4; ++m) _Pragma("unroll") for (int k = 0; k < 2; ++k) dst[m][k] = *(const PG8_LAS bf16x8*)(lds + PG8_SA(b, h) + aoff + m * 2048 + k * 1024); } while (0)
#define PG8_LDB(dst, b, h) do { if constexpr (DIAG >= 2) break; _Pragma("unroll") for (int n = 0; n < 2; ++n) _Pragma("unroll") for (int k = 0; k < 2; ++k) dst[n][k] = *(const PG8_LAS bf16x8*)(lds + PG8_SB(b, h) + boff + n * 2048 + k * 1024); } while (0)
#define PG8_MMA(ai, bj, At, Bt) do { __builtin_amdgcn_s_setprio(1); _Pragma("unroll") for (int m = 0; m < 4; ++m) _Pragma("unroll") for (int n = 0; n < 2; ++n) { \
        if constexpr (FP8) { asm volatile("v_mfma_f32_16x16x128_f8f6f4 %0, %1, %2, %0" : "+v"(acc[ai][bj][m][n]) : "v"(cat8(Bt[n][0], Bt[n][1])), "v"(cat8(At[m][0], At[m][1]))); } \
        else { _Pragma("unroll") for (int k = 0; k < 2; ++k) acc[ai][bj][m][n] = __builtin_amdgcn_mfma_f32_16x16x32_bf16(Bt[n][k], At[m][k], acc[ai][bj][m][n], 0, 0, 0); } } __builtin_amdgcn_s_setprio(0); } while (0)
#define PG8_WAIT_V(n) asm volatile("s_waitcnt vmcnt(" #n ")" ::: "memory")
#define PG8_WAIT_L(n) asm volatile("s_waitcnt lgkmcnt(" #n ")" ::: "memory")
#define PG8_BAR __builtin_amdgcn_s_barrier()
#if PG8_LOADPRIO
#define PG8_LP_ON __builtin_amdgcn_s_setprio(PG8_LOADPRIO)
#define PG8_LP_OFF __builtin_amdgcn_s_setprio(0)
#else
#define PG8_LP_ON do {} while (0)
#define PG8_LP_OFF do {} while (0)
#endif
#define PG8_SCHED __builtin_amdgcn_sched_barrier(0)
    Unit cur, nxt; int ui = 0;
    if (!S.next(0, cur)) return;
    f32x4 acc[2][2][4][2];
#pragma unroll
    for (int a = 0; a < 2; ++a)
#pragma unroll
        for (int b = 0; b < 2; ++b)
#pragma unroll
            for (int m = 0; m < 4; ++m)
#pragma unroll
                for (int n = 0; n < 2; ++n) acc[a][b][m][n] = (f32x4){0.f, 0.f, 0.f, 0.f};
    bf16x8 At[4][2], B0[2][2], B1[2][2];
    if constexpr (DIAG >= 2) { _Pragma("unroll") for (int i = 0; i < 4; ++i) _Pragma("unroll") for (int k = 0; k < 2; ++k) At[i][k] = (bf16x8){0,0,0,0,0,0,0,0}; _Pragma("unroll") for (int i = 0; i < 2; ++i) _Pragma("unroll") for (int k = 0; k < 2; ++k) { B0[i][k] = (bf16x8){0,0,0,0,0,0,0,0}; B1[i][k] = (bf16x8){0,0,0,0,0,0,0,0}; } }
    const char* cA = (const char*)g.A + (size_t)cur.pm * tstep; const char* cB = (const char*)g.Bt + (size_t)cur.pn * tstep;
    int kb = 0, ke = nt; if constexpr (Sched::SK) { kb = cur.kb; ke = cur.ke; }
    const char* pA = cA + (size_t)kb * kstep; const char* pB = cB + (size_t)kb * kstep;
    S.a_ready(cur);
    if constexpr (SP2) {
        PG8_STAGE(PG8_SB(0, 0), pB, voffB); PG8_STAGE(PG8_SB(0, 1), pB + hstep, voffB); PG8_STAGE(PG8_SA(0, 0), pA, voffA); PG8_STAGE(PG8_SA(0, 1), pA + hstep, voffA);
        if (wr == 1) PG8_BAR;
        PG8_WAIT_V(2); PG8_BAR;
        PG8_STAGE(PG8_SB(1, 0), pB + kstep, voffB); PG8_STAGE(PG8_SA(1, 0), pA + kstep, voffA); PG8_STAGE(PG8_SB(1, 1), pB + hstep + kstep, voffB);
        PG8_WAIT_V(6); PG8_BAR;
    } else {
        PG8_STAGE(PG8_SB(0, 0), pB, voffB); PG8_STAGE(PG8_SA(0, 0), pA, voffA); PG8_STAGE(PG8_SB(0, 1), pB + hstep, voffB); PG8_STAGE(PG8_SA(0, 1), pA + hstep, voffA);
        if (wr == 1) PG8_BAR;
        PG8_WAIT_V(4); PG8_BAR;
        PG8_STAGE(PG8_SB(1, 0), pB + kstep, voffB); PG8_STAGE(PG8_SA(1, 0), pA + kstep, voffA); PG8_STAGE(PG8_SB(1, 1), pB + hstep + kstep, voffB);
        PG8_WAIT_V(6); PG8_BAR;
    }
    for (;;) {
        const bool has_next = S.next(ui + 1, nxt);
        const char* nA0 = has_next ? (const char*)g.A + (size_t)nxt.pm * tstep : cA; const char* nB0 = has_next ? (const char*)g.Bt + (size_t)nxt.pn * tstep : cB;
        int nkb = 0; if constexpr (Sched::SK) { if (has_next) nkb = nxt.kb; }
        const char* nA = nA0 + (size_t)nkb * kstep; const char* nB = nB0 + (size_t)nkb * kstep;
        for (int t = kb; t < ke; t += 2) {
            const bool last = (t == ke - 2);
            const char* a1 = cA + (size_t)(t + 1) * kstep;
            const char* a2 = last ? nA : cA + (size_t)(t + 2) * kstep; const char* b2 = last ? nB : cB + (size_t)(t + 2) * kstep;
            const char* a3 = a2 + kstep; const char* b3 = b2 + kstep;
            if (last && has_next) S.a_ready(nxt);
            if constexpr (SP2) {
            PG8_LP_ON; PG8_LDB(B0, 0, 0); PG8_LDB(B1, 0, 1); PG8_SCHED; PG8_LDA(At, 0, 0); PG8_STAGE(PG8_SA(1, 1), a1 + hstep, voffA);
            PG8_LP_OFF; PG8_WAIT_V(8); PG8_WAIT_L(0); PG8_BAR; PG8_MMA(0, 0, At, B0); PG8_MMA(0, 1, At, B1); PG8_BAR; PG8_SCHED;
            PG8_LP_ON; PG8_LDA(At, 0, 1); PG8_STAGE(PG8_SB(0, 0), b2, voffB); PG8_STAGE(PG8_SB(0, 1), b2 + hstep, voffB); PG8_STAGE(PG8_SA(0, 0), a2, voffA);
            PG8_LP_OFF; PG8_WAIT_V(8); PG8_WAIT_L(0); PG8_BAR; PG8_MMA(1, 0, At, B0); PG8_MMA(1, 1, At, B1); PG8_BAR; PG8_SCHED;
            PG8_LP_ON; PG8_LDB(B0, 1, 0); PG8_LDB(B1, 1, 1); PG8_SCHED; PG8_LDA(At, 1, 0); PG8_STAGE(PG8_SA(0, 1), a2 + hstep, voffA);
            PG8_LP_OFF; PG8_WAIT_V(8); PG8_WAIT_L(0); PG8_BAR; PG8_MMA(0, 0, At, B0); PG8_MMA(0, 1, At, B1); PG8_BAR; PG8_SCHED;
            PG8_LP_ON; PG8_LDA(At, 1, 1); PG8_STAGE(PG8_SB(1, 0), b3, voffB); PG8_STAGE(PG8_SB(1, 1), b3 + hstep, voffB); PG8_STAGE(PG8_SA(1, 0), a3, voffA);
            PG8_LP_OFF; PG8_WAIT_V(8); PG8_WAIT_L(0); PG8_BAR; PG8_MMA(1, 0, At, B0); PG8_MMA(1, 1, At, B1); PG8_BAR; PG8_SCHED;
            } else {
            PG8_LDB(B0, 0, 0); PG8_SCHED; PG8_LDA(At, 0, 0); PG8_STAGE(PG8_SA(1, 1), a1 + hstep, voffA);
            PG8_WAIT_L(8); PG8_BAR; PG8_WAIT_L(0); PG8_MMA(0, 0, At, B0); PG8_BAR; PG8_SCHED;
            PG8_LDB(B1, 0, 1); PG8_STAGE(PG8_SB(0, 0), b2, voffB);
            PG8_BAR; PG8_WAIT_L(0); PG8_MMA(0, 1, At, B1); PG8_BAR;
            PG8_LDA(At, 0, 1); PG8_STAGE(PG8_SA(0, 0), a2, voffA);
            PG8_BAR; PG8_WAIT_L(0); PG8_MMA(1, 0, At, B0); PG8_BAR; PG8_SCHED;
            PG8_STAGE(PG8_SB(0, 1), b2 + hstep, voffB);
            PG8_WAIT_V(6); PG8_BAR; PG8_MMA(1, 1, At, B1); PG8_BAR;
            PG8_LDB(B0, 1, 0); PG8_SCHED; PG8_LDA(At, 1, 0); PG8_STAGE(PG8_SA(0, 1), a2 + hstep, voffA);
            PG8_WAIT_L(8); PG8_BAR; PG8_WAIT_L(0); PG8_MMA(0, 0, At, B0); PG8_BAR; PG8_SCHED;
            PG8_LDB(B1, 1, 1); PG8_STAGE(PG8_SB(1, 0), b3, voffB);
            PG8_BAR; PG8_WAIT_L(0); PG8_MMA(0, 1, At, B1); PG8_BAR;
            PG8_LDA(At, 1, 1); PG8_STAGE(PG8_SA(1, 0), a3, voffA);
            PG8_BAR; PG8_WAIT_L(0); PG8_MMA(1, 0, At, B0); PG8_BAR; PG8_SCHED;
            PG8_STAGE(PG8_SB(1, 1), b3 + hstep, voffB);
            PG8_WAIT_V(6); PG8_BAR; PG8_MMA(1, 1, At, B1); PG8_BAR;
            }
        }
        if constexpr (FP8) { asm volatile("s_nop 7\n\ts_nop 7" ::: "memory"); PG8_SCHED; }
        if constexpr (ALIGN_EPI) { if (wr == 0) PG8_BAR; }
        if constexpr (Sched::SK) {
            if (cur.kind == 1) S.store_partial(acc, cur, tid);
            else if (cur.kind == 0) { E(acc, cur, wr, wc, fr, fq); S.done(cur); }
        } else
        if constexpr (!Epi::AFTER_DRAIN) { E(acc, cur, wr, wc, fr, fq); S.done(cur); }
        if (!has_next) break;
#pragma unroll
        for (int a = 0; a < 2; ++a)
#pragma unroll
            for (int b = 0; b < 2; ++b)
#pragma unroll
                for (int m = 0; m < 4; ++m)
#pragma unroll
                    for (int n = 0; n < 2; ++n) acc[a][b][m][n] = (f32x4){0.f, 0.f, 0.f, 0.f};
        cur = nxt; cA = nA0; cB = nB0; ++ui; if constexpr (Sched::SK) { kb = cur.kb; ke = cur.ke; }
        if constexpr (ALIGN_EPI) { if (wr == 1) PG8_BAR; }
    }
    PG8_WAIT_V(0);
    if constexpr (!ALIGN_EPI) { if (wr == 0) PG8_BAR; }
    PG8_BAR;
    if constexpr (Epi::AFTER_DRAIN) { E.fused(acc, cur, wr, wc, fr, fq, lds, wid, lane); S.done(cur); }
    if constexpr (Sched::SK) { if (cur.kind == 2) { S.add_partial(acc, cur, tid, wid); E(acc, cur, wr, wc, fr, fq); S.done(cur); } }
#undef PG8_SA
#undef PG8_SB
#undef PG8_STAGE
#undef PG8_LDA
#undef PG8_LDB
#undef PG8_MMA
#undef PG8_WAIT_V
#undef PG8_WAIT_L
#undef PG8_BAR
#undef PG8_LP_ON
#undef PG8_LP_OFF
#undef PG8_SCHED
}
}

#ifndef PG8_SP2
#define PG8_SP2 true
#endif
#ifndef PG8_ALIGN
#define PG8_ALIGN true
#endif
#ifndef PROBE_GEMM
#define PROBE_GEMM 0
#endif
#ifndef UP_CUT
#define UP_CUT 0
#endif
#ifndef MK_PER_PHASE
#define MK_PER_PHASE 0
#endif

constexpr int NWAVES = 8;
constexpr int D = 4096, SEQ = 8192, DBATCH = 128, DSEQ = 8, MS = DBATCH * DSEQ, M = SEQ + MS;
constexpr int FF = 11008, NPROJ = 9216, NMOD = 9, MODW = NMOD * D, MODROWS = 256;
constexpr int C_K = 2048, C_V = 2560, C_GB = 3072, C_GC = 5120, C_HC = 7168;
constexpr int WIN = 128, NHEAD = 16;
constexpr float EPS = 1e-6f;
constexpr float S_H = 8.f, S_W13 = 512.f, S_T = 8.f, S_W2 = 512.f;
constexpr size_t O_YP = 0, O_YS = 33554432, O_KWP = 37748736, O_VWP = 37814272, O_CP = 37879808, O_KWS = 37883904, O_VWS = 46272512, O_CS = 54661120, O_END = 55185408;
enum { I_XP = 0, I_XS, I_CP, I_CS, I_CK, I_CV, I_SC, I_RB, I_G1, I_W1A, I_W3A, I_W2A, I_GM, I_WIN, I_SINK, I_CW, I_WOUT, I_G2, I_W1B, I_W3B, I_W2B, I_WADA, I_BADA, I_GF, N_IN };

constexpr size_t MiB = 1u << 20;
constexpr size_t al(size_t x) { return (x + MiB - 1) / MiB * MiB; }
constexpr size_t WS_CTL = 0, CTL_ZERO_BYTES = 1 * MiB;
constexpr size_t WS_W13A = 1 * MiB;
constexpr size_t WS_W2A  = WS_W13A + al((size_t)2 * FF * D * 2);
constexpr size_t WS_WIN  = WS_W2A + al((size_t)D * FF * 2);
constexpr size_t WS_WOUT = WS_WIN + al((size_t)NPROJ * D * 2);
constexpr size_t WS_W13B = WS_WOUT + al((size_t)D * D * 2);
constexpr size_t WS_W2B  = WS_W13B + al((size_t)2 * FF * D * 2);
constexpr size_t WS_WADA = WS_W2B + al((size_t)D * FF * 2);
constexpr size_t WS_CSI  = WS_WADA + al((size_t)MODW * D * 2);
constexpr size_t WS_MOD  = WS_CSI + al((size_t)MODROWS * D * 2);
constexpr size_t WS_X1   = WS_MOD + al((size_t)MODROWS * MODW * 4);
constexpr size_t WS_H    = WS_X1 + al((size_t)M * D * 4);
constexpr size_t WS_T    = WS_H + al((size_t)M * D * 2);
constexpr size_t WS_PROJ = WS_T + al((size_t)M * FF * 2);
constexpr size_t WS_MIX  = WS_PROJ + al((size_t)M * NPROJ * 2);
constexpr size_t WS_PART = WS_MIX + al((size_t)M * D * 2);
constexpr size_t WS_SKS  = WS_PART + al((size_t)4 * (DBATCH + 1) * 12288 * 4);
constexpr size_t WS_SKS2 = WS_SKS + (size_t)256 * 262144;
constexpr size_t WS_END  = WS_SKS2 + (size_t)256 * 262144;
constexpr int CW_TMO = 0, CW_CODE = 1, CW_BAR = 4096;
constexpr int CW_SK = 16384, CW_SK_STRIDE = 16384;
static_assert((size_t)(CW_SK + 8 * CW_SK_STRIDE) * 4 <= CTL_ZERO_BYTES, "stream-K counters inside the zeroed control region");

constexpr int RING_OFF = 0, RING_BYTES = 131072;
constexpr int SKLIST_OFF = 131072;
constexpr int LDSCTL_OFF = 143360, MISC_OFF = LDSCTL_OFF + 320;
constexpr int LDS_BYTES = 147456;
static_assert(MISC_OFF + 128 <= LDS_BYTES, "LDS map");

#define GAS __attribute__((address_space(1)))
#define LAS __attribute__((address_space(3)))
typedef unsigned short bf16;
typedef unsigned v4u __attribute__((ext_vector_type(4)));
typedef unsigned v2u __attribute__((ext_vector_type(2)));
typedef float f32x4 __attribute__((ext_vector_type(4)));
typedef float f32x16 __attribute__((ext_vector_type(16)));
typedef short bf16x8 __attribute__((ext_vector_type(8)));
typedef GAS unsigned gu32;
#define RLX_AGENT __ATOMIC_RELAXED, __HIP_MEMORY_SCOPE_AGENT
#define LDS_WAIT() asm volatile("s_waitcnt lgkmcnt(0)" ::: "memory")
#define VM_WAIT() asm volatile("s_waitcnt vmcnt(0)" ::: "memory")
__device__ __forceinline__ unsigned f2bf(float f) { unsigned u = __builtin_bit_cast(unsigned, f); return (u + 0x7fffu + ((u >> 16) & 1u)) >> 16; }
__device__ __forceinline__ unsigned pk2(float lo, float hi) { return f2bf(lo) | (f2bf(hi) << 16); }
__device__ __forceinline__ float bf_lo(unsigned w) { return __builtin_bit_cast(float, w << 16); }
__device__ __forceinline__ float bf_hi(unsigned w) { return __builtin_bit_cast(float, w & 0xffff0000u); }

#define XB_TMO      128
#define XB_XCNT(j)  (256  + 64 * (j))
#define XB_XSUB(j)  (1280 + 64 * (j))
#define XB_XGEN(j)  (2304 + 64 * (j))
#define XB_TOP      3328
#define XB_TOPGEN   3392
#define XCD_BAR_WORDS 3456
#define XB_SPIN_CAP (1u << 18)

__device__ __forceinline__ unsigned xb_ld(unsigned* p)              { return __hip_atomic_load(p, __ATOMIC_RELAXED, __HIP_MEMORY_SCOPE_AGENT); }
__device__ __forceinline__ unsigned xb_add(unsigned* p, unsigned v) { return __hip_atomic_fetch_add(p, v, __ATOMIC_RELAXED, __HIP_MEMORY_SCOPE_AGENT); }
__device__ __forceinline__ unsigned xb_xcc_id() { return (unsigned)__builtin_amdgcn_s_getreg((3 << 11) | 20) & 0xFu; }
#define XB_SPIN(cond, bar) do { unsigned _sp = 0; while (cond) { __builtin_amdgcn_s_sleep(1); \
    if ((++_sp & 255u) == 0u) { if (xb_ld(&(bar)[XB_TMO])) break; if (_sp > XB_SPIN_CAP) { atomicAdd(&(bar)[XB_TMO], 1u); break; } } } } while (0)

struct XcdBarrier {
    unsigned* bar; unsigned x;
    volatile LAS unsigned* st;
};

__device__ __forceinline__ XcdBarrier xcd_barrier_post(unsigned* bar, volatile LAS unsigned* st) {
    XcdBarrier b; b.bar = bar; b.x = xb_xcc_id(); b.st = st;
    if (threadIdx.x == 0) (void)xb_add(&bar[XB_XCNT(b.x)], 1u);
    return b;
}
__device__ __forceinline__ void xcd_barrier_complete(unsigned* bar, unsigned x, unsigned& nloc, unsigned& nx) {
    const unsigned G = gridDim.x * gridDim.y * gridDim.z;
    unsigned sum, cnt, mine, sp = 0u;
    for (;;) {
        sum = 0u; cnt = 0u; mine = 0u;
#pragma unroll
        for (unsigned j = 0; j < 16; ++j) { const unsigned c = xb_ld(&bar[XB_XCNT(j)]); sum += c; cnt += (c > 0u) ? 1u : 0u; mine = (j == x) ? c : mine; }
        if (sum == G) break;
        __builtin_amdgcn_s_sleep(1);
        if ((++sp & 255u) == 0u) { if (xb_ld(&bar[XB_TMO])) break; if (sp > XB_SPIN_CAP) { atomicAdd(&bar[XB_TMO], 1u); break; } }
    }
    nloc = mine > 0u ? mine : 1u; nx = cnt > 0u ? cnt : 1u;
}

__device__ __forceinline__ void xcd_barrier(const XcdBarrier& b) {
    asm volatile("s_waitcnt vmcnt(0)" ::: "memory");
    __syncthreads();
    if (threadIdx.x == 0) {
        unsigned* bar = b.bar;
        __builtin_amdgcn_s_waitcnt(0);
        unsigned nloc = b.st[0], nx = b.st[1];
        if (nloc == 0u) { xcd_barrier_complete(bar, b.x, nloc, nx); b.st[0] = nloc; b.st[1] = nx; }
        const unsigned old = xb_add(&bar[XB_XSUB(b.x)], 1u);
        const unsigned gen = old / nloc;
        if (old + 1u == (gen + 1u) * nloc) {
            __builtin_amdgcn_fence(__ATOMIC_RELEASE, "agent");
            asm volatile("s_waitcnt vmcnt(0)" ::: "memory");
            const unsigned og = xb_add(&bar[XB_TOP], 1u);
            const unsigned tg = og / nx;
            if (og + 1u == (tg + 1u) * nx) xb_add(&bar[XB_TOPGEN], 1u);
            else XB_SPIN(xb_ld(&bar[XB_TOPGEN]) == tg, bar);
            __builtin_amdgcn_fence(__ATOMIC_ACQUIRE, "agent");
            xb_add(&bar[XB_XGEN(b.x)], 1u);
            asm volatile("s_waitcnt vmcnt(0)" ::: "memory");
        } else {
            XB_SPIN(xb_ld(&bar[XB_XGEN(b.x)]) == gen, bar);
            __builtin_amdgcn_fence(__ATOMIC_ACQUIRE, "agent");
            asm volatile("s_waitcnt vmcnt(0)" ::: "memory");
        }
    }
    __syncthreads();
}


struct Frame {
    LAS unsigned char* lds;
    volatile LAS unsigned* MISC;
    gu32* ctl;
    int tid, lane, wave;
    int vcu, G;
};
__device__ __forceinline__ float wave_sum(float v) {
#pragma unroll
    for (int o = 1; o < 64; o <<= 1) v += __shfl_xor(v, o);
    return v;
}
template <int MODE>
__device__ __forceinline__ void p0_transpose_item(const float* W, int K, int N, bf16* WT, LAS float* scr, int item, int lane) {
    const int nblk = N / 32, kb = item / nblk, nb = item % nblk, k0 = 64 * kb, n0 = 32 * nb;
    const GAS float* Wg = (const GAS float*)W;
    float ld[32];
#pragma unroll
    for (int i = 0; i < 32; ++i) { const int kk = 2 * i + (lane >> 5); ld[i] = __builtin_nontemporal_load(&Wg[(size_t)(k0 + kk) * N + n0 + (lane & 31)]); }
#pragma unroll
    for (int i = 0; i < 32; ++i) { const int kk = 2 * i + (lane >> 5); scr[kk * 33 + (lane & 31)] = ld[i]; }
    LDS_WAIT(); asm volatile("" ::: "memory");
    const int c = lane & 7;
    const int r0 = (MODE == 0) ? n0 : (n0 / 128) * 256 + (n0 % 128) + (MODE == 2 ? 128 : 0);
#pragma unroll
    for (int j = 0; j < 4; ++j) { const int n = (lane >> 3) + 8 * j; const LAS float* s = scr + (8 * c) * 33 + n;
        v4u o; o.x = pg8::cvt_pk_bf16(s[0 * 33], s[1 * 33]); o.y = pg8::cvt_pk_bf16(s[2 * 33], s[3 * 33]); o.z = pg8::cvt_pk_bf16(s[4 * 33], s[5 * 33]); o.w = pg8::cvt_pk_bf16(s[6 * 33], s[7 * 33]);
        *(GAS v4u*)(WT + (size_t)(r0 + n) * K + k0 + 8 * c) = o; }
    LDS_WAIT(); asm volatile("" ::: "memory");
}

template <int MODE>
__device__ __forceinline__ void p0_transpose_item8(const float* W, int K, int N, unsigned char* WT, float scale, LAS float* scr, int item, int lane) {
    const int nblk = N / 32, kb = item / nblk, nb = item % nblk, k0 = 128 * kb, n0 = 32 * nb;
    const GAS float* Wg = (const GAS float*)W;
#pragma unroll
    for (int h2 = 0; h2 < 2; ++h2) { float ld[32];
#pragma unroll
        for (int i = 0; i < 32; ++i) { const int kk = 2 * (i + 32 * h2) + (lane >> 5); ld[i] = __builtin_nontemporal_load(&Wg[(size_t)(k0 + kk) * N + n0 + (lane & 31)]); }
#pragma unroll
        for (int i = 0; i < 32; ++i) { const int kk = 2 * (i + 32 * h2) + (lane >> 5); scr[kk * 33 + (lane & 31)] = ld[i]; } }
    LDS_WAIT(); asm volatile("" ::: "memory");
    const int n = lane & 31, hf = lane >> 5;
    const int r0 = (MODE == 0) ? n0 : (n0 / 128) * 256 + (n0 % 128) + (MODE == 2 ? 128 : 0);
#pragma unroll
    for (int p = 0; p < 4; ++p) { const int q = 2 * p + hf; const LAS float* s = scr + (16 * q) * 33 + n;
        v4u o;
        o.x = pg8::cvt4_fp8(s[0 * 33] * scale, s[1 * 33] * scale, s[2 * 33] * scale, s[3 * 33] * scale);
        o.y = pg8::cvt4_fp8(s[4 * 33] * scale, s[5 * 33] * scale, s[6 * 33] * scale, s[7 * 33] * scale);
        o.z = pg8::cvt4_fp8(s[8 * 33] * scale, s[9 * 33] * scale, s[10 * 33] * scale, s[11 * 33] * scale);
        o.w = pg8::cvt4_fp8(s[12 * 33] * scale, s[13 * 33] * scale, s[14 * 33] * scale, s[15 * 33] * scale);
        *(GAS v4u*)(WT + (size_t)(r0 + n) * K + k0 + 16 * q) = o; }
    LDS_WAIT(); asm volatile("" ::: "memory");
}

struct Args { const float* in[N_IN]; float* out; unsigned char* ws; int ph_lo, ph_hi; };

enum { JOB_W1A = 0, JOB_W3A, JOB_W2A, JOB_WIN, JOB_WOUT, JOB_W1B, JOB_W3B, JOB_W2B };
template <int JOB>
__device__ __forceinline__ void conv_job(Frame& F, const Args& A, int rank, int nw) {
    LAS float* scr = (LAS float*)(F.lds + RING_OFF + F.wave * 16896);
    unsigned char* ws = A.ws;
    constexpr int I_13 = (D / 128) * (FF / 32), I_2 = (FF / 128) * (D / 32), I_IN = (D / 64) * (NPROJ / 32), I_OUT = (D / 64) * (D / 32);
    constexpr int N = (JOB == JOB_W1A || JOB == JOB_W3A || JOB == JOB_W1B || JOB == JOB_W3B) ? I_13 : (JOB == JOB_W2A || JOB == JOB_W2B) ? I_2 : (JOB == JOB_WIN) ? I_IN : I_OUT;
    for (int it = rank; it < N; it += nw) {
        if constexpr (JOB == JOB_W1A) p0_transpose_item8<1>(A.in[I_W1A], D, FF, ws + WS_W13A, S_W13, scr, it, F.lane);
        if constexpr (JOB == JOB_W3A) p0_transpose_item8<2>(A.in[I_W3A], D, FF, ws + WS_W13A, S_W13, scr, it, F.lane);
        if constexpr (JOB == JOB_W2A) p0_transpose_item8<0>(A.in[I_W2A], FF, D, ws + WS_W2A, S_W2, scr, it, F.lane);
        if constexpr (JOB == JOB_WIN) p0_transpose_item<0>(A.in[I_WIN], D, NPROJ, (bf16*)(ws + WS_WIN), scr, it, F.lane);
        if constexpr (JOB == JOB_WOUT) p0_transpose_item<0>(A.in[I_WOUT], D, D, (bf16*)(ws + WS_WOUT), scr, it, F.lane);
        if constexpr (JOB == JOB_W1B) p0_transpose_item8<1>(A.in[I_W1B], D, FF, ws + WS_W13B, S_W13, scr, it, F.lane);
        if constexpr (JOB == JOB_W3B) p0_transpose_item8<2>(A.in[I_W3B], D, FF, ws + WS_W13B, S_W13, scr, it, F.lane);
        if constexpr (JOB == JOB_W2B) p0_transpose_item8<0>(A.in[I_W2B], FF, D, ws + WS_W2B, S_W2, scr, it, F.lane);
    }
}
__device__ __forceinline__ void csilu_phase(Frame& F, const Args& A) {
    const int gt = (F.vcu * NWAVES + F.wave) * 64 + F.lane, NGT = F.G * NWAVES * 64;
    bf16* cs = (bf16*)(A.ws + WS_CSI);
    for (int it = gt; it < 144 * D / 8; it += NGT) {
        const int row = it / (D / 8), c8 = (it % (D / 8)) * 8;
        v4u o = (v4u){0u, 0u, 0u, 0u};
        if (row <= DBATCH) {
            const float* src = (row == 0) ? A.in[I_CP] + c8 : A.in[I_CS] + (size_t)(row - 1) * D + c8;
            const f32x4 a = *(const GAS f32x4*)src, b = *(const GAS f32x4*)(src + 4);
            float v[8] = {a[0], a[1], a[2], a[3], b[0], b[1], b[2], b[3]};
#pragma unroll
            for (int j = 0; j < 8; ++j) v[j] = v[j] / (1.0f + __expf(-v[j]));
            o.x = pk2(v[0], v[1]); o.y = pk2(v[2], v[3]); o.z = pk2(v[4], v[5]); o.w = pk2(v[6], v[7]);
        }
        *(GAS v4u*)(cs + ((size_t)((c8 >> 5) * 9 + (row >> 4)) * 64 + ((c8 & 31) >> 3) * 16 + (row & 15)) * 8) = o;
    }
}
constexpr int MODI_SB = 2560, MODI_A_OFF = 8 * MODI_SB, MODI_A_BYTES = 9216;
__device__ __forceinline__ void mod_item256(Frame& F, const Args& A, int cg, int k0, int nsteps, float* dst, int ldd, int dcol0, const float* bias) {
    const int lane = F.lane, w = F.wave, n0 = 256 * cg + 32 * w, tid = F.tid;
    LAS unsigned char* sb = F.lds + w * MODI_SB;
    LAS unsigned char* la = F.lds + MODI_A_OFF;
    const bf16* CS = (const bf16*)(A.ws + WS_CSI);
    const int kp = lane >> 3, a8 = lane & 7, n4 = 4 * a8;
    const GAS char* Wb = (const GAS char*)(A.in[I_WADA] + (size_t)k0 * MODW + n0);
    const unsigned wlo = (unsigned)((2 * kp) * MODW + n4) * 4u;
    const GAS char* Cb = (const GAS char*)CS + (size_t)(k0 / 32) * 9216;
    const unsigned c1 = (unsigned)tid * 16u, c2 = (unsigned)(512 + (tid & 63)) * 16u;
    f32x4 acc[9][2];
#pragma unroll
    for (int mt = 0; mt < 9; ++mt)
#pragma unroll
        for (int j = 0; j < 2; ++j) acc[mt][j] = (f32x4){0.f, 0.f, 0.f, 0.f};
    f32x4 buf[4][4];
    v4u ar[2][2];
#define MODI_LOAD(b, s) do { _Pragma("unroll") for (int i = 0; i < 4; ++i) buf[b][i] = __builtin_nontemporal_load((const GAS f32x4*)(Wb + (size_t)(32 * (s) + 16 * (i >> 1) + (i & 1)) * (MODW * 4) + wlo)); } while (0)
#define MODI_ALOAD(r, s) do { const int s_ = (s) < nsteps ? (s) : nsteps - 1; ar[r][0] = *(const GAS v4u*)(Cb + (size_t)s_ * 9216 + c1); ar[r][1] = *(const GAS v4u*)(Cb + (size_t)s_ * 9216 + c2); } while (0)
#define MODI_AWRITE(r, s) do { *(LAS v4u*)(la + ((s) & 1) * MODI_A_BYTES + c1) = ar[r][0]; *(LAS v4u*)(la + ((s) & 1) * MODI_A_BYTES + c2) = ar[r][1]; } while (0)
    __syncthreads();
    MODI_ALOAD(0, 0); MODI_ALOAD(1, 1);
    MODI_LOAD(0, 0); MODI_LOAD(1, 1); MODI_LOAD(2, 2); MODI_LOAD(3, 3);
    MODI_AWRITE(0, 0);
    MODI_ALOAD(0, 2);
    __syncthreads();
#pragma unroll 1
    for (int s4 = 0; s4 < nsteps; s4 += 4) {
#pragma unroll
        for (int b = 0; b < 4; ++b) { const int s = s4 + b;
#pragma unroll
            for (int ip = 0; ip < 2; ++ip)
#pragma unroll
                for (int e = 0; e < 4; ++e) { const int n = n4 + e, k = 2 * kp + 16 * ip;
                    *(LAS unsigned*)(sb + n * 80 + (((k >> 3) ^ (a8 & 3)) * 16) + (k & 7) * 2) = pg8::cvt_pk_bf16(buf[b][2 * ip][e], buf[b][2 * ip + 1][e]); }
            asm volatile("" ::: "memory");
            { const int sn = (s + 4 < nsteps) ? s + 4 : nsteps - 1; MODI_LOAD(b, sn); }
            asm volatile("" ::: "memory");
            bf16x8 bfr[2];
#pragma unroll
            for (int j = 0; j < 2; ++j) { const int n = 16 * j + (lane & 15); bfr[j] = *(const LAS bf16x8*)(sb + n * 80 + (((lane >> 4) ^ ((n >> 2) & 3)) * 16)); }
#pragma unroll
            for (int mg = 0; mg < 3; ++mg) { bf16x8 af[3];
#pragma unroll
                for (int i = 0; i < 3; ++i) af[i] = *(const LAS bf16x8*)(la + (s & 1) * MODI_A_BYTES + (3 * mg + i) * 1024 + lane * 16);
#pragma unroll
                for (int i = 0; i < 3; ++i)
#pragma unroll
                    for (int j = 0; j < 2; ++j) acc[3 * mg + i][j] = __builtin_amdgcn_mfma_f32_16x16x32_bf16(af[i], bfr[j], acc[3 * mg + i][j], 0, 0, 0);
                asm volatile("" ::: "memory"); }
            MODI_AWRITE((b + 1) & 1, s + 1);
            asm volatile("" ::: "memory");
            MODI_ALOAD((b + 1) & 1, s + 3);
            __syncthreads();
        }
    }
#undef MODI_LOAD
#undef MODI_ALOAD
#undef MODI_AWRITE
    const int c0 = 32 * w + (lane & 15);
#pragma unroll
    for (int j = 0; j < 2; ++j) { const float bv = bias ? bias[256 * cg + c0 + 16 * j] : 0.f;
#pragma unroll
        for (int mt = 0; mt < 9; ++mt)
#pragma unroll
            for (int r = 0; r < 4; ++r) { const int row = 16 * mt + 4 * (lane >> 4) + r;
                if (row <= DBATCH) dst[(size_t)row * ldd + dcol0 + c0 + 16 * j] = acc[mt][j][r] + bv; } }
    LDS_WAIT();
}
__device__ __forceinline__ void mod_chunk_partials(Frame& F, const Args& A, int chunk, int rank, int nwg) {
    float* PART = (float*)(A.ws + WS_PART);
    for (int it = rank; it < 192; it += nwg) { const int cg = it >> 2, q = it & 3;
        mod_item256(F, A, 48 * chunk + cg, 1024 * q, 32, PART + (size_t)q * (DBATCH + 1) * 12288, 12288, 256 * cg, nullptr); }
}
__device__ __forceinline__ void mod_combine(Frame& F, const Args& A, int chunk) {
    const float* PART = (const float*)(A.ws + WS_PART); float* MOD = (float*)(A.ws + WS_MOD);
    const int gt = (F.vcu * NWAVES + F.wave) * 64 + F.lane, NGT = F.G * NWAVES * 64;
    constexpr int PS = (DBATCH + 1) * 12288;
    for (int i = gt; i < PS / 4; i += NGT) { const int r = (4 * i) / 12288, c = (4 * i) % 12288;
        const f32x4 s = (*(const GAS f32x4*)(PART + 4 * (size_t)i) + *(const GAS f32x4*)(PART + PS + 4 * (size_t)i)) + (*(const GAS f32x4*)(PART + 2 * (size_t)PS + 4 * (size_t)i) + *(const GAS f32x4*)(PART + 3 * (size_t)PS + 4 * (size_t)i));
        *(GAS f32x4*)(MOD + (size_t)r * MODW + 12288 * chunk + c) = s + *(const GAS f32x4*)(A.in[I_BADA] + 12288 * chunk + c); }
}

template <bool FP8OUT>
__device__ __forceinline__ void normmod_store(bf16* H, int m, int lane, int j, f32x4 h) {
    if constexpr (FP8OUT) { ((GAS unsigned*)((unsigned char*)H + (size_t)m * D) + lane)[64 * j] = pg8::cvt4_fp8(h.x * S_H, h.y * S_H, h.z * S_H, h.w * S_H); }
    else { v2u w; w.x = pg8::cvt_pk_bf16(h.x, h.y); w.y = pg8::cvt_pk_bf16(h.z, h.w); ((GAS v2u*)(H + (size_t)m * D) + lane)[64 * j] = w; }
}
template <bool XBF16> __device__ __forceinline__ f32x4 ldx4(const void* rowp, int q) {
    if constexpr (XBF16) { const v2u w = ((const GAS v2u*)rowp)[q]; return (f32x4){bf_lo(w.x), bf_hi(w.x), bf_lo(w.y), bf_hi(w.y)}; }
    else return ((const GAS f32x4*)rowp)[q];
}
template <bool XBF16> __device__ __forceinline__ const void* xrowp(const void* base, size_t r) { if constexpr (XBF16) return (const bf16*)base + r * D; else return (const float*)base + r * D; }
template <bool FP8OUT, bool XBF16>
__device__ __forceinline__ void normmod_phase(Frame& F, const void* xp, const void* xs, const float* g, const float* mod, int ish, int isc, bf16* H) {
    const int gw = F.vcu * NWAVES + F.wave, NGW = F.G * NWAVES, lane = F.lane;
    LAS f32x4* lgs = (LAS f32x4*)F.lds; LAS f32x4* lsh = (LAS f32x4*)(F.lds + D * 4);
    for (int i = F.tid; i < D / 4; i += NWAVES * 64) { const f32x4 gg = *((const GAS f32x4*)g + i), sc = *((const GAS f32x4*)(mod + (size_t)isc * D) + i);
        lgs[i] = gg * (sc + 1.0f); lsh[i] = *((const GAS f32x4*)(mod + (size_t)ish * D) + i); }
    __syncthreads();
    if (gw < SEQ) {
        f32x4 cur[16], nx[16];
#pragma unroll
        for (int j = 0; j < 16; ++j) cur[j] = ldx4<XBF16>(xrowp<XBF16>(xp, (size_t)gw), lane + 64 * j);
#pragma unroll 1
        for (int m = gw; m < SEQ; m += NGW) {
            asm volatile("" ::: "memory");
            const int mn = (m + NGW < SEQ) ? m + NGW : m;
#pragma unroll
            for (int j = 0; j < 16; ++j) nx[j] = ldx4<XBF16>(xrowp<XBF16>(xp, (size_t)mn), lane + 64 * j);
            float s = 0.f;
#pragma unroll
            for (int j = 0; j < 16; ++j) s += (cur[j].x * cur[j].x + cur[j].y * cur[j].y) + (cur[j].z * cur[j].z + cur[j].w * cur[j].w);
            const float rstd = 1.0f / sqrtf(wave_sum(s) * (1.f / D) + EPS);
#pragma unroll
            for (int j = 0; j < 16; ++j) normmod_store<FP8OUT>(H, m, lane, j, (cur[j] * rstd) * lgs[lane + 64 * j] + lsh[lane + 64 * j]);
#pragma unroll
            for (int j = 0; j < 16; ++j) cur[j] = nx[j];
        }
    }
    for (int m = SEQ + gw; m < M; m += NGW) {
        const float* mrow = mod + (size_t)(1 + ((m - SEQ) >> 3)) * MODW;
        const void* xr = xrowp<XBF16>(xs, (size_t)(m - SEQ));
        f32x4 v[16]; float s = 0.f;
#pragma unroll
        for (int j = 0; j < 16; ++j) { v[j] = ldx4<XBF16>(xr, lane + 64 * j); s += (v[j].x * v[j].x + v[j].y * v[j].y) + (v[j].z * v[j].z + v[j].w * v[j].w); }
        const float rstd = 1.0f / sqrtf(wave_sum(s) * (1.f / D) + EPS);
        const GAS f32x4* gr = (const GAS f32x4*)g + lane;
        const GAS f32x4* shr = (const GAS f32x4*)(mrow + (size_t)ish * D) + lane;
        const GAS f32x4* scr = (const GAS f32x4*)(mrow + (size_t)isc * D) + lane;
#pragma unroll
        for (int j = 0; j < 16; ++j) { const f32x4 gg = gr[64 * j], sh = shr[64 * j], sc = scr[64 * j];
            normmod_store<FP8OUT>(H, m, lane, j, (v[j] * rstd) * gg * (sc + 1.0f) + sh); }
    }
    __syncthreads();
}
__device__ __forceinline__ void final_norm_phase(Frame& F, const bf16* X1, const float* g, float* out) {
    const int gw = F.vcu * NWAVES + F.wave, NGW = F.G * NWAVES, lane = F.lane;
    LAS f32x4* lg = (LAS f32x4*)F.lds;
    for (int i = F.tid; i < D / 4; i += NWAVES * 64) lg[i] = *((const GAS f32x4*)g + i);
    __syncthreads();
    if (gw >= M) return;
    f32x4 cur[16], nx[16];
#pragma unroll
    for (int j = 0; j < 16; ++j) cur[j] = ldx4<true>(X1 + (size_t)gw * D, lane + 64 * j);
#pragma unroll 1
    for (int m = gw; m < M; m += NGW) {
        asm volatile("" ::: "memory");
        const int mn = (m + NGW < M) ? m + NGW : m;
#pragma unroll
        for (int j = 0; j < 16; ++j) nx[j] = ldx4<true>(X1 + (size_t)mn * D, lane + 64 * j);
        float s = 0.f;
#pragma unroll
        for (int j = 0; j < 16; ++j) s += (cur[j].x * cur[j].x + cur[j].y * cur[j].y) + (cur[j].z * cur[j].z + cur[j].w * cur[j].w);
        const float rstd = 1.0f / sqrtf(wave_sum(s) * (1.f / D) + EPS);
        GAS f32x4* o = (GAS f32x4*)(out + ((m < SEQ) ? O_YP + (size_t)m * D : O_YS + (size_t)(m - SEQ) * D)) + lane;
#pragma unroll
        for (int j = 0; j < 16; ++j) o[64 * j] = (cur[j] * rstd) * lg[lane + 64 * j];
#pragma unroll
        for (int j = 0; j < 16; ++j) cur[j] = nx[j];
    }
}

namespace att {
constexpr int KROW = 272, VROW = 528;
constexpr int K_OFF = 0, V_OFF = 256 * KROW, LUT_OFF = V_OFF + 128 * VROW, LUT_STRIDE = 132;
constexpr int ATT_LDS = LUT_OFF + 4 * LUT_STRIDE * 4;
static_assert(ATT_LDS <= LDSCTL_OFF, "attention LDS image below the control words");
constexpr float SCALE = 0.08838834764831845f;
__device__ __forceinline__ int t5_bucket(int n) {
    if (n < 16) return n;
    int b = 16;
    b += (n >= 19); b += (n >= 21); b += (n >= 24); b += (n >= 27); b += (n >= 31); b += (n >= 35); b += (n >= 40); b += (n >= 46);
    b += (n >= 52); b += (n >= 59); b += (n >= 67); b += (n >= 77); b += (n >= 87); b += (n >= 99); b += (n >= 113);
    return b;
}
__device__ __forceinline__ int vslot(int kidx) { return (kidx & ~15) | (8 * ((kidx >> 2) & 1) + 4 * ((kidx >> 3) & 1) + (kidx & 3)); }
__device__ __forceinline__ void fill_lut(LAS unsigned char* lds, const float* rel_bias, int hk, int tid) {
    LAS float* lut = (LAS float*)(lds + LUT_OFF);
    for (int i = tid; i < 4 * 129; i += NWAVES * 64) { const int g = i / 129, dist = i % 129; lut[g * LUT_STRIDE + dist] = rel_bias[t5_bucket(dist) * NHEAD + 4 * hk + g]; }
}
template <int NT>
__device__ __forceinline__ void attn_qtile(const LAS unsigned char* lds, int ktile0, const bf16x8 (&Q)[8], int r, int kmin, int kmax, int g, float sink, bf16* orow, int lane) {
    const int c = lane & 31, h = lane >> 5;
    f32x16 X[NT];
#pragma unroll
    for (int t = 0; t < NT; ++t) {
#pragma unroll
        for (int i = 0; i < 16; ++i) X[t][i] = 0.f;
#pragma unroll
        for (int ks = 0; ks < 8; ++ks) { const bf16x8 kf = *(const LAS bf16x8*)(lds + K_OFF + (32 * (ktile0 + t) + c) * KROW + (16 * ks + 8 * h) * 2);
            X[t] = __builtin_amdgcn_mfma_f32_32x32x16_bf16(kf, Q[ks], X[t], 0, 0, 0); }
    }
    const LAS float* lut = (const LAS float*)(lds + LUT_OFF) + g * LUT_STRIDE;
    float mx = sink;
#pragma unroll
    for (int t = 0; t < NT; ++t)
#pragma unroll
        for (int i = 0; i < 16; ++i) { const int kidx = 32 * (ktile0 + t) + (i & 3) + 8 * (i >> 2) + 4 * h; const int dist = 128 + r - kidx;
            const bool valid = (dist >= 0) && (dist <= 128) && (kidx >= kmin) && (kidx < kmax);
            const int di = dist < 0 ? 0 : (dist > 128 ? 128 : dist);
            float s = X[t][i] * SCALE + lut[di]; s = valid ? s : -1e30f; X[t][i] = s; mx = fmaxf(mx, s); }
    mx = fmaxf(mx, __shfl_xor(mx, 32));
    float sum = 0.f;
#pragma unroll
    for (int t = 0; t < NT; ++t)
#pragma unroll
        for (int i = 0; i < 16; ++i) { const float p = __expf(X[t][i] - mx); X[t][i] = p; sum += p; }
    sum += __shfl_xor(sum, 32);
    const float inv = 1.0f / (sum + __expf(sink - mx));
    f32x16 O[4];
#pragma unroll
    for (int dt = 0; dt < 4; ++dt)
#pragma unroll
        for (int i = 0; i < 16; ++i) O[dt][i] = 0.f;
#pragma unroll
    for (int t = 0; t < NT; ++t)
#pragma unroll
        for (int s = 0; s < 2; ++s) {
            v4u pw; pw.x = pg8::cvt_pk_bf16(X[t][8 * s + 0], X[t][8 * s + 1]); pw.y = pg8::cvt_pk_bf16(X[t][8 * s + 2], X[t][8 * s + 3]);
            pw.z = pg8::cvt_pk_bf16(X[t][8 * s + 4], X[t][8 * s + 5]); pw.w = pg8::cvt_pk_bf16(X[t][8 * s + 6], X[t][8 * s + 7]);
            const bf16x8 pf = __builtin_bit_cast(bf16x8, pw);
#pragma unroll
            for (int dt = 0; dt < 4; ++dt) { const bf16x8 vf = *(const LAS bf16x8*)(lds + V_OFF + (32 * dt + c) * VROW + (32 * (ktile0 + t) + 16 * s + 8 * h) * 2);
                O[dt] = __builtin_amdgcn_mfma_f32_32x32x16_bf16(vf, pf, O[dt], 0, 0, 0); }
        }
#pragma unroll
    for (int dt = 0; dt < 4; ++dt)
#pragma unroll
        for (int i = 0; i < 4; ++i) { v2u w; w.x = pk2(O[dt][4 * i + 0] * inv, O[dt][4 * i + 1] * inv); w.y = pk2(O[dt][4 * i + 2] * inv, O[dt][4 * i + 3] * inv);
            *(GAS v2u*)(orow + 32 * dt + 8 * i + 4 * h) = w; }
}
__device__ __forceinline__ void stage_kv(LAS unsigned char* lds, int kidx, int ch, v4u kq, v4u vq) {
    *(LAS v4u*)(lds + K_OFF + kidx * KROW + ch * 16) = kq;
    LAS unsigned short* vt = (LAS unsigned short*)(lds + V_OFF + (8 * ch) * VROW) + vslot(kidx);
    vt[0 * (VROW / 2)] = (unsigned short)(vq.x & 0xffffu); vt[1 * (VROW / 2)] = (unsigned short)(vq.x >> 16);
    vt[2 * (VROW / 2)] = (unsigned short)(vq.y & 0xffffu); vt[3 * (VROW / 2)] = (unsigned short)(vq.y >> 16);
    vt[4 * (VROW / 2)] = (unsigned short)(vq.z & 0xffffu); vt[5 * (VROW / 2)] = (unsigned short)(vq.z >> 16);
    vt[6 * (VROW / 2)] = (unsigned short)(vq.w & 0xffffu); vt[7 * (VROW / 2)] = (unsigned short)(vq.w >> 16);
}
__device__ __forceinline__ void store8_f32(float* dst, v4u q) {
    *(GAS f32x4*)dst = (f32x4){bf_lo(q.x), bf_hi(q.x), bf_lo(q.y), bf_hi(q.y)};
    *(GAS f32x4*)(dst + 4) = (f32x4){bf_lo(q.z), bf_hi(q.z), bf_lo(q.w), bf_hi(q.w)};
}
__device__ __forceinline__ void prompt_unit(Frame& F, const Args& A, int b, int hk) {
    const bf16* PROJ = (const bf16*)(A.ws + WS_PROJ); bf16* MIX = (bf16*)(A.ws + WS_MIX);
    LAS unsigned char* lds = F.lds;
    fill_lut(lds, A.in[I_RB], hk, F.tid);
    v4u kqa[8], vqa[8];
#pragma unroll
    for (int i = 0; i < 8; ++i) { const int cid = F.tid + 512 * i, kidx = cid >> 4, ch = cid & 15; const int row = 128 * (b - 1) + kidx, rowc = row < 0 ? 0 : row;
        const bf16* p = PROJ + (size_t)rowc * NPROJ + 128 * hk + 8 * ch; kqa[i] = *(const GAS v4u*)(p + C_K); vqa[i] = *(const GAS v4u*)(p + C_V); }
#pragma unroll
    for (int i = 0; i < 8; ++i) { const int cid = F.tid + 512 * i, kidx = cid >> 4, ch = cid & 15; const int row = 128 * (b - 1) + kidx;
        v4u kq = kqa[i], vq = vqa[i];
        if (row < 0) { kq = (v4u){0u, 0u, 0u, 0u}; vq = (v4u){0u, 0u, 0u, 0u}; }
        stage_kv(lds, kidx, ch, kq, vq);
        if (b == SEQ / 128 - 1 && kidx >= 128) {
            store8_f32(A.out + O_KWP + (size_t)(kidx - 128) * 512 + 128 * hk + 8 * ch, kq);
            store8_f32(A.out + O_VWP + (size_t)(kidx - 128) * 512 + 128 * hk + 8 * ch, vq); }
    }
    __syncthreads();
    const int g = F.wave >> 1, half = F.wave & 1, c = F.lane & 31, h = F.lane >> 5, head = 4 * hk + g;
    const float sink = A.in[I_SINK][head];
#pragma unroll 1
    for (int qt = 0; qt < 2; ++qt) { const int r = 64 * half + 32 * qt + c, row = 128 * b + r;
        bf16x8 Q[8];
#pragma unroll
        for (int ks = 0; ks < 8; ++ks) Q[ks] = *(const GAS bf16x8*)(PROJ + (size_t)row * NPROJ + 128 * head + 16 * ks + 8 * h);
        attn_qtile<5>(lds, 2 * half + qt, Q, r, b == 0 ? 128 : 0, 256, g, sink, MIX + (size_t)row * D + 128 * head, F.lane);
    }
    __syncthreads();
}
__device__ __forceinline__ void sample_unit(Frame& F, const Args& A, int s, int hk) {
    const bf16* PROJ = (const bf16*)(A.ws + WS_PROJ); bf16* MIX = (bf16*)(A.ws + WS_MIX);
    LAS unsigned char* lds = F.lds;
    fill_lut(lds, A.in[I_RB], hk, F.tid);
    {
        const int ch = F.tid & 15, kb0 = F.tid >> 4;
        f32x4 ck[4][2], cv[4][2];
#pragma unroll
        for (int i = 0; i < 4; ++i) { const size_t off = (((size_t)s * 128 + kb0 + 32 * i) * 4 + hk) * 128 + 8 * ch;
            ck[i][0] = *(const GAS f32x4*)(A.in[I_CK] + off); ck[i][1] = *(const GAS f32x4*)(A.in[I_CK] + off + 4);
            cv[i][0] = *(const GAS f32x4*)(A.in[I_CV] + off); cv[i][1] = *(const GAS f32x4*)(A.in[I_CV] + off + 4); }
        const int kn = 128 + kb0, knc = kn < 136 ? kn : 135;
        const bf16* pn = PROJ + (size_t)(SEQ + 8 * s + (knc - 128)) * NPROJ + 128 * hk + 8 * ch;
        v4u nkq = *(const GAS v4u*)(pn + C_K), nvq = *(const GAS v4u*)(pn + C_V);
#pragma unroll
        for (int i = 0; i < 4; ++i) { const int kidx = kb0 + 32 * i; const f32x4 k0 = ck[i][0], k1 = ck[i][1], v0 = cv[i][0], v1 = cv[i][1];
            const v4u kq = (v4u){pg8::cvt_pk_bf16(k0[0], k0[1]), pg8::cvt_pk_bf16(k0[2], k0[3]), pg8::cvt_pk_bf16(k1[0], k1[1]), pg8::cvt_pk_bf16(k1[2], k1[3])};
            const v4u vq = (v4u){pg8::cvt_pk_bf16(v0[0], v0[1]), pg8::cvt_pk_bf16(v0[2], v0[3]), pg8::cvt_pk_bf16(v1[0], v1[1]), pg8::cvt_pk_bf16(v1[2], v1[3])};
            if (kidx >= 8) {
                float* ko = A.out + O_KWS + (((size_t)s * 128 + (kidx - 8)) * 4 + hk) * 128 + 8 * ch; *(GAS f32x4*)ko = k0; *(GAS f32x4*)(ko + 4) = k1;
                float* vo = A.out + O_VWS + (((size_t)s * 128 + (kidx - 8)) * 4 + hk) * 128 + 8 * ch; *(GAS f32x4*)vo = v0; *(GAS f32x4*)(vo + 4) = v1; }
            stage_kv(lds, kidx, ch, kq, vq); }
        if (kn < 136) {
            store8_f32(A.out + O_KWS + (((size_t)s * 128 + (kn - 8)) * 4 + hk) * 128 + 8 * ch, nkq);
            store8_f32(A.out + O_VWS + (((size_t)s * 128 + (kn - 8)) * 4 + hk) * 128 + 8 * ch, nvq);
        } else { nkq = (v4u){0u, 0u, 0u, 0u}; nvq = (v4u){0u, 0u, 0u, 0u}; }
        stage_kv(lds, kn, ch, nkq, nvq);
    }
    __syncthreads();
    if (F.wave == 0) {
        const int c = F.lane & 31, h = F.lane >> 5, g = c >> 3, t = c & 7, head = 4 * hk + g, row = SEQ + 8 * s + t;
        const float sink = A.in[I_SINK][head];
        bf16x8 Q[8];
#pragma unroll
        for (int ks = 0; ks < 8; ++ks) Q[ks] = *(const GAS bf16x8*)(PROJ + (size_t)row * NPROJ + 128 * head + 16 * ks + 8 * h);
        attn_qtile<5>(lds, 0, Q, t, 0, 136, g, sink, MIX + (size_t)row * D + 128 * head, F.lane);
    }
    __syncthreads();
}
__device__ __forceinline__ f32x4 ld4bf(const bf16* p) { const v2u q = *(const GAS v2u*)p; return (f32x4){bf_lo(q.x), bf_hi(q.x), bf_lo(q.y), bf_hi(q.y)}; }
__device__ __forceinline__ void conv_item(Frame& F, const Args& A, int item) {
    const bf16* PROJ = (const bf16*)(A.ws + WS_PROJ); bf16* MIX = (bf16*)(A.ws + WS_MIX);
    const int sl = item >> 3, r0 = 8 * sl, c0 = 256 * (item & 7) + 4 * F.lane;
    const f32x4 w0 = *(const GAS f32x4*)(A.in[I_CW] + c0), w1 = *(const GAS f32x4*)(A.in[I_CW] + 2048 + c0), w2 = *(const GAS f32x4*)(A.in[I_CW] + 4096 + c0);
#define load4(row, col) ld4bf(PROJ + (size_t)(row) * NPROJ + (col) + c0)
    f32x4 u[10], gb[8];
    if (r0 >= SEQ) { const int s = (r0 - SEQ) >> 3;
        u[0] = *(const GAS f32x4*)(A.in[I_SC] + ((size_t)s * 2 + 0) * 2048 + c0); u[1] = *(const GAS f32x4*)(A.in[I_SC] + ((size_t)s * 2 + 1) * 2048 + c0); }
    else if (r0 == 0) { u[0] = (f32x4){0.f, 0.f, 0.f, 0.f}; u[1] = u[0]; }
    else { u[0] = load4(r0 - 2, C_GC) * load4(r0 - 2, C_HC); u[1] = load4(r0 - 1, C_GC) * load4(r0 - 1, C_HC); }
#pragma unroll
    for (int i = 0; i < 8; ++i) { u[2 + i] = load4(r0 + i, C_GC) * load4(r0 + i, C_HC); gb[i] = load4(r0 + i, C_GB); }
#pragma unroll
    for (int i = 0; i < 8; ++i) { const int row = r0 + i;
        const f32x4 y = gb[i] * (w0 * u[i] + w1 * u[i + 1] + w2 * u[i + 2]);
        v2u w; w.x = pg8::cvt_pk_bf16(y.x, y.y); w.y = pg8::cvt_pk_bf16(y.z, y.w); *(GAS v2u*)(MIX + (size_t)row * D + 2048 + c0) = w;
        if (i >= 6) {
            if (r0 == SEQ - 8) *(GAS f32x4*)(A.out + O_CP + (size_t)(i - 6) * 2048 + c0) = u[2 + i];
            if (r0 >= SEQ) *(GAS f32x4*)(A.out + O_CS + ((size_t)((r0 - SEQ) >> 3) * 2 + (i - 6)) * 2048 + c0) = u[2 + i]; } }
#undef load4
}
__device__ __forceinline__ void mixer_phase(Frame& F, const Args& A) {
#ifndef PROBE_P7
#define PROBE_P7 0
#endif
    for (int u = F.vcu; u < 256 * (PROBE_P7 == 1 ? 2 : 1); u += F.G) prompt_unit(F, A, (u & 255) >> 2, u & 3);
    for (int u = F.vcu; u < 512 * (PROBE_P7 == 2 ? 2 : 1); u += F.G) sample_unit(F, A, (u & 511) >> 2, u & 3);
    for (int u = F.vcu * NWAVES + F.wave; u < (M / 8) * 8 * (PROBE_P7 == 3 ? 2 : 1); u += F.G * NWAVES) conv_item(F, A, u % ((M / 8) * 8));
}
}

constexpr int N_PHASES = 13;
__global__ void __launch_bounds__(NWAVES * 64, 2) mk_fwd(Args args) {
    extern __shared__ __attribute__((aligned(16))) unsigned char lds[];
    Frame F;
    F.lds = (LAS unsigned char*)lds;
    F.MISC = (volatile LAS unsigned*)(F.lds + MISC_OFF);
    F.tid = threadIdx.x; F.lane = F.tid & 63; F.wave = __builtin_amdgcn_readfirstlane(F.tid >> 6);
    F.G = gridDim.x; { const int bx = blockIdx.x; F.vcu = (F.G % 8 == 0) ? (bx % 8) * (F.G / 8) + bx / 8 : bx; }
    unsigned char* ws = args.ws;
    F.ctl = (gu32*)(ws + WS_CTL);
    for (int u = F.tid; u < (LDS_BYTES - LDSCTL_OFF) / 4; u += NWAVES * 64) ((LAS unsigned*)(F.lds + LDSCTL_OFF))[u] = 0u;
    __syncthreads();
    XcdBarrier bar = xcd_barrier_post((unsigned*)(F.ctl + CW_BAR), F.MISC + 8);
    const int lo = args.ph_lo, hi = args.ph_hi;
#define IN(k) (lo <= (k) && (k) < hi)
#ifndef PROBE_PHASE
#define PROBE_PHASE -1
#endif
#define REPS(k) ((PROBE_PHASE == (k)) ? 2 : 1)
#define SEAM(k) do { if (IN(k) && IN((k) + 1)) xcd_barrier(bar); } while (0)
    bf16* W13A = (bf16*)(ws + WS_W13A); bf16* W2A = (bf16*)(ws + WS_W2A); bf16* WINT = (bf16*)(ws + WS_WIN); bf16* WOUT = (bf16*)(ws + WS_WOUT);
    bf16* W13B = (bf16*)(ws + WS_W13B); bf16* W2B = (bf16*)(ws + WS_W2B); bf16* WADA = (bf16*)(ws + WS_WADA); bf16* CSI = (bf16*)(ws + WS_CSI);
    float* MOD = (float*)(ws + WS_MOD); bf16* X1 = (bf16*)(ws + WS_X1);     bf16* H = (bf16*)(ws + WS_H); bf16* T = (bf16*)(ws + WS_T);
    bf16* PROJ = (bf16*)(ws + WS_PROJ); bf16* MIX = (bf16*)(ws + WS_MIX);
    const int cb = (int)blockIdx.x;

    if (IN(0)) {
#pragma unroll
        for (int rep = 0; rep < REPS(0); ++rep) { if (rep) xcd_barrier(bar);  csilu_phase(F, args); { const int rank = F.vcu * NWAVES + F.wave, nw = F.G * NWAVES; conv_job<JOB_W1A>(F, args, rank, nw); conv_job<JOB_W3A>(F, args, rank, nw); conv_job<JOB_WIN>(F, args, rank, nw); }  } } SEAM(0);
    if (IN(1)) {
#pragma unroll
        for (int rep = 0; rep < REPS(1); ++rep) { if (rep) xcd_barrier(bar); mod_chunk_partials(F, args, 0, F.vcu, F.G); } } SEAM(1);
    if (IN(2)) {
#pragma unroll
        for (int rep = 0; rep < REPS(2); ++rep) { if (rep) xcd_barrier(bar);  mod_combine(F, args, 0); xcd_barrier(bar); normmod_phase<true, false>(F, args.in[I_XP], args.in[I_XS], args.in[I_G1], MOD, 0, 1, H);  } } SEAM(2);
    if (IN(3)) {
#pragma unroll
        for (int rep = 0; rep < REPS(3); ++rep) { if (rep) xcd_barrier(bar);  pg8::Gemm g{H, W13A, M, 2 * FF, D / 2}; pg8::StaticOrder S; S.init(M, 2 * FF, F.G, cb);
        pg8::EpiSwiGLU8 E{(unsigned char*)T, FF, 1.0f / (S_H * S_W13), S_T};
        #if UP_CUT
#pragma unroll 1
        for (int sb = 0; sb < S.nwg; sb += UP_CUT) { if (sb) xcd_barrier(bar); S.sub(sb, (sb + 2 * UP_CUT > S.nwg) ? S.nwg : sb + UP_CUT);
            pg8::gemm_phase<pg8::EpiSwiGLU8, pg8::StaticOrder, PG8_ALIGN, PG8_SP2, true>(F.lds + RING_OFF, g, S, E); if (sb + 2 * UP_CUT > S.nwg) break; }
#else
        pg8::gemm_phase<pg8::EpiSwiGLU8, pg8::StaticOrder, PG8_ALIGN, PG8_SP2, true>(F.lds + RING_OFF, g, S, E);
#endif
#if PROBE_GEMM
        { xcd_barrier(bar); pg8::DegenOrder S2; S2.init(M, 2 * FF, F.G, cb); pg8::EpiNull E2{(float*)(ws + WS_PART)};
          pg8::gemm_phase<pg8::EpiNull, pg8::DegenOrder, PG8_ALIGN, PG8_SP2, true, PROBE_GEMM - 1>(F.lds + RING_OFF, g, S2, E2); xcd_barrier(bar); }
#endif
        if (rep == 0) { const int left = ((M / 256) * (2 * FF / 256)) % F.G;
            if (cb >= left) { const int rank = (cb - left) * NWAVES + F.wave, nw = (F.G - left) * NWAVES; conv_job<JOB_W2A>(F, args, rank, nw); } } } } SEAM(3);
    if (IN(4)) {
#pragma unroll
        for (int rep = 0; rep < REPS(4); ++rep) { if (rep) xcd_barrier(bar);  pg8::Gemm g{T, W2A, M, D, FF / 2}; pg8::StaticOrder S; S.init(M, D, F.G, cb);
        pg8::EpiResid<true, false> E{args.in[I_XP], args.in[I_XS], X1, MOD, D, MODW, 2 * D, SEQ, 0.5f / (S_T * S_W2)};
        pg8::gemm_phase<pg8::EpiResid<true, false>, pg8::StaticOrder, PG8_ALIGN, PG8_SP2, true>(F.lds + RING_OFF, g, S, E);
        if (rep == 0) { const int left = ((M / 256) * (D / 256)) % F.G;
            if (cb >= left) { const int ir = cb - left, ni = F.G - left;
                mod_chunk_partials(F, args, 1, ir, ni); __syncthreads(); {     const int rank = ir * NWAVES + F.wave, nw = ni * NWAVES; conv_job<JOB_W1B>(F, args, rank, nw); } } } } } SEAM(4);
    if (IN(5)) { mod_combine(F, args, 1); xcd_barrier(bar); normmod_phase<false, true>(F, X1, X1 + (size_t)SEQ * D, args.in[I_GM], MOD, 3, 4, H); } SEAM(5);
    if (IN(6)) {
#pragma unroll
        for (int rep = 0; rep < REPS(6); ++rep) { if (rep) xcd_barrier(bar);  pg8::Gemm g{H, WINT, M, NPROJ, D}; pg8::StaticOrder S; S.init(M, NPROJ, F.G, cb);
        pg8::EpiBf16 E{PROJ, NPROJ};
        pg8::gemm_phase<pg8::EpiBf16, pg8::StaticOrder, PG8_ALIGN, PG8_SP2>(F.lds + RING_OFF, g, S, E);
        if (rep == 0) { const int left = ((M / 256) * (NPROJ / 256)) % F.G;
            if (cb >= left) { const int ir = cb - left, ni = F.G - left;
                mod_chunk_partials(F, args, 2, ir, ni); __syncthreads(); { const int rank = ir * NWAVES + F.wave, nw = ni * NWAVES; conv_job<JOB_WOUT>(F, args, rank, nw); conv_job<JOB_W3B>(F, args, rank, nw); } } } } } SEAM(6);
    if (IN(7)) {
#pragma unroll
        for (int rep = 0; rep < REPS(7); ++rep) { if (rep) xcd_barrier(bar);  att::mixer_phase(F, args);  } } SEAM(7);
    if (IN(8)) { pg8::Gemm g{MIX, WOUT, M, D, D}; pg8::StaticOrder S; S.init(M, D, F.G, cb);
        pg8::EpiResid<true, true> E{X1, X1 + (size_t)SEQ * D, X1, MOD, D, MODW, 5 * D, SEQ, 1.0f};
        pg8::gemm_phase<pg8::EpiResid<true, true>, pg8::StaticOrder, PG8_ALIGN, PG8_SP2>(F.lds + RING_OFF, g, S, E);
        { const int left = ((M / 256) * (D / 256)) % F.G;
            if (cb >= left) { const int rank = (cb - left) * NWAVES + F.wave, nw = (F.G - left) * NWAVES; conv_job<JOB_W2B>(F, args, rank, nw); } } } SEAM(8);
    if (IN(9)) { mod_combine(F, args, 2); xcd_barrier(bar); normmod_phase<true, true>(F, X1, X1 + (size_t)SEQ * D, args.in[I_G2], MOD, 6, 7, H); } SEAM(9);
    if (IN(10)) { pg8::Gemm g{H, W13B, M, 2 * FF, D / 2}; pg8::ListOrder S; { pg8::SkOrder K; K.init(M, 2 * FF, D / 2, F.G, cb); S.list = (const LAS int*)(F.lds + SKLIST_OFF); S.n = pg8::sk_build_list(K, (LAS int*)(F.lds + SKLIST_OFF)); }
        S.slots = (float*)(ws + WS_SKS); S.counters = (unsigned*)(F.ctl + CW_SK + 0 * CW_SK_STRIDE);
        pg8::EpiSwiGLU8 E{(unsigned char*)T, FF, 1.0f / (S_H * S_W13), S_T};
        pg8::gemm_phase<pg8::EpiSwiGLU8, pg8::ListOrder, PG8_ALIGN, PG8_SP2, true>(F.lds + RING_OFF, g, S, E); } SEAM(10);
    if (IN(11)) { pg8::Gemm g{T, W2B, M, D, FF / 2}; pg8::ListOrder S; { pg8::SkOrder K; K.init(M, D, FF / 2, F.G, cb); S.list = (const LAS int*)(F.lds + SKLIST_OFF); S.n = pg8::sk_build_list(K, (LAS int*)(F.lds + SKLIST_OFF)); }
        S.slots = (float*)(ws + WS_SKS2); S.counters = (unsigned*)(F.ctl + CW_SK + 1 * CW_SK_STRIDE);
        pg8::EpiResid<false, true> E{X1, X1 + (size_t)SEQ * D, X1, MOD, D, MODW, 8 * D, SEQ, 0.5f / (S_T * S_W2)};
        pg8::gemm_phase<pg8::EpiResid<false, true>, pg8::ListOrder, PG8_ALIGN, PG8_SP2, true>(F.lds + RING_OFF, g, S, E); } SEAM(11);
    if (IN(12)) { final_norm_phase(F, X1, args.in[I_GF], args.out); }
#undef IN
#undef SEAM
}

extern "C" void kernel_launch(void* const* d_in, const int* in_sizes, int n_in, void* d_out, int out_size, void* d_ws, size_t ws_size, hipStream_t stream) {
    static int grid = 0;
    if (grid == 0) {
        if (n_in != N_IN || (size_t)out_size != O_END || ws_size < WS_END) { fprintf(stderr, "kernel_launch: unexpected shapes: n_in %d out %d ws %zu (need %zu)\n", n_in, out_size, ws_size, (size_t)WS_END); grid = -1; return; }
        int dev = 0, cus = 0, per_cu = 0;
        if (hipGetDevice(&dev) != hipSuccess || hipDeviceGetAttribute(&cus, hipDeviceAttributeMultiprocessorCount, dev) != hipSuccess) { grid = -1; return; }
        if (hipFuncSetAttribute((const void*)mk_fwd, hipFuncAttributeMaxDynamicSharedMemorySize, LDS_BYTES) != hipSuccess) { fprintf(stderr, "kernel_launch: hipFuncSetAttribute failed\n"); grid = -1; return; }
        if (hipOccupancyMaxActiveBlocksPerMultiprocessor(&per_cu, (const void*)mk_fwd, NWAVES * 64, LDS_BYTES) != hipSuccess || per_cu < 1) { fprintf(stderr, "kernel_launch: occupancy query says %d\n", per_cu); }
        (void)hipGetLastError();
        grid = cus;
    }
    if (grid < 0) return;
    if (hipMemsetAsync((char*)d_ws + WS_CTL, 0, CTL_ZERO_BYTES, stream) != hipSuccess) return;
    Args a{};
    for (int i = 0; i < N_IN; ++i) a.in[i] = (const float*)d_in[i];
    a.out = (float*)d_out; a.ws = (unsigned char*)d_ws;
#if MK_PER_PHASE
    for (int p = 0; p < N_PHASES; ++p) { a.ph_lo = p; a.ph_hi = p + 1; hipLaunchKernelGGL(mk_fwd, dim3(grid), dim3(NWAVES * 64), LDS_BYTES, stream, a); }
#else
    a.ph_lo = 0; a.ph_hi = N_PHASES;
    hipLaunchKernelGGL(mk_fwd, dim3(grid), dim3(NWAVES * 64), LDS_BYTES, stream, a);
#endif
    const hipError_t le = hipPeekAtLastError();
    if (le != hipSuccess) fprintf(stderr, "kernel_launch: launch failed: %s\n", hipGetErrorName(le));
}
```

```cpp
#include <hip/hip_runtime.h>
#include <cstdio>
#include <cstdint>
#ifndef PG8_LOADPRIO
#define PG8_LOADPRIO 0
#endif
namespace pg8 {
#define PG8_LAS __attribute__((address_space(3)))
typedef unsigned short bf16_t;
typedef short bf16x8 __attribute__((ext_vector_type(8)));
typedef float f32x4 __attribute__((ext_vector_type(4)));
typedef unsigned u32x4 __attribute__((ext_vector_type(4)));
typedef unsigned u32x2 __attribute__((ext_vector_type(2)));
typedef int i32x4 __attribute__((ext_vector_type(4)));
typedef int i32x8 __attribute__((ext_vector_type(8)));
__device__ __forceinline__ i32x8 cat8(bf16x8 lo, bf16x8 hi) { return __builtin_shufflevector(__builtin_bit_cast(i32x4, lo), __builtin_bit_cast(i32x4, hi), 0, 1, 2, 3, 4, 5, 6, 7); }
__device__ __forceinline__ unsigned cvt4_fp8(float a, float b, float c, float d) {
    a = __builtin_fminf(__builtin_fmaxf(a, -448.f), 448.f); b = __builtin_fminf(__builtin_fmaxf(b, -448.f), 448.f);
    c = __builtin_fminf(__builtin_fmaxf(c, -448.f), 448.f); d = __builtin_fminf(__builtin_fmaxf(d, -448.f), 448.f);
    int w = 0; w = __builtin_amdgcn_cvt_pk_fp8_f32(a, b, w, false); w = __builtin_amdgcn_cvt_pk_fp8_f32(c, d, w, true); return (unsigned)w; }
constexpr int BM = 256, BK = 64, HALF = 128, HTB = HALF * BK * 2  , STAGE_BYTES = 8 * HTB, NXCD = 8, WGM = 8;

__host__ __device__ __forceinline__ int lds_byte(int r, int c) { const int st = (r >> 4) * 2 + (c >> 5), rr = r & 15, cc = c & 31, ob = rr * 64 + cc * 2; return st * 1024 + (ob ^ (((ob >> 9) & 1) << 5)); }
__host__ __device__ __forceinline__ void stage_rc(int b, int& R, int& C) { const int st = b / 1024, sb = b % 1024, swz = sb ^ (((sb >> 9) & 1) << 5); R = (st >> 1) * 16 + swz / 64; C = (st & 1) * 32 + (swz % 64) / 2; }
__host__ __device__ __forceinline__ int perm32(int rho) { const int n = rho >> 4, i = rho & 15; return 8 * (i >> 2) + 4 * n + (i & 3); }

struct Unit { int pm, pn, kb, ke, kind, slot; };
struct Gemm { const bf16_t* A; const bf16_t* Bt; int M, N, K; };

struct StaticOrder {
    static constexpr bool SK = false;
    int nM, nN, nwg, G, c, base, lim;
    __host__ __device__ void init(int M, int N, int G_, int c_) { nM = M / BM; nN = N / BM; nwg = nM * nN; G = G_; c = c_; base = 0; lim = nwg; }
    __host__ __device__ void sub(int b, int l) { base = b; lim = l < nwg ? l : nwg; }
    __host__ __device__ bool next(int i, Unit& u) const {
        const long L = (long)base + (long)i * G + c; if (L >= lim) return false;
        int wgid = (int)L; { const int q = nwg / NXCD, r = nwg % NXCD, xcd = wgid % NXCD, off = wgid / NXCD; wgid = (xcd < r ? xcd * (q + 1) : r * (q + 1) + (xcd - r) * q) + off; }
        const int nig = WGM * nN, gid = wgid / nig, fm = gid * WGM, gsz = (nM - fm) < WGM ? (nM - fm) : WGM;
        u.pm = fm + ((wgid % nig) % gsz); u.pn = (wgid % nig) / gsz; return true;
    }
    __device__ __forceinline__ void a_ready(const Unit&) const {}
    __device__ __forceinline__ void done(const Unit&) const {}
};

struct DegenOrder {
    static constexpr bool SK = false;
    int nwg, G, c;
    __device__ __forceinline__ void init(int M, int N, int G_, int c_) { nwg = (M / BM) * (N / BM); G = G_; c = c_; }
    __device__ __forceinline__ bool next(int i, Unit& u) const { if ((long)i * G + c >= nwg) return false; u.pm = 0; u.pn = 0; return true; }
    __device__ __forceinline__ void a_ready(const Unit&) const {}
    __device__ __forceinline__ void done(const Unit&) const {}
};
struct SkOrder {
    int nM, nN, nwg, G, c, Rs, cnt8, qq, nt, np, q, ufirst, ulast, nsk; long s, e;
    __device__ __forceinline__ void init(int M, int N, int Kbf, int G_, int c_) {
        nM = M / BM; nN = N / BM; nwg = nM * nN; G = G_; c = c_; nt = Kbf / BK; np = nt / 2;
        if (G != 256 || (nwg % 8) != 0 || nwg < 2 * G) { Rs = (nwg + G - 1) / G; nsk = 0; qq = nwg / 8; cnt8 = 0; q = 0; s = e = 0; ufirst = ulast = 0; return; }
        Rs = nwg / G - 1; const int usk = nwg - Rs * G; cnt8 = usk / 8; qq = nwg / 8; q = (c % 8) * 32 + c / 8;
        const long P = (long)usk * np; s = (long)q * P / G; e = (long)(q + 1) * P / G;
        ufirst = (int)(s / np); ulast = (int)((e - 1) / np); nsk = ulast - ufirst + 1;
    }
    __device__ __forceinline__ void tile_of(int wgid, Unit& u) const { const int nig = WGM * nN, gid = wgid / nig, fm = gid * WGM, gsz = (nM - fm) < WGM ? (nM - fm) : WGM; u.pm = fm + ((wgid % nig) % gsz); u.pn = (wgid % nig) / gsz; }
    __device__ __forceinline__ bool next(int i, Unit& u) const {
        if (i < Rs) { const long L = (long)i * G + c; if (L >= nwg) return false;
            int wgid = (int)L; { const int qv = nwg / NXCD, r = nwg % NXCD, xcd = wgid % NXCD, off = wgid / NXCD; wgid = (xcd < r ? xcd * (qv + 1) : r * (qv + 1) + (xcd - r) * qv) + off; }
            tile_of(wgid, u); u.kb = 0; u.ke = nt; u.kind = 0; u.slot = 0; return true; }
        const int j = i - Rs; if (j >= nsk) return false;
        const int un = ufirst + j; tile_of((un / cnt8) * qq + 32 * Rs + (un % cnt8), u);
        u.kb = (j == 0) ? 2 * (int)(s - (long)ufirst * np) : 0; u.ke = (un == ulast) ? 2 * (int)(e - (long)ulast * np) : nt;
        u.kind = (u.kb > 0) ? 1 : ((u.ke < nt) ? 2 : 0); u.slot = (u.kind == 1) ? q : q + 1; return true;
    }
    __device__ __forceinline__ int count() const { return Rs + nsk; }
};

struct ListOrder {
    static constexpr bool SK = true;
    const PG8_LAS int* list; int n;
    float* slots; unsigned* counters;
    __device__ __forceinline__ bool next(int i, Unit& u) const {
        if (i >= n) return false; const PG8_LAS int* p = list + 8 * i;
        u.pm = __builtin_amdgcn_readfirstlane(p[0]); u.pn = __builtin_amdgcn_readfirstlane(p[1]); u.kb = __builtin_amdgcn_readfirstlane(p[2]);
        u.ke = __builtin_amdgcn_readfirstlane(p[3]); u.kind = __builtin_amdgcn_readfirstlane(p[4]); u.slot = __builtin_amdgcn_readfirstlane(p[5]); return true;
    }
    __device__ __forceinline__ void a_ready(const Unit&) const {}
    __device__ __forceinline__ void done(const Unit&) const {}
    __device__ __forceinline__ void store_partial(const f32x4 (&acc)[2][2][4][2], const Unit& u, int tid) const {
        const __amdgpu_buffer_rsrc_t rs = __builtin_amdgcn_make_buffer_rsrc((void*)(slots + (size_t)u.slot * 65536), (short)0, 262144, 0x00020000);
#pragma unroll
        for (int a = 0; a < 2; ++a)
#pragma unroll
            for (int b = 0; b < 2; ++b)
#pragma unroll
                for (int m = 0; m < 4; ++m)
#pragma unroll
                    for (int n = 0; n < 2; ++n) __builtin_amdgcn_raw_buffer_store_b128(__builtin_bit_cast(u32x4, acc[a][b][m][n]), rs, ((((a * 2 + b) * 4 + m) * 2 + n) * 512 + tid) * 16, 0, 16);
        asm volatile("s_waitcnt vmcnt(0)" ::: "memory");
        if ((tid & 63) == 0) __hip_atomic_fetch_add(counters + 64 * u.slot, 1u, __ATOMIC_RELAXED, __HIP_MEMORY_SCOPE_AGENT);
    }
    __device__ __forceinline__ void add_partial(f32x4 (&acc)[2][2][4][2], const Unit& u, int tid, int wid) const {
        if (wid == 0) {
            unsigned spins = 0;
            while ((unsigned)__builtin_amdgcn_readfirstlane(__hip_atomic_load(counters + 64 * u.slot, __ATOMIC_RELAXED, __HIP_MEMORY_SCOPE_AGENT)) < 8u) { __builtin_amdgcn_s_sleep(2); if (++spins > (1u << 22)) break; }
            __builtin_amdgcn_fence(__ATOMIC_ACQUIRE, "agent");
            asm volatile("s_waitcnt vmcnt(0)" ::: "memory");
        }
        asm volatile("" ::: "memory"); __builtin_amdgcn_s_barrier(); asm volatile("" ::: "memory");
        const float* sp = slots + (size_t)u.slot * 65536;
#pragma unroll
        for (int a = 0; a < 2; ++a)
#pragma unroll
            for (int b = 0; b < 2; ++b)
#pragma unroll
                for (int m = 0; m < 4; ++m)
                {
#pragma unroll
                  for (int n = 0; n < 2; ++n) acc[a][b][m][n] += *(const f32x4*)(sp + ((size_t)((((a * 2 + b) * 4 + m) * 2 + n) * 512 + tid)) * 4);
                  if (m & 1) asm volatile("" : "+v"(acc[a][b][m - 1][0]), "+v"(acc[a][b][m - 1][1]), "+v"(acc[a][b][m][0]), "+v"(acc[a][b][m][1]) :: "memory"); }
    }
};
__device__ __forceinline__ int sk_build_list(const SkOrder& S, PG8_LAS int* list) {
    const int n = S.count();
    if ((int)threadIdx.x < n && threadIdx.x < 32) { Unit u; S.next((int)threadIdx.x, u); PG8_LAS int* p = list + 8 * threadIdx.x; p[0] = u.pm; p[1] = u.pn; p[2] = u.kb; p[3] = u.ke; p[4] = u.kind; p[5] = u.slot; }
    __syncthreads();
    return n < 32 ? n : 32;
}

__device__ __forceinline__ unsigned cvt_pk_bf16(float lo, float hi) { unsigned r; asm volatile("v_cvt_pk_bf16_f32 %0, %1, %2" : "=v"(r) : "v"(lo), "v"(hi)); return r; }
typedef float f32x2 __attribute__((ext_vector_type(2)));

struct EpiNull {
    static constexpr bool PERM = true, AFTER_DRAIN = false;
    float* sink;
    __device__ __forceinline__ void operator()(const f32x4 (&acc)[2][2][4][2], const Unit& u, int wr, int wc, int fr, int fq) const {
        f32x4 s = acc[0][0][0][0];
#pragma unroll
        for (int a = 0; a < 2; ++a)
#pragma unroll
            for (int b = 0; b < 2; ++b)
#pragma unroll
                for (int m = 0; m < 4; ++m)
#pragma unroll
                    for (int n = 0; n < 2; ++n) s += acc[a][b][m][n];
        if (s[0] + s[1] + s[2] + s[3] == 1.2345e37f) *sink = s[0];
    }
};
struct EpiF32 {
    static constexpr bool PERM = false, AFTER_DRAIN = false;
    float* C; int ldc; const float* bias;
    __device__ __forceinline__ void operator()(const f32x4 (&acc)[2][2][4][2], const Unit& u, int wr, int wc, int fr, int fq) const {
        const int row0 = u.pm * BM + wr * 64 + fr, col0 = u.pn * BM + wc * 32 + 4 * fq;
        f32x4 bv[2][2];
#pragma unroll
        for (int bj = 0; bj < 2; ++bj)
#pragma unroll
            for (int n = 0; n < 2; ++n) bv[bj][n] = *(const f32x4*)(bias + col0 + bj * HALF + n * 16);
#pragma unroll
        for (int ai = 0; ai < 2; ++ai)
#pragma unroll
            for (int m = 0; m < 4; ++m) { float* rowp = C + (size_t)(row0 + ai * HALF + m * 16) * ldc + col0;
#pragma unroll
                for (int bj = 0; bj < 2; ++bj)
#pragma unroll
                    for (int n = 0; n < 2; ++n) *(f32x4*)(rowp + bj * HALF + n * 16) = acc[ai][bj][m][n] + bv[bj][n]; }
    }
};
struct EpiBf16 {
    static constexpr bool PERM = true, AFTER_DRAIN = false;
    bf16_t* O; int ldc;
    __device__ __forceinline__ void operator()(const f32x4 (&acc)[2][2][4][2], const Unit& u, int wr, int wc, int fr, int fq) const {
        const int row0 = u.pm * BM + wr * 64 + fr, col0 = u.pn * BM + wc * 32 + 8 * fq;
#pragma unroll
        for (int ai = 0; ai < 2; ++ai)
#pragma unroll
            for (int m = 0; m < 4; ++m) { bf16_t* rowp = O + (size_t)(row0 + ai * HALF + m * 16) * ldc + col0;
#pragma unroll
                for (int bj = 0; bj < 2; ++bj) { const f32x4 v0 = acc[ai][bj][m][0], v1 = acc[ai][bj][m][1];
                    u32x4 w; w.x = cvt_pk_bf16(v0[0], v0[1]); w.y = cvt_pk_bf16(v0[2], v0[3]); w.z = cvt_pk_bf16(v1[0], v1[1]); w.w = cvt_pk_bf16(v1[2], v1[3]);
                    *(u32x4*)(rowp + bj * HALF) = w; } }
    }
};
__device__ __forceinline__ float silu_mul(float a, float b) { return a * b * __builtin_amdgcn_rcpf(1.0f + __expf(-a)); }
struct EpiSwiGLU {
    static constexpr bool PERM = true, AFTER_DRAIN = false;
    bf16_t* O; int ldc;
    __device__ __forceinline__ void operator()(const f32x4 (&acc)[2][2][4][2], const Unit& u, int wr, int wc, int fr, int fq) const {
        const int row0 = u.pm * BM + wr * 64 + fr, col0 = u.pn * HALF + wc * 32 + 8 * fq;
#pragma unroll
        for (int ai = 0; ai < 2; ++ai)
#pragma unroll
            for (int m = 0; m < 4; ++m) { bf16_t* rowp = O + (size_t)(row0 + ai * HALF + m * 16) * ldc + col0;
                const f32x4 a0 = acc[ai][0][m][0], a1 = acc[ai][0][m][1], b0 = acc[ai][1][m][0], b1 = acc[ai][1][m][1];
                u32x4 w;
                w.x = cvt_pk_bf16(silu_mul(a0[0], b0[0]), silu_mul(a0[1], b0[1])); w.y = cvt_pk_bf16(silu_mul(a0[2], b0[2]), silu_mul(a0[3], b0[3]));
                w.z = cvt_pk_bf16(silu_mul(a1[0], b1[0]), silu_mul(a1[1], b1[1])); w.w = cvt_pk_bf16(silu_mul(a1[2], b1[2]), silu_mul(a1[3], b1[3]));
                *(u32x4*)rowp = w; }
    }
};
struct EpiSwiGLU8 {
    static constexpr bool PERM = true, AFTER_DRAIN = false;
    unsigned char* O; int ldc; float inv, st;
    __device__ __forceinline__ void operator()(const f32x4 (&acc)[2][2][4][2], const Unit& u, int wr, int wc, int fr, int fq) const {
        const int row0 = u.pm * BM + wr * 64 + fr, col0 = u.pn * HALF + wc * 32 + 8 * fq;
        const float ib = inv * st;
#pragma unroll
        for (int ai = 0; ai < 2; ++ai)
#pragma unroll
            for (int m = 0; m < 4; ++m) { unsigned char* rowp = O + (size_t)(row0 + ai * HALF + m * 16) * ldc + col0;
                const f32x4 a0 = acc[ai][0][m][0] * inv, a1 = acc[ai][0][m][1] * inv, b0 = acc[ai][1][m][0] * ib, b1 = acc[ai][1][m][1] * ib;
                u32x2 w;
                w.x = cvt4_fp8(silu_mul(a0[0], b0[0]), silu_mul(a0[1], b0[1]), silu_mul(a0[2], b0[2]), silu_mul(a0[3], b0[3]));
                w.y = cvt4_fp8(silu_mul(a1[0], b1[0]), silu_mul(a1[1], b1[1]), silu_mul(a1[2], b1[2]), silu_mul(a1[3], b1[3]));
                *(u32x2*)rowp = w; }
    }
};
template <bool PIPE, bool BASE_BF16> struct EpiResid {
    static constexpr bool PERM = false, AFTER_DRAIN = false;
    const void* base_p; const void* base_s; bf16_t* out; const float* mod; int ldc, modld, goff, split_rows; float gs;
    static __device__ __forceinline__ f32x4 ldb(const void* rowp, int c) {
        if constexpr (BASE_BF16) { const u32x2 q = *(const u32x2*)((const bf16_t*)rowp + c);
            return (f32x4){__builtin_bit_cast(float, q.x << 16), __builtin_bit_cast(float, q.x & 0xffff0000u), __builtin_bit_cast(float, q.y << 16), __builtin_bit_cast(float, q.y & 0xffff0000u)}; }
        else return *(const f32x4*)((const float*)rowp + c);
    }
    static __device__ __forceinline__ const void* rowptr(const void* b, size_t r, int ldc) { if constexpr (BASE_BF16) return (const bf16_t*)b + r * ldc; else return (const float*)b + r * ldc; }
    static __device__ __forceinline__ void stq(bf16_t* p, f32x4 v) { u32x2 w; w.x = cvt_pk_bf16(v[0], v[1]); w.y = cvt_pk_bf16(v[2], v[3]); *(u32x2*)p = w; }
    __device__ __forceinline__ void operator()(const f32x4 (&acc)[2][2][4][2], const Unit& u, int wr, int wc, int fr, int fq) const {
        const int col0 = u.pn * BM + wc * 32 + 4 * fq;
        if (PIPE && u.pm * BM < split_rows) {
            f32x4 gq[2][2], bc[2][2], bn[2][2];
            { const void* rp = rowptr(base_p, (size_t)(u.pm * BM + wr * 64 + fr), ldc);
#pragma unroll
            for (int bj = 0; bj < 2; ++bj)
#pragma unroll
                for (int n = 0; n < 2; ++n) { gq[bj][n] = *(const f32x4*)(mod + goff + col0 + bj * HALF + n * 16) * gs; bc[bj][n] = ldb(rp, col0 + bj * HALF + n * 16); } }
#pragma unroll
            for (int gi = 0; gi < 8; ++gi) { const int ai = gi >> 2, m = gi & 3; const int r = u.pm * BM + ai * HALF + wr * 64 + m * 16 + fr;
                if (gi < 7) { const void* rp = rowptr(base_p, (size_t)(u.pm * BM + ((gi + 1) >> 2) * HALF + wr * 64 + ((gi + 1) & 3) * 16 + fr), ldc);
#pragma unroll
                    for (int bj = 0; bj < 2; ++bj)
#pragma unroll
                        for (int n = 0; n < 2; ++n) bn[bj][n] = ldb(rp, col0 + bj * HALF + n * 16); }
                bf16_t* orow = out + (size_t)r * ldc;
#pragma unroll
                for (int bj = 0; bj < 2; ++bj)
#pragma unroll
                    for (int n = 0; n < 2; ++n) { stq(orow + col0 + bj * HALF + n * 16, bc[bj][n] + gq[bj][n] * acc[ai][bj][m][n]); bc[bj][n] = bn[bj][n]; }
                asm volatile("" ::: "memory"); }
        } else {
#pragma unroll
            for (int ai = 0; ai < 2; ++ai)
#pragma unroll
                for (int m = 0; m < 4; ++m) { const int r = u.pm * BM + ai * HALF + wr * 64 + m * 16 + fr;
                    const void* brow = (r < split_rows) ? rowptr(base_p, (size_t)r, ldc) : rowptr(base_s, (size_t)(r - split_rows), ldc);
                    const float* grow = mod + (size_t)((r < split_rows) ? 0 : 1 + ((r - split_rows) >> 3)) * modld + goff;
                    bf16_t* orow = out + (size_t)r * ldc;
#pragma unroll
                    for (int bj = 0; bj < 2; ++bj)
#pragma unroll
                        for (int n = 0; n < 2; ++n) { const int c = col0 + bj * HALF + n * 16;
                            const f32x4 b = ldb(brow, c), g = *(const f32x4*)(grow + c);
                            stq(orow + c, b + (g * gs) * acc[ai][bj][m][n]); }
                    asm volatile("" ::: "memory"); }
        }
    }
};
template <class Epi, class Sched, bool ALIGN_EPI = false, bool SP2 = false, bool FP8 = false, int DIAG = 0>
__device__ __forceinline__ void gemm_phase(PG8_LAS unsigned char* lds, const Gemm g, const Sched& S, const Epi& E) {
    const int tid = threadIdx.x, wid = __builtin_amdgcn_readfirstlane(tid >> 6), lane = tid & 63, wr = wid >> 2, wc = wid & 3, fr = lane & 15, fq = lane >> 4;
    const int K = g.K, nt = K / BK;
    unsigned voffA[2], voffB[2];
#pragma unroll
    for (int i = 0; i < 2; ++i) { int R, C; stage_rc(tid * 16 + i * 8192, R, C); const int Rb = Epi::PERM ? ((R & ~31) + perm32(R & 31)) : R;
        voffA[i] = (unsigned)(R * K + C) * 2u; voffB[i] = (unsigned)(Rb * K + C) * 2u; }
    const size_t kstep = (size_t)(BK * 2);
    const size_t hstep = (size_t)HALF * K * 2;
    const size_t tstep = 2 * hstep;
    const unsigned ldsw = (unsigned)wid * 1024u;
    const int aoff = lds_byte(wr * 64 + fr, fq * 8), boff = lds_byte(wc * 32 + fr, fq * 8);
#define PG8_SA(b, h) (((b) * 2 + (h)) * HTB)
#define PG8_SB(b, h) ((4 + (b) * 2 + (h)) * HTB)
#define PG8_STAGE(bufoff, gbase, voff) do { if constexpr (DIAG >= 1) break; _Pragma("unroll") for (int _i = 0; _i < 2; ++_i) \
        __builtin_amdgcn_global_load_lds((const unsigned*)((const char*)(gbase) + (voff)[_i]), (PG8_LAS unsigned*)(lds + (bufoff) + ldsw + _i * 8192), 16, 0, 0); } while (0)
#define PG8_LDA(dst, b, h) do { if constexpr (DIAG == 2 || DIAG == 3) break; _Pragma("unroll") for (int m = 0; m < 4; ++m) _Pragma("unroll") for (int k = 0; k < 2; ++k) dst[m][k] = *(const PG8_LAS bf16x8*)(lds + PG8_SA(b, h) + aoff + m * 2048 + k * 1024); } while (0)
#define PG8_LDB(dst, b, h) do { if constexpr (DIAG == 2 || DIAG == 3) break; _Pragma("unroll") for (int n = 0; n < 2; ++n) _Pragma("unroll") for (int k = 0; k < 2; ++k) dst[n][k] = *(const PG8_LAS bf16x8*)(lds + PG8_SB(b, h) + boff + n * 2048 + k * 1024); } while (0)
#define PG8_MMA(ai, bj, At, Bt) do { if constexpr (DIAG == 4) { _Pragma("unroll") for (int m = 0; m < 4; ++m) asm volatile("" :: "v"(cat8(At[m][0], At[m][1]))); _Pragma("unroll") for (int n = 0; n < 2; ++n) asm volatile("" :: "v"(cat8(Bt[n][0], Bt[n][1]))); break; } __builtin_amdgcn_s_setprio(1); _Pragma("unroll") for (int m = 0; m < 4; ++m) _Pragma("unroll") for (int n = 0; n < 2; ++n) { \
        if constexpr (FP8) { asm volatile("v_mfma_f32_16x16x128_f8f6f4 %0, %1, %2, %0" : "+v"(acc[ai][bj][m][n]) : "v"(cat8(Bt[n][0], Bt[n][1])), "v"(cat8(At[m][0], At[m][1]))); } \
        else { _Pragma("unroll") for (int k = 0; k < 2; ++k) acc[ai][bj][m][n] = __builtin_amdgcn_mfma_f32_16x16x32_bf16(Bt[n][k], At[m][k], acc[ai][bj][m][n], 0, 0, 0); } } __builtin_amdgcn_s_setprio(0); } while (0)
#define PG8_WAIT_V(n) asm volatile("s_waitcnt vmcnt(" #n ")" ::: "memory")
#define PG8_WAIT_L(n) asm volatile("s_waitcnt lgkmcnt(" #n ")" ::: "memory")
#define PG8_BAR __builtin_amdgcn_s_barrier()
#if PG8_LOADPRIO
#define PG8_LP_ON __builtin_amdgcn_s_setprio(PG8_LOADPRIO)
#define PG8_LP_OFF __builtin_amdgcn_s_setprio(0)
#else
#define PG8_LP_ON do {} while (0)
#define PG8_LP_OFF do {} while (0)
#endif
#define PG8_SCHED __builtin_amdgcn_sched_barrier(0)
    Unit cur, nxt; int ui = 0;
    if (!S.next(0, cur)) return;
    f32x4 acc[2][2][4][2];
#pragma unroll
    for (int a = 0; a < 2; ++a)
#pragma unroll
        for (int b = 0; b < 2; ++b)
#pragma unroll
            for (int m = 0; m < 4; ++m)
#pragma unroll
                for (int n = 0; n < 2; ++n) acc[a][b][m][n] = (f32x4){0.f, 0.f, 0.f, 0.f};
    bf16x8 At[4][2], B0[2][2], B1[2][2];
    if constexpr (DIAG == 2 || DIAG == 3) { _Pragma("unroll") for (int i = 0; i < 4; ++i) _Pragma("unroll") for (int k = 0; k < 2; ++k) At[i][k] = (bf16x8){0,0,0,0,0,0,0,0}; _Pragma("unroll") for (int i = 0; i < 2; ++i) _Pragma("unroll") for (int k = 0; k < 2; ++k) { B0[i][k] = (bf16x8){0,0,0,0,0,0,0,0}; B1[i][k] = (bf16x8){0,0,0,0,0,0,0,0}; } }
    const char* cA = (const char*)g.A + (size_t)cur.pm * tstep; const char* cB = (const char*)g.Bt + (size_t)cur.pn * tstep;
    int kb = 0, ke = nt; if constexpr (Sched::SK) { kb = cur.kb; ke = cur.ke; }
    const char* pA = cA + (size_t)kb * kstep; const char* pB = cB + (size_t)kb * kstep;
    S.a_ready(cur);
    if constexpr (SP2) {
        PG8_STAGE(PG8_SB(0, 0), pB, voffB); PG8_STAGE(PG8_SB(0, 1), pB + hstep, voffB); PG8_STAGE(PG8_SA(0, 0), pA, voffA); PG8_STAGE(PG8_SA(0, 1), pA + hstep, voffA);
        if (wr == 1) PG8_BAR;
        PG8_WAIT_V(2); PG8_BAR;
        PG8_STAGE(PG8_SB(1, 0), pB + kstep, voffB); PG8_STAGE(PG8_SA(1, 0), pA + kstep, voffA); PG8_STAGE(PG8_SB(1, 1), pB + hstep + kstep, voffB);
        PG8_WAIT_V(6); PG8_BAR;
    } else {
        PG8_STAGE(PG8_SB(0, 0), pB, voffB); PG8_STAGE(PG8_SA(0, 0), pA, voffA); PG8_STAGE(PG8_SB(0, 1), pB + hstep, voffB); PG8_STAGE(PG8_SA(0, 1), pA + hstep, voffA);
        if (wr == 1) PG8_BAR;
        PG8_WAIT_V(4); PG8_BAR;
        PG8_STAGE(PG8_SB(1, 0), pB + kstep, voffB); PG8_STAGE(PG8_SA(1, 0), pA + kstep, voffA); PG8_STAGE(PG8_SB(1, 1), pB + hstep + kstep, voffB);
        PG8_WAIT_V(6); PG8_BAR;
    }
    for (;;) {
        const bool has_next = S.next(ui + 1, nxt);
        const char* nA0 = has_next ? (const char*)g.A + (size_t)nxt.pm * tstep : cA; const char* nB0 = has_next ? (const char*)g.Bt + (size_t)nxt.pn * tstep : cB;
        int nkb = 0; if constexpr (Sched::SK) { if (has_next) nkb = nxt.kb; }
        const char* nA = nA0 + (size_t)nkb * kstep; const char* nB = nB0 + (size_t)nkb * kstep;
        for (int t = kb; t < ke; t += 2) {
            const bool last = (t == ke - 2);
            const char* a1 = cA + (size_t)(t + 1) * kstep;
            const char* a2 = last ? nA : cA + (size_t)(t + 2) * kstep; const char* b2 = last ? nB : cB + (size_t)(t + 2) * kstep;
            const char* a3 = a2 + kstep; const char* b3 = b2 + kstep;
            if (last && has_next) S.a_ready(nxt);
            if constexpr (SP2) {
            PG8_LP_ON; PG8_LDB(B0, 0, 0); PG8_LDB(B1, 0, 1); PG8_SCHED; PG8_LDA(At, 0, 0); PG8_STAGE(PG8_SA(1, 1), a1 + hstep, voffA);
            PG8_LP_OFF; PG8_WAIT_V(8); PG8_WAIT_L(0); PG8_BAR; PG8_MMA(0, 0, At, B0); PG8_MMA(0, 1, At, B1); PG8_BAR; PG8_SCHED;
            PG8_LP_ON; PG8_LDA(At, 0, 1); PG8_STAGE(PG8_SB(0, 0), b2, voffB); PG8_STAGE(PG8_SB(0, 1), b2 + hstep, voffB); PG8_STAGE(PG8_SA(0, 0), a2, voffA);
            PG8_LP_OFF; PG8_WAIT_V(8); PG8_WAIT_L(0); PG8_BAR; PG8_MMA(1, 0, At, B0); PG8_MMA(1, 1, At, B1); PG8_BAR; PG8_SCHED;
            PG8_LP_ON; PG8_LDB(B0, 1, 0); PG8_LDB(B1, 1, 1); PG8_SCHED; PG8_LDA(At, 1, 0); PG8_STAGE(PG8_SA(0, 1), a2 + hstep, voffA);
            PG8_LP_OFF; PG8_WAIT_V(8); PG8_WAIT_L(0); PG8_BAR; PG8_MMA(0, 0, At, B0); PG8_MMA(0, 1, At, B1); PG8_BAR; PG8_SCHED;
            PG8_LP_ON; PG8_LDA(At, 1, 1); PG8_STAGE(PG8_SB(1, 0), b3, voffB); PG8_STAGE(PG8_SB(1, 1), b3 + hstep, voffB); PG8_STAGE(PG8_SA(1, 0), a3, voffA);
            PG8_LP_OFF; PG8_WAIT_V(8); PG8_WAIT_L(0); PG8_BAR; PG8_MMA(1, 0, At, B0); PG8_MMA(1, 1, At, B1); PG8_BAR; PG8_SCHED;
            } else {
            PG8_LDB(B0, 0, 0); PG8_SCHED; PG8_LDA(At, 0, 0); PG8_STAGE(PG8_SA(1, 1), a1 + hstep, voffA);
            PG8_WAIT_L(8); PG8_BAR; PG8_WAIT_L(0); PG8_MMA(0, 0, At, B0); PG8_BAR; PG8_SCHED;
            PG8_LDB(B1, 0, 1); PG8_STAGE(PG8_SB(0, 0), b2, voffB);
            PG8_BAR; PG8_WAIT_L(0); PG8_MMA(0, 1, At, B1); PG8_BAR;
            PG8_LDA(At, 0, 1); PG8_STAGE(PG8_SA(0, 0), a2, voffA);
            PG8_BAR; PG8_WAIT_L(0); PG8_MMA(1, 0, At, B0); PG8_BAR; PG8_SCHED;
            PG8_STAGE(PG8_SB(0, 1), b2 + hstep, voffB);
            PG8_WAIT_V(6); PG8_BAR; PG8_MMA(1, 1, At, B1); PG8_BAR;
            PG8_LDB(B0, 1, 0); PG8_SCHED; PG8_LDA(At, 1, 0); PG8_STAGE(PG8_SA(0, 1), a2 + hstep, voffA);
            PG8_WAIT_L(8); PG8_BAR; PG8_WAIT_L(0); PG8_MMA(0, 0, At, B0); PG8_BAR; PG8_SCHED;
            PG8_LDB(B1, 1, 1); PG8_STAGE(PG8_SB(1, 0), b3, voffB);
            PG8_BAR; PG8_WAIT_L(0); PG8_MMA(0, 1, At, B1); PG8_BAR;
            PG8_LDA(At, 1, 1); PG8_STAGE(PG8_SA(1, 0), a3, voffA);
            PG8_BAR; PG8_WAIT_L(0); PG8_MMA(1, 0, At, B0); PG8_BAR; PG8_SCHED;
            PG8_STAGE(PG8_SB(1, 1), b3 + hstep, voffB);
            PG8_WAIT_V(6); PG8_BAR; PG8_MMA(1, 1, At, B1); PG8_BAR;
            }
        }
        if constexpr (FP8) { asm volatile("s_nop 7\n\ts_nop 7" ::: "memory"); PG8_SCHED; }
        if constexpr (ALIGN_EPI) { if (wr == 0) PG8_BAR; }
        if constexpr (Sched::SK) {
            if (cur.kind == 1) S.store_partial(acc, cur, tid);
            else if (cur.kind == 0) { E(acc, cur, wr, wc, fr, fq); S.done(cur); }
        } else
        if constexpr (!Epi::AFTER_DRAIN) { E(acc, cur, wr, wc, fr, fq); S.done(cur); }
        if (!has_next) break;
#pragma unroll
        for (int a = 0; a < 2; ++a)
#pragma unroll
            for (int b = 0; b < 2; ++b)
#pragma unroll
                for (int m = 0; m < 4; ++m)
#pragma unroll
                    for (int n = 0; n < 2; ++n) acc[a][b][m][n] = (f32x4){0.f, 0.f, 0.f, 0.f};
        cur = nxt; cA = nA0; cB = nB0; ++ui; if constexpr (Sched::SK) { kb = cur.kb; ke = cur.ke; }
        if constexpr (ALIGN_EPI) { if (wr == 1) PG8_BAR; }
    }
    PG8_WAIT_V(0);
    if constexpr (!ALIGN_EPI) { if (wr == 0) PG8_BAR; }
    PG8_BAR;
    if constexpr (Epi::AFTER_DRAIN) { E.fused(acc, cur, wr, wc, fr, fq, lds, wid, lane); S.done(cur); }
    if constexpr (Sched::SK) { if (cur.kind == 2) { S.add_partial(acc, cur, tid, wid); E(acc, cur, wr, wc, fr, fq); S.done(cur); } }
#undef PG8_SA
#undef PG8_SB
#undef PG8_STAGE
#undef PG8_LDA
#undef PG8_LDB
#undef PG8_MMA
#undef PG8_WAIT_V
#undef PG8_WAIT_L
#undef PG8_BAR
#undef PG8_LP_ON
#undef PG8_LP_OFF
#undef PG8_SCHED
}
}

#ifndef PG8_SP2
#define PG8_SP2 true
#endif
#ifndef PG8_ALIGN
#define PG8_ALIGN true
#endif
#ifndef PROBE_GEMM
#define PROBE_GEMM 0
#endif
#ifndef UP_CUT
#define UP_CUT 0
#endif
#ifndef MK_PER_PHASE
#define MK_PER_PHASE 0
#endif

constexpr int NWAVES = 8;
constexpr int D = 4096, SEQ = 8192, DBATCH = 128, DSEQ = 8, MS = DBATCH * DSEQ, M = SEQ + MS;
constexpr int FF = 11008, NPROJ = 9216, NMOD = 9, MODW = NMOD * D, MODROWS = 256;
constexpr int C_K = 2048, C_V = 2560, C_GB = 3072, C_GC = 5120, C_HC = 7168;
constexpr int WIN = 128, NHEAD = 16;
constexpr float EPS = 1e-6f;
constexpr float S_H = 8.f, S_W13 = 512.f, S_T = 8.f, S_W2 = 512.f;
constexpr size_t O_YP = 0, O_YS = 33554432, O_KWP = 37748736, O_VWP = 37814272, O_CP = 37879808, O_KWS = 37883904, O_VWS = 46272512, O_CS = 54661120, O_END = 55185408;
enum { I_XP = 0, I_XS, I_CP, I_CS, I_CK, I_CV, I_SC, I_RB, I_G1, I_W1A, I_W3A, I_W2A, I_GM, I_WIN, I_SINK, I_CW, I_WOUT, I_G2, I_W1B, I_W3B, I_W2B, I_WADA, I_BADA, I_GF, N_IN };

constexpr size_t MiB = 1u << 20;
constexpr size_t al(size_t x) { return (x + MiB - 1) / MiB * MiB; }
constexpr size_t WS_CTL = 0, CTL_ZERO_BYTES = 1 * MiB;
constexpr size_t WS_W13A = 1 * MiB;
constexpr size_t WS_W2A  = WS_W13A + al((size_t)2 * FF * D * 2);
constexpr size_t WS_WIN  = WS_W2A + al((size_t)D * FF * 2);
constexpr size_t WS_WOUT = WS_WIN + al((size_t)NPROJ * D * 2);
constexpr size_t WS_W13B = WS_WOUT + al((size_t)D * D * 2);
constexpr size_t WS_W2B  = WS_W13B + al((size_t)2 * FF * D * 2);
constexpr size_t WS_WADA = WS_W2B + al((size_t)D * FF * 2);
constexpr size_t WS_CSI  = WS_WADA + al((size_t)MODW * D * 2);
constexpr size_t WS_MOD  = WS_CSI + al((size_t)MODROWS * D * 2);
constexpr size_t WS_X1   = WS_MOD + al((size_t)MODROWS * MODW * 4);
constexpr size_t WS_H    = WS_X1 + al((size_t)M * D * 4);
constexpr size_t WS_T    = WS_H + al((size_t)M * D * 2);
constexpr size_t WS_PROJ = WS_T + al((size_t)M * FF * 2);
constexpr size_t WS_MIX  = WS_PROJ + al((size_t)M * NPROJ * 2);
constexpr size_t WS_PART = WS_MIX + al((size_t)M * D * 2);
constexpr size_t WS_SKS  = WS_PART + al((size_t)4 * (DBATCH + 1) * 12288 * 4);
constexpr size_t WS_SKS2 = WS_SKS + (size_t)256 * 262144;
constexpr size_t WS_END  = WS_SKS2 + (size_t)256 * 262144;
constexpr int CW_TMO = 0, CW_CODE = 1, CW_BAR = 4096;
constexpr int CW_SK = 16384, CW_SK_STRIDE = 16384;
constexpr int CW_MODC = CW_SK + 4 * CW_SK_STRIDE;
static_assert((size_t)(CW_SK + 8 * CW_SK_STRIDE) * 4 <= CTL_ZERO_BYTES && CW_MODC + 64 * 144 <= CW_SK + 8 * CW_SK_STRIDE, "stream-K / adaLN counters inside the zeroed control region");

constexpr int RING_OFF = 0, RING_BYTES = 131072;
constexpr int SKLIST_OFF = 131072;
constexpr int LDSCTL_OFF = 143360, MISC_OFF = LDSCTL_OFF + 320;
constexpr int LDS_BYTES = 147456;
static_assert(MISC_OFF + 128 <= LDS_BYTES, "LDS map");

#define GAS __attribute__((address_space(1)))
#define LAS __attribute__((address_space(3)))
typedef unsigned short bf16;
typedef unsigned v4u __attribute__((ext_vector_type(4)));
typedef unsigned v2u __attribute__((ext_vector_type(2)));
typedef float f32x4 __attribute__((ext_vector_type(4)));
typedef float f32x16 __attribute__((ext_vector_type(16)));
typedef short bf16x8 __attribute__((ext_vector_type(8)));
typedef GAS unsigned gu32;
#define RLX_AGENT __ATOMIC_RELAXED, __HIP_MEMORY_SCOPE_AGENT
#define LDS_WAIT() asm volatile("s_waitcnt lgkmcnt(0)" ::: "memory")
#define VM_WAIT() asm volatile("s_waitcnt vmcnt(0)" ::: "memory")
__device__ __forceinline__ unsigned f2bf(float f) { unsigned u = __builtin_bit_cast(unsigned, f); return (u + 0x7fffu + ((u >> 16) & 1u)) >> 16; }
__device__ __forceinline__ unsigned pk2(float lo, float hi) { return f2bf(lo) | (f2bf(hi) << 16); }
__device__ __forceinline__ float bf_lo(unsigned w) { return __builtin_bit_cast(float, w << 16); }
__device__ __forceinline__ float bf_hi(unsigned w) { return __builtin_bit_cast(float, w & 0xffff0000u); }

#define XB_TMO      128
#define XB_XCNT(j)  (256  + 64 * (j))
#define XB_XSUB(j)  (1280 + 64 * (j))
#define XB_XGEN(j)  (2304 + 64 * (j))
#define XB_TOP      3328
#define XB_TOPGEN   3392
#define XCD_BAR_WORDS 3456
#define XB_SPIN_CAP (1u << 18)

__device__ __forceinline__ unsigned xb_ld(unsigned* p)              { return __hip_atomic_load(p, __ATOMIC_RELAXED, __HIP_MEMORY_SCOPE_AGENT); }
__device__ __forceinline__ unsigned xb_add(unsigned* p, unsigned v) { return __hip_atomic_fetch_add(p, v, __ATOMIC_RELAXED, __HIP_MEMORY_SCOPE_AGENT); }
__device__ __forceinline__ unsigned xb_xcc_id() { return (unsigned)__builtin_amdgcn_s_getreg((3 << 11) | 20) & 0xFu; }
#define XB_SPIN(cond, bar) do { unsigned _sp = 0; while (cond) { __builtin_amdgcn_s_sleep(1); \
    if ((++_sp & 255u) == 0u) { if (xb_ld(&(bar)[XB_TMO])) break; if (_sp > XB_SPIN_CAP) { atomicAdd(&(bar)[XB_TMO], 1u); break; } } } } while (0)

struct XcdBarrier {
    unsigned* bar; unsigned x;
    volatile LAS unsigned* st;
};

__device__ __forceinline__ XcdBarrier xcd_barrier_post(unsigned* bar, volatile LAS unsigned* st) {
    XcdBarrier b; b.bar = bar; b.x = xb_xcc_id(); b.st = st;
    if (threadIdx.x == 0) (void)xb_add(&bar[XB_XCNT(b.x)], 1u);
    return b;
}
__device__ __forceinline__ void xcd_barrier_complete(unsigned* bar, unsigned x, unsigned& nloc, unsigned& nx) {
    const unsigned G = gridDim.x * gridDim.y * gridDim.z;
    unsigned sum, cnt, mine, sp = 0u;
    for (;;) {
        sum = 0u; cnt = 0u; mine = 0u;
#pragma unroll
        for (unsigned j = 0; j < 16; ++j) { const unsigned c = xb_ld(&bar[XB_XCNT(j)]); sum += c; cnt += (c > 0u) ? 1u : 0u; mine = (j == x) ? c : mine; }
        if (sum == G) break;
        __builtin_amdgcn_s_sleep(1);
        if ((++sp & 255u) == 0u) { if (xb_ld(&bar[XB_TMO])) break; if (sp > XB_SPIN_CAP) { atomicAdd(&bar[XB_TMO], 1u); break; } }
    }
    nloc = mine > 0u ? mine : 1u; nx = cnt > 0u ? cnt : 1u;
}

__device__ __forceinline__ void xcd_barrier(const XcdBarrier& b) {
    asm volatile("s_waitcnt vmcnt(0)" ::: "memory");
    __syncthreads();
    if (threadIdx.x == 0) {
        unsigned* bar = b.bar;
        __builtin_amdgcn_s_waitcnt(0);
        unsigned nloc = b.st[0], nx = b.st[1];
        if (nloc == 0u) { xcd_barrier_complete(bar, b.x, nloc, nx); b.st[0] = nloc; b.st[1] = nx; }
        const unsigned old = xb_add(&bar[XB_XSUB(b.x)], 1u);
        const unsigned gen = old / nloc;
        if (old + 1u == (gen + 1u) * nloc) {
            __builtin_amdgcn_fence(__ATOMIC_RELEASE, "agent");
            asm volatile("s_waitcnt vmcnt(0)" ::: "memory");
            const unsigned og = xb_add(&bar[XB_TOP], 1u);
            const unsigned tg = og / nx;
            if (og + 1u == (tg + 1u) * nx) xb_add(&bar[XB_TOPGEN], 1u);
            else XB_SPIN(xb_ld(&bar[XB_TOPGEN]) == tg, bar);
            __builtin_amdgcn_fence(__ATOMIC_ACQUIRE, "agent");
            xb_add(&bar[XB_XGEN(b.x)], 1u);
            asm volatile("s_waitcnt vmcnt(0)" ::: "memory");
        } else {
            XB_SPIN(xb_ld(&bar[XB_XGEN(b.x)]) == gen, bar);
            __builtin_amdgcn_fence(__ATOMIC_ACQUIRE, "agent");
            asm volatile("s_waitcnt vmcnt(0)" ::: "memory");
        }
    }
    __syncthreads();
}


struct Frame {
    LAS unsigned char* lds;
    volatile LAS unsigned* MISC;
    gu32* ctl;
    int tid, lane, wave;
    int vcu, G;
};
__device__ __forceinline__ float wave_sum(float v) {
#pragma unroll
    for (int o = 1; o < 64; o <<= 1) v += __shfl_xor(v, o);
    return v;
}
template <int MODE>
__device__ __forceinline__ void p0_transpose_item(const float* W, int K, int N, bf16* WT, LAS float* scr, int item, int lane) {
    const int nblk = N / 32, kb = item / nblk, nb = item % nblk, k0 = 64 * kb, n0 = 32 * nb;
    const GAS float* Wg = (const GAS float*)W;
    float ld[32];
#pragma unroll
    for (int i = 0; i < 32; ++i) { const int kk = 2 * i + (lane >> 5); ld[i] = __builtin_nontemporal_load(&Wg[(size_t)(k0 + kk) * N + n0 + (lane & 31)]); }
#pragma unroll
    for (int i = 0; i < 32; ++i) { const int kk = 2 * i + (lane >> 5); scr[kk * 33 + (lane & 31)] = ld[i]; }
    LDS_WAIT(); asm volatile("" ::: "memory");
    const int c = lane & 7;
    const int r0 = (MODE == 0) ? n0 : (n0 / 128) * 256 + (n0 % 128) + (MODE == 2 ? 128 : 0);
#pragma unroll
    for (int j = 0; j < 4; ++j) { const int n = (lane >> 3) + 8 * j; const LAS float* s = scr + (8 * c) * 33 + n;
        v4u o; o.x = pg8::cvt_pk_bf16(s[0 * 33], s[1 * 33]); o.y = pg8::cvt_pk_bf16(s[2 * 33], s[3 * 33]); o.z = pg8::cvt_pk_bf16(s[4 * 33], s[5 * 33]); o.w = pg8::cvt_pk_bf16(s[6 * 33], s[7 * 33]);
        *(GAS v4u*)(WT + (size_t)(r0 + n) * K + k0 + 8 * c) = o; }
    LDS_WAIT(); asm volatile("" ::: "memory");
}

template <int MODE>
__device__ __forceinline__ void p0_transpose_item8(const float* W, int K, int N, unsigned char* WT, float scale, LAS float* scr, int item, int lane) {
    const int nblk = N / 32, kb = item / nblk, nb = item % nblk, k0 = 128 * kb, n0 = 32 * nb;
    const GAS float* Wg = (const GAS float*)W;
#pragma unroll
    for (int h2 = 0; h2 < 2; ++h2) { float ld[32];
#pragma unroll
        for (int i = 0; i < 32; ++i) { const int kk = 2 * (i + 32 * h2) + (lane >> 5); ld[i] = __builtin_nontemporal_load(&Wg[(size_t)(k0 + kk) * N + n0 + (lane & 31)]); }
#pragma unroll
        for (int i = 0; i < 32; ++i) { const int kk = 2 * (i + 32 * h2) + (lane >> 5); scr[kk * 33 + (lane & 31)] = ld[i]; } }
    LDS_WAIT(); asm volatile("" ::: "memory");
    const int n = lane & 31, hf = lane >> 5;
    const int r0 = (MODE == 0) ? n0 : (n0 / 128) * 256 + (n0 % 128) + (MODE == 2 ? 128 : 0);
#pragma unroll
    for (int p = 0; p < 4; ++p) { const int q = 2 * p + hf; const LAS float* s = scr + (16 * q) * 33 + n;
        v4u o;
        o.x = pg8::cvt4_fp8(s[0 * 33] * scale, s[1 * 33] * scale, s[2 * 33] * scale, s[3 * 33] * scale);
        o.y = pg8::cvt4_fp8(s[4 * 33] * scale, s[5 * 33] * scale, s[6 * 33] * scale, s[7 * 33] * scale);
        o.z = pg8::cvt4_fp8(s[8 * 33] * scale, s[9 * 33] * scale, s[10 * 33] * scale, s[11 * 33] * scale);
        o.w = pg8::cvt4_fp8(s[12 * 33] * scale, s[13 * 33] * scale, s[14 * 33] * scale, s[15 * 33] * scale);
        *(GAS v4u*)(WT + (size_t)(r0 + n) * K + k0 + 16 * q) = o; }
    LDS_WAIT(); asm volatile("" ::: "memory");
}

struct Args { const float* in[N_IN]; float* out; unsigned char* ws; int ph_lo, ph_hi; };

enum { JOB_W1A = 0, JOB_W3A, JOB_W2A, JOB_WIN, JOB_WOUT, JOB_W1B, JOB_W3B, JOB_W2B };
template <int JOB>
__device__ __forceinline__ void conv_job(Frame& F, const Args& A, int rank, int nw) {
    LAS float* scr = (LAS float*)(F.lds + RING_OFF + F.wave * 16896);
    unsigned char* ws = A.ws;
    constexpr int I_13 = (D / 128) * (FF / 32), I_2 = (FF / 128) * (D / 32), I_IN = (D / 64) * (NPROJ / 32), I_OUT = (D / 64) * (D / 32);
    constexpr int N = (JOB == JOB_W1A || JOB == JOB_W3A || JOB == JOB_W1B || JOB == JOB_W3B) ? I_13 : (JOB == JOB_W2A || JOB == JOB_W2B) ? I_2 : (JOB == JOB_WIN) ? I_IN : I_OUT;
    for (int it = rank; it < N; it += nw) {
        if constexpr (JOB == JOB_W1A) p0_transpose_item8<1>(A.in[I_W1A], D, FF, ws + WS_W13A, S_W13, scr, it, F.lane);
        if constexpr (JOB == JOB_W3A) p0_transpose_item8<2>(A.in[I_W3A], D, FF, ws + WS_W13A, S_W13, scr, it, F.lane);
        if constexpr (JOB == JOB_W2A) p0_transpose_item8<0>(A.in[I_W2A], FF, D, ws + WS_W2A, S_W2, scr, it, F.lane);
        if constexpr (JOB == JOB_WIN) p0_transpose_item<0>(A.in[I_WIN], D, NPROJ, (bf16*)(ws + WS_WIN), scr, it, F.lane);
        if constexpr (JOB == JOB_WOUT) p0_transpose_item<0>(A.in[I_WOUT], D, D, (bf16*)(ws + WS_WOUT), scr, it, F.lane);
        if constexpr (JOB == JOB_W1B) p0_transpose_item8<1>(A.in[I_W1B], D, FF, ws + WS_W13B, S_W13, scr, it, F.lane);
        if constexpr (JOB == JOB_W3B) p0_transpose_item8<2>(A.in[I_W3B], D, FF, ws + WS_W13B, S_W13, scr, it, F.lane);
        if constexpr (JOB == JOB_W2B) p0_transpose_item8<0>(A.in[I_W2B], FF, D, ws + WS_W2B, S_W2, scr, it, F.lane);
    }
}
__device__ __forceinline__ void csilu_phase(Frame& F, const Args& A) {
    const int gt = (F.vcu * NWAVES + F.wave) * 64 + F.lane, NGT = F.G * NWAVES * 64;
    bf16* cs = (bf16*)(A.ws + WS_CSI);
    for (int it = gt; it < 144 * D / 8; it += NGT) {
        const int row = it / (D / 8), c8 = (it % (D / 8)) * 8;
        v4u o = (v4u){0u, 0u, 0u, 0u};
        if (row <= DBATCH) {
            const float* src = (row == 0) ? A.in[I_CP] + c8 : A.in[I_CS] + (size_t)(row - 1) * D + c8;
            const f32x4 a = *(const GAS f32x4*)src, b = *(const GAS f32x4*)(src + 4);
            float v[8] = {a[0], a[1], a[2], a[3], b[0], b[1], b[2], b[3]};
#pragma unroll
            for (int j = 0; j < 8; ++j) v[j] = v[j] / (1.0f + __expf(-v[j]));
            o.x = pk2(v[0], v[1]); o.y = pk2(v[2], v[3]); o.z = pk2(v[4], v[5]); o.w = pk2(v[6], v[7]);
        }
        *(GAS v4u*)(cs + ((size_t)((c8 >> 5) * 9 + (row >> 4)) * 64 + ((c8 & 31) >> 3) * 16 + (row & 15)) * 8) = o;
    }
}
constexpr int MODI_SB = 2560, MODI_A_OFF = 8 * MODI_SB, MODI_A_BYTES = 9216;
__device__ __forceinline__ void mod_item256(Frame& F, const Args& A, int cg, int k0, int nsteps, float* dst, int ldd, int dcol0, const float* bias) {
    const int lane = F.lane, w = F.wave, n0 = 256 * cg + 32 * w, tid = F.tid;
    LAS unsigned char* sb = F.lds + w * MODI_SB;
    LAS unsigned char* la = F.lds + MODI_A_OFF;
    const bf16* CS = (const bf16*)(A.ws + WS_CSI);
    const int kp = lane >> 3, a8 = lane & 7, n4 = 4 * a8;
    const GAS char* Wb = (const GAS char*)(A.in[I_WADA] + (size_t)k0 * MODW + n0);
    const unsigned wlo = (unsigned)((2 * kp) * MODW + n4) * 4u;
    const GAS char* Cb = (const GAS char*)CS + (size_t)(k0 / 32) * 9216;
    const unsigned c1 = (unsigned)tid * 16u, c2 = (unsigned)(512 + (tid & 63)) * 16u;
    f32x4 acc[9][2];
#pragma unroll
    for (int mt = 0; mt < 9; ++mt)
#pragma unroll
        for (int j = 0; j < 2; ++j) acc[mt][j] = (f32x4){0.f, 0.f, 0.f, 0.f};
    f32x4 buf[2][4];
    v4u ar[2][2];
#define MODI_LOAD(b, s) do { _Pragma("unroll") for (int i = 0; i < 4; ++i) buf[b][i] = __builtin_nontemporal_load((const GAS f32x4*)(Wb + (size_t)(32 * (s) + 16 * (i >> 1) + (i & 1)) * (MODW * 4) + wlo)); } while (0)
#define MODI_ALOAD(r, s) do { const int s_ = (s) < nsteps ? (s) : nsteps - 1; ar[r][0] = *(const GAS v4u*)(Cb + (size_t)s_ * 9216 + c1); ar[r][1] = *(const GAS v4u*)(Cb + (size_t)s_ * 9216 + c2); } while (0)
#define MODI_AWRITE(r, s) do { *(LAS v4u*)(la + ((s) & 1) * MODI_A_BYTES + c1) = ar[r][0]; *(LAS v4u*)(la + ((s) & 1) * MODI_A_BYTES + c2) = ar[r][1]; } while (0)
    __syncthreads();
    MODI_ALOAD(0, 0); MODI_ALOAD(1, 1);
    MODI_LOAD(0, 0); MODI_LOAD(1, 1);
    MODI_AWRITE(0, 0);
    MODI_ALOAD(0, 2);
    __syncthreads();
#pragma unroll 1
    for (int s4 = 0; s4 < nsteps; s4 += 2) {
#pragma unroll
        for (int b = 0; b < 2; ++b) { const int s = s4 + b;
#pragma unroll
            for (int ip = 0; ip < 2; ++ip)
#pragma unroll
                for (int e = 0; e < 4; ++e) { const int n = n4 + e, k = 2 * kp + 16 * ip;
                    *(LAS unsigned*)(sb + n * 80 + (((k >> 3) ^ (a8 & 3)) * 16) + (k & 7) * 2) = pg8::cvt_pk_bf16(buf[b][2 * ip][e], buf[b][2 * ip + 1][e]); }
            asm volatile("" ::: "memory");
            { const int sn = (s + 2 < nsteps) ? s + 2 : nsteps - 1; MODI_LOAD(b, sn); }
            asm volatile("" ::: "memory");
            bf16x8 bfr[2];
#pragma unroll
            for (int j = 0; j < 2; ++j) { const int n = 16 * j + (lane & 15); bfr[j] = *(const LAS bf16x8*)(sb + n * 80 + (((lane >> 4) ^ ((n >> 2) & 3)) * 16)); }
#pragma unroll
            for (int mg = 0; mg < 3; ++mg) { bf16x8 af[3];
#pragma unroll
                for (int i = 0; i < 3; ++i) af[i] = *(const LAS bf16x8*)(la + (s & 1) * MODI_A_BYTES + (3 * mg + i) * 1024 + lane * 16);
#pragma unroll
                for (int i = 0; i < 3; ++i)
#pragma unroll
                    for (int j = 0; j < 2; ++j) acc[3 * mg + i][j] = __builtin_amdgcn_mfma_f32_16x16x32_bf16(af[i], bfr[j], acc[3 * mg + i][j], 0, 0, 0);
                asm volatile("" ::: "memory"); }
            MODI_AWRITE((b + 1) & 1, s + 1);
            asm volatile("" ::: "memory");
            MODI_ALOAD((b + 1) & 1, s + 3);
            __syncthreads();
        }
    }
#undef MODI_LOAD
#undef MODI_ALOAD
#undef MODI_AWRITE
    const int c0 = 32 * w + (lane & 15);
#pragma unroll
    for (int j = 0; j < 2; ++j) { const float bv = bias ? bias[256 * cg + c0 + 16 * j] : 0.f;
#pragma unroll
        for (int mt = 0; mt < 9; ++mt)
#pragma unroll
            for (int r = 0; r < 4; ++r) { const int row = 16 * mt + 4 * (lane >> 4) + r;
                if (row <= DBATCH) dst[(size_t)row * ldd + dcol0 + c0 + 16 * j] = acc[mt][j][r] + bv; } }
    LDS_WAIT();
}
__device__ __forceinline__ void mod_group_finish(Frame& F, const Args& A, int chunk, int cg) {
    asm volatile("s_waitcnt vmcnt(0)" ::: "memory");
    __syncthreads();
    if (threadIdx.x == 0) {
        __builtin_amdgcn_fence(__ATOMIC_RELEASE, "agent");
        asm volatile("s_waitcnt vmcnt(0)" ::: "memory");
        const unsigned old = __hip_atomic_fetch_add((unsigned*)(F.ctl + CW_MODC + 64 * (48 * chunk + cg)), 1u, __ATOMIC_RELAXED, __HIP_MEMORY_SCOPE_AGENT);
        if (old == 3u) { __builtin_amdgcn_fence(__ATOMIC_ACQUIRE, "agent"); asm volatile("s_waitcnt vmcnt(0)" ::: "memory"); }
        F.MISC[0] = (old == 3u) ? 1u : 0u;
    }
    __syncthreads();
    if (F.MISC[0] != 0u) {
        const float* PART = (const float*)(A.ws + WS_PART); float* MOD = (float*)(A.ws + WS_MOD);
        constexpr size_t PS = (size_t)(DBATCH + 1) * 12288;
#pragma unroll 1
        for (int i = threadIdx.x; i < (DBATCH + 1) * 64; i += NWAVES * 64) { const int r = i >> 6, c = 256 * cg + 4 * (i & 63);
            const float* p = PART + (size_t)r * 12288 + c;
            const f32x4 s = (*(const GAS f32x4*)p + *(const GAS f32x4*)(p + PS)) + (*(const GAS f32x4*)(p + 2 * PS) + *(const GAS f32x4*)(p + 3 * PS));
            *(GAS f32x4*)(MOD + (size_t)r * MODW + 12288 * chunk + c) = s + *(const GAS f32x4*)(A.in[I_BADA] + 12288 * chunk + c); }
    }
    __syncthreads();
}
__device__ __forceinline__ void mod_chunk_partials(Frame& F, const Args& A, int chunk, int rank, int nwg) {
#pragma unroll 1
    for (int it = rank; it < 192; it += nwg) {
        mod_item256(F, A, 48 * chunk + (it >> 2), 1024 * (it & 3), 32, (float*)(A.ws + WS_PART) + (size_t)(it & 3) * ((size_t)(DBATCH + 1) * 12288), 12288, 256 * (it >> 2), nullptr);
        mod_group_finish(F, A, chunk, it >> 2);
    }
}

template <bool FP8OUT>
__device__ __forceinline__ void normmod_store(bf16* H, int m, int lane, int j, f32x4 h) {
    if constexpr (FP8OUT) { ((GAS unsigned*)((unsigned char*)H + (size_t)m * D) + lane)[64 * j] = pg8::cvt4_fp8(h.x * S_H, h.y * S_H, h.z * S_H, h.w * S_H); }
    else { v2u w; w.x = pg8::cvt_pk_bf16(h.x, h.y); w.y = pg8::cvt_pk_bf16(h.z, h.w); ((GAS v2u*)(H + (size_t)m * D) + lane)[64 * j] = w; }
}
template <bool XBF16> __device__ __forceinline__ f32x4 ldx4(const void* rowp, int q) {
    if constexpr (XBF16) { const v2u w = ((const GAS v2u*)rowp)[q]; return (f32x4){bf_lo(w.x), bf_hi(w.x), bf_lo(w.y), bf_hi(w.y)}; }
    else return ((const GAS f32x4*)rowp)[q];
}
template <bool XBF16> __device__ __forceinline__ const void* xrowp(const void* base, size_t r) { if constexpr (XBF16) return (const bf16*)base + r * D; else return (const float*)base + r * D; }
template <bool FP8OUT, bool XBF16>
__device__ __forceinline__ void normmod_phase(Frame& F, const void* xp, const void* xs, const float* g, const float* mod, int ish, int isc, bf16* H) {
    const int gw = F.vcu * NWAVES + F.wave, NGW = F.G * NWAVES, lane = F.lane;
    LAS f32x4* lgs = (LAS f32x4*)F.lds; LAS f32x4* lsh = (LAS f32x4*)(F.lds + D * 4);
    for (int i = F.tid; i < D / 4; i += NWAVES * 64) { const f32x4 gg = *((const GAS f32x4*)g + i), sc = *((const GAS f32x4*)(mod + (size_t)isc * D) + i);
        lgs[i] = gg * (sc + 1.0f); lsh[i] = *((const GAS f32x4*)(mod + (size_t)ish * D) + i); }
    __syncthreads();
    if (gw < SEQ) {
        f32x4 cur[16], nx[16];
#pragma unroll
        for (int j = 0; j < 16; ++j) cur[j] = ldx4<XBF16>(xrowp<XBF16>(xp, (size_t)gw), lane + 64 * j);
#pragma unroll 1
        for (int m = gw; m < SEQ; m += NGW) {
            asm volatile("" ::: "memory");
            const int mn = (m + NGW < SEQ) ? m + NGW : m;
#pragma unroll
            for (int j = 0; j < 16; ++j) nx[j] = ldx4<XBF16>(xrowp<XBF16>(xp, (size_t)mn), lane + 64 * j);
            float s = 0.f;
#pragma unroll
            for (int j = 0; j < 16; ++j) s += (cur[j].x * cur[j].x + cur[j].y * cur[j].y) + (cur[j].z * cur[j].z + cur[j].w * cur[j].w);
            const float rstd = 1.0f / sqrtf(wave_sum(s) * (1.f / D) + EPS);
#pragma unroll
            for (int j = 0; j < 16; ++j) normmod_store<FP8OUT>(H, m, lane, j, (cur[j] * rstd) * lgs[lane + 64 * j] + lsh[lane + 64 * j]);
#pragma unroll
            for (int j = 0; j < 16; ++j) cur[j] = nx[j];
        }
    }
    for (int m = SEQ + gw; m < M; m += NGW) {
        const float* mrow = mod + (size_t)(1 + ((m - SEQ) >> 3)) * MODW;
        const void* xr = xrowp<XBF16>(xs, (size_t)(m - SEQ));
        f32x4 v[16]; float s = 0.f;
#pragma unroll
        for (int j = 0; j < 16; ++j) { v[j] = ldx4<XBF16>(xr, lane + 64 * j); s += (v[j].x * v[j].x + v[j].y * v[j].y) + (v[j].z * v[j].z + v[j].w * v[j].w); }
        const float rstd = 1.0f / sqrtf(wave_sum(s) * (1.f / D) + EPS);
        const GAS f32x4* gr = (const GAS f32x4*)g + lane;
        const GAS f32x4* shr = (const GAS f32x4*)(mrow + (size_t)ish * D) + lane;
        const GAS f32x4* scr = (const GAS f32x4*)(mrow + (size_t)isc * D) + lane;
#pragma unroll
        for (int j = 0; j < 16; ++j) { const f32x4 gg = gr[64 * j], sh = shr[64 * j], sc = scr[64 * j];
            normmod_store<FP8OUT>(H, m, lane, j, (v[j] * rstd) * gg * (sc + 1.0f) + sh); }
    }
    __syncthreads();
}
__device__ __forceinline__ void final_norm_phase(Frame& F, const bf16* X1, const float* g, float* out) {
    const int gw = F.vcu * NWAVES + F.wave, NGW = F.G * NWAVES, lane = F.lane;
    LAS f32x4* lg = (LAS f32x4*)F.lds;
    for (int i = F.tid; i < D / 4; i += NWAVES * 64) lg[i] = *((const GAS f32x4*)g + i);
    __syncthreads();
    if (gw >= M) return;
    f32x4 cur[16], nx[16];
#pragma unroll
    for (int j = 0; j < 16; ++j) cur[j] = ldx4<true>(X1 + (size_t)gw * D, lane + 64 * j);
#pragma unroll 1
    for (int m = gw; m < M; m += NGW) {
        asm volatile("" ::: "memory");
        const int mn = (m + NGW < M) ? m + NGW : m;
#pragma unroll
        for (int j = 0; j < 16; ++j) nx[j] = ldx4<true>(X1 + (size_t)mn * D, lane + 64 * j);
        float s = 0.f;
#pragma unroll
        for (int j = 0; j < 16; ++j) s += (cur[j].x * cur[j].x + cur[j].y * cur[j].y) + (cur[j].z * cur[j].z + cur[j].w * cur[j].w);
        const float rstd = 1.0f / sqrtf(wave_sum(s) * (1.f / D) + EPS);
        GAS f32x4* o = (GAS f32x4*)(out + ((m < SEQ) ? O_YP + (size_t)m * D : O_YS + (size_t)(m - SEQ) * D)) + lane;
#pragma unroll
        for (int j = 0; j < 16; ++j) o[64 * j] = (cur[j] * rstd) * lg[lane + 64 * j];
#pragma unroll
        for (int j = 0; j < 16; ++j) cur[j] = nx[j];
    }
}

namespace att {
constexpr int KROW = 272, VROW = 528;
constexpr int K_OFF = 0, V_OFF = 256 * KROW, LUT_OFF = V_OFF + 128 * VROW, LUT_STRIDE = 132;
constexpr int ATT_LDS = LUT_OFF + 4 * LUT_STRIDE * 4;
static_assert(ATT_LDS <= LDSCTL_OFF, "attention LDS image below the control words");
constexpr float SCALE = 0.08838834764831845f;
__device__ __forceinline__ int t5_bucket(int n) {
    if (n < 16) return n;
    int b = 16;
    b += (n >= 19); b += (n >= 21); b += (n >= 24); b += (n >= 27); b += (n >= 31); b += (n >= 35); b += (n >= 40); b += (n >= 46);
    b += (n >= 52); b += (n >= 59); b += (n >= 67); b += (n >= 77); b += (n >= 87); b += (n >= 99); b += (n >= 113);
    return b;
}
__device__ __forceinline__ int vslot(int kidx) { return (kidx & ~15) | (8 * ((kidx >> 2) & 1) + 4 * ((kidx >> 3) & 1) + (kidx & 3)); }
__device__ __forceinline__ void fill_lut(LAS unsigned char* lds, const float* rel_bias, int hk, int tid) {
    LAS float* lut = (LAS float*)(lds + LUT_OFF);
    for (int i = tid; i < 4 * 129; i += NWAVES * 64) { const int g = i / 129, dist = i % 129; lut[g * LUT_STRIDE + dist] = rel_bias[t5_bucket(dist) * NHEAD + 4 * hk + g]; }
}
template <int NT>
__device__ __forceinline__ void attn_qtile(const LAS unsigned char* lds, int ktile0, const bf16x8 (&Q)[8], int r, int kmin, int kmax, int g, float sink, bf16* orow, int lane) {
    const int c = lane & 31, h = lane >> 5;
    f32x16 X[NT];
#pragma unroll
    for (int t = 0; t < NT; ++t) {
#pragma unroll
        for (int i = 0; i < 16; ++i) X[t][i] = 0.f;
#pragma unroll
        for (int ks = 0; ks < 8; ++ks) { const bf16x8 kf = *(const LAS bf16x8*)(lds + K_OFF + (32 * (ktile0 + t) + c) * KROW + (16 * ks + 8 * h) * 2);
            X[t] = __builtin_amdgcn_mfma_f32_32x32x16_bf16(kf, Q[ks], X[t], 0, 0, 0); }
    }
    const LAS float* lut = (const LAS float*)(lds + LUT_OFF) + g * LUT_STRIDE;
    float mx = sink;
#pragma unroll
    for (int t = 0; t < NT; ++t)
#pragma unroll
        for (int i = 0; i < 16; ++i) { const int kidx = 32 * (ktile0 + t) + (i & 3) + 8 * (i >> 2) + 4 * h; const int dist = 128 + r - kidx;
            const bool valid = (dist >= 0) && (dist <= 128) && (kidx >= kmin) && (kidx < kmax);
            const int di = dist < 0 ? 0 : (dist > 128 ? 128 : dist);
            float s = X[t][i] * SCALE + lut[di]; s = valid ? s : -1e30f; X[t][i] = s; mx = fmaxf(mx, s); }
    mx = fmaxf(mx, __shfl_xor(mx, 32));
    float sum = 0.f;
#pragma unroll
    for (int t = 0; t < NT; ++t)
#pragma unroll
        for (int i = 0; i < 16; ++i) { const float p = __expf(X[t][i] - mx); X[t][i] = p; sum += p; }
    sum += __shfl_xor(sum, 32);
    const float inv = 1.0f / (sum + __expf(sink - mx));
    f32x16 O[4];
#pragma unroll
    for (int dt = 0; dt < 4; ++dt)
#pragma unroll
        for (int i = 0; i < 16; ++i) O[dt][i] = 0.f;
#pragma unroll
    for (int t = 0; t < NT; ++t)
#pragma unroll
        for (int s = 0; s < 2; ++s) {
            v4u pw; pw.x = pg8::cvt_pk_bf16(X[t][8 * s + 0], X[t][8 * s + 1]); pw.y = pg8::cvt_pk_bf16(X[t][8 * s + 2], X[t][8 * s + 3]);
            pw.z = pg8::cvt_pk_bf16(X[t][8 * s + 4], X[t][8 * s + 5]); pw.w = pg8::cvt_pk_bf16(X[t][8 * s + 6], X[t][8 * s + 7]);
            const bf16x8 pf = __builtin_bit_cast(bf16x8, pw);
#pragma unroll
            for (int dt = 0; dt < 4; ++dt) { const bf16x8 vf = *(const LAS bf16x8*)(lds + V_OFF + (32 * dt + c) * VROW + (32 * (ktile0 + t) + 16 * s + 8 * h) * 2);
                O[dt] = __builtin_amdgcn_mfma_f32_32x32x16_bf16(vf, pf, O[dt], 0, 0, 0); }
        }
#pragma unroll
    for (int dt = 0; dt < 4; ++dt)
#pragma unroll
        for (int i = 0; i < 4; ++i) { v2u w; w.x = pk2(O[dt][4 * i + 0] * inv, O[dt][4 * i + 1] * inv); w.y = pk2(O[dt][4 * i + 2] * inv, O[dt][4 * i + 3] * inv);
            *(GAS v2u*)(orow + 32 * dt + 8 * i + 4 * h) = w; }
}
__device__ __forceinline__ void stage_kv(LAS unsigned char* lds, int kidx, int ch, v4u kq, v4u vq) {
    *(LAS v4u*)(lds + K_OFF + kidx * KROW + ch * 16) = kq;
    LAS unsigned short* vt = (LAS unsigned short*)(lds + V_OFF + (8 * ch) * VROW) + vslot(kidx);
    vt[0 * (VROW / 2)] = (unsigned short)(vq.x & 0xffffu); vt[1 * (VROW / 2)] = (unsigned short)(vq.x >> 16);
    vt[2 * (VROW / 2)] = (unsigned short)(vq.y & 0xffffu); vt[3 * (VROW / 2)] = (unsigned short)(vq.y >> 16);
    vt[4 * (VROW / 2)] = (unsigned short)(vq.z & 0xffffu); vt[5 * (VROW / 2)] = (unsigned short)(vq.z >> 16);
    vt[6 * (VROW / 2)] = (unsigned short)(vq.w & 0xffffu); vt[7 * (VROW / 2)] = (unsigned short)(vq.w >> 16);
}
__device__ __forceinline__ void store8_f32(float* dst, v4u q) {
    *(GAS f32x4*)dst = (f32x4){bf_lo(q.x), bf_hi(q.x), bf_lo(q.y), bf_hi(q.y)};
    *(GAS f32x4*)(dst + 4) = (f32x4){bf_lo(q.z), bf_hi(q.z), bf_lo(q.w), bf_hi(q.w)};
}
__device__ __forceinline__ void prompt_unit(Frame& F, const Args& A, int b, int hk) {
    const bf16* PROJ = (const bf16*)(A.ws + WS_PROJ); bf16* MIX = (bf16*)(A.ws + WS_MIX);
    LAS unsigned char* lds = F.lds;
    fill_lut(lds, A.in[I_RB], hk, F.tid);
    v4u kqa[8], vqa[8];
#pragma unroll
    for (int i = 0; i < 8; ++i) { const int cid = F.tid + 512 * i, kidx = cid >> 4, ch = cid & 15; const int row = 128 * (b - 1) + kidx, rowc = row < 0 ? 0 : row;
        const bf16* p = PROJ + (size_t)rowc * NPROJ + 128 * hk + 8 * ch; kqa[i] = *(const GAS v4u*)(p + C_K); vqa[i] = *(const GAS v4u*)(p + C_V); }
#pragma unroll
    for (int i = 0; i < 8; ++i) { const int cid = F.tid + 512 * i, kidx = cid >> 4, ch = cid & 15; const int row = 128 * (b - 1) + kidx;
        v4u kq = kqa[i], vq = vqa[i];
        if (row < 0) { kq = (v4u){0u, 0u, 0u, 0u}; vq = (v4u){0u, 0u, 0u, 0u}; }
        stage_kv(lds, kidx, ch, kq, vq);
        if (b == SEQ / 128 - 1 && kidx >= 128) {
            store8_f32(A.out + O_KWP + (size_t)(kidx - 128) * 512 + 128 * hk + 8 * ch, kq);
            store8_f32(A.out + O_VWP + (size_t)(kidx - 128) * 512 + 128 * hk + 8 * ch, vq); }
    }
    __syncthreads();
    const int g = F.wave >> 1, half = F.wave & 1, c = F.lane & 31, h = F.lane >> 5, head = 4 * hk + g;
    const float sink = A.in[I_SINK][head];
#pragma unroll 1
    for (int qt = 0; qt < 2; ++qt) { const int r = 64 * half + 32 * qt + c, row = 128 * b + r;
        bf16x8 Q[8];
#pragma unroll
        for (int ks = 0; ks < 8; ++ks) Q[ks] = *(const GAS bf16x8*)(PROJ + (size_t)row * NPROJ + 128 * head + 16 * ks + 8 * h);
        attn_qtile<5>(lds, 2 * half + qt, Q, r, b == 0 ? 128 : 0, 256, g, sink, MIX + (size_t)row * D + 128 * head, F.lane);
    }
    __syncthreads();
}
__device__ __forceinline__ void sample_unit(Frame& F, const Args& A, int s, int hk) {
    const bf16* PROJ = (const bf16*)(A.ws + WS_PROJ); bf16* MIX = (bf16*)(A.ws + WS_MIX);
    LAS unsigned char* lds = F.lds;
    fill_lut(lds, A.in[I_RB], hk, F.tid);
    {
        const int ch = F.tid & 15, kb0 = F.tid >> 4;
        f32x4 ck[4][2], cv[4][2];
#pragma unroll
        for (int i = 0; i < 4; ++i) { const size_t off = (((size_t)s * 128 + kb0 + 32 * i) * 4 + hk) * 128 + 8 * ch;
            ck[i][0] = *(const GAS f32x4*)(A.in[I_CK] + off); ck[i][1] = *(const GAS f32x4*)(A.in[I_CK] + off + 4);
            cv[i][0] = *(const GAS f32x4*)(A.in[I_CV] + off); cv[i][1] = *(const GAS f32x4*)(A.in[I_CV] + off + 4); }
        const int kn = 128 + kb0, knc = kn < 136 ? kn : 135;
        const bf16* pn = PROJ + (size_t)(SEQ + 8 * s + (knc - 128)) * NPROJ + 128 * hk + 8 * ch;
        v4u nkq = *(const GAS v4u*)(pn + C_K), nvq = *(const GAS v4u*)(pn + C_V);
#pragma unroll
        for (int i = 0; i < 4; ++i) { const int kidx = kb0 + 32 * i; const f32x4 k0 = ck[i][0], k1 = ck[i][1], v0 = cv[i][0], v1 = cv[i][1];
            const v4u kq = (v4u){pg8::cvt_pk_bf16(k0[0], k0[1]), pg8::cvt_pk_bf16(k0[2], k0[3]), pg8::cvt_pk_bf16(k1[0], k1[1]), pg8::cvt_pk_bf16(k1[2], k1[3])};
            const v4u vq = (v4u){pg8::cvt_pk_bf16(v0[0], v0[1]), pg8::cvt_pk_bf16(v0[2], v0[3]), pg8::cvt_pk_bf16(v1[0], v1[1]), pg8::cvt_pk_bf16(v1[2], v1[3])};
            if (kidx >= 8) {
                float* ko = A.out + O_KWS + (((size_t)s * 128 + (kidx - 8)) * 4 + hk) * 128 + 8 * ch; *(GAS f32x4*)ko = k0; *(GAS f32x4*)(ko + 4) = k1;
                float* vo = A.out + O_VWS + (((size_t)s * 128 + (kidx - 8)) * 4 + hk) * 128 + 8 * ch; *(GAS f32x4*)vo = v0; *(GAS f32x4*)(vo + 4) = v1; }
            stage_kv(lds, kidx, ch, kq, vq); }
        if (kn < 136) {
            store8_f32(A.out + O_KWS + (((size_t)s * 128 + (kn - 8)) * 4 + hk) * 128 + 8 * ch, nkq);
            store8_f32(A.out + O_VWS + (((size_t)s * 128 + (kn - 8)) * 4 + hk) * 128 + 8 * ch, nvq);
        } else { nkq = (v4u){0u, 0u, 0u, 0u}; nvq = (v4u){0u, 0u, 0u, 0u}; }
        stage_kv(lds, kn, ch, nkq, nvq);
    }
    __syncthreads();
    if (F.wave == 0) {
        const int c = F.lane & 31, h = F.lane >> 5, g = c >> 3, t = c & 7, head = 4 * hk + g, row = SEQ + 8 * s + t;
        const float sink = A.in[I_SINK][head];
        bf16x8 Q[8];
#pragma unroll
        for (int ks = 0; ks < 8; ++ks) Q[ks] = *(const GAS bf16x8*)(PROJ + (size_t)row * NPROJ + 128 * head + 16 * ks + 8 * h);
        attn_qtile<5>(lds, 0, Q, t, 0, 136, g, sink, MIX + (size_t)row * D + 128 * head, F.lane);
    }
    __syncthreads();
}
__device__ __forceinline__ f32x4 ld4bf(const bf16* p) { const v2u q = *(const GAS v2u*)p; return (f32x4){bf_lo(q.x), bf_hi(q.x), bf_lo(q.y), bf_hi(q.y)}; }
__device__ __forceinline__ void conv_item(Frame& F, const Args& A, int item) {
    const bf16* PROJ = (const bf16*)(A.ws + WS_PROJ); bf16* MIX = (bf16*)(A.ws + WS_MIX);
    const int sl = item >> 3, r0 = 8 * sl, c0 = 256 * (item & 7) + 4 * F.lane;
    const f32x4 w0 = *(const GAS f32x4*)(A.in[I_CW] + c0), w1 = *(const GAS f32x4*)(A.in[I_CW] + 2048 + c0), w2 = *(const GAS f32x4*)(A.in[I_CW] + 4096 + c0);
#define load4(row, col) ld4bf(PROJ + (size_t)(row) * NPROJ + (col) + c0)
    f32x4 u[10], gb[8];
    if (r0 >= SEQ) { const int s = (r0 - SEQ) >> 3;
        u[0] = *(const GAS f32x4*)(A.in[I_SC] + ((size_t)s * 2 + 0) * 2048 + c0); u[1] = *(const GAS f32x4*)(A.in[I_SC] + ((size_t)s * 2 + 1) * 2048 + c0); }
    else if (r0 == 0) { u[0] = (f32x4){0.f, 0.f, 0.f, 0.f}; u[1] = u[0]; }
    else { u[0] = load4(r0 - 2, C_GC) * load4(r0 - 2, C_HC); u[1] = load4(r0 - 1, C_GC) * load4(r0 - 1, C_HC); }
#pragma unroll
    for (int i = 0; i < 8; ++i) { u[2 + i] = load4(r0 + i, C_GC) * load4(r0 + i, C_HC); gb[i] = load4(r0 + i, C_GB); }
#pragma unroll
    for (int i = 0; i < 8; ++i) { const int row = r0 + i;
        const f32x4 y = gb[i] * (w0 * u[i] + w1 * u[i + 1] + w2 * u[i + 2]);
        v2u w; w.x = pg8::cvt_pk_bf16(y.x, y.y); w.y = pg8::cvt_pk_bf16(y.z, y.w); *(GAS v2u*)(MIX + (size_t)row * D + 2048 + c0) = w;
        if (i >= 6) {
            if (r0 == SEQ - 8) *(GAS f32x4*)(A.out + O_CP + (size_t)(i - 6) * 2048 + c0) = u[2 + i];
            if (r0 >= SEQ) *(GAS f32x4*)(A.out + O_CS + ((size_t)((r0 - SEQ) >> 3) * 2 + (i - 6)) * 2048 + c0) = u[2 + i]; } }
#undef load4
}
__device__ __forceinline__ void mixer_phase(Frame& F, const Args& A) {
#ifndef PROBE_P7
#define PROBE_P7 0
#endif
    for (int u = F.vcu; u < 256 * (PROBE_P7 == 1 ? 2 : 1); u += F.G) prompt_unit(F, A, (u & 255) >> 2, u & 3);
    for (int u = F.vcu; u < 512 * (PROBE_P7 == 2 ? 2 : 1); u += F.G) sample_unit(F, A, (u & 511) >> 2, u & 3);
    for (int u = F.vcu * NWAVES + F.wave; u < (M / 8) * 8 * (PROBE_P7 == 3 ? 2 : 1); u += F.G * NWAVES) conv_item(F, A, u % ((M / 8) * 8));
}
}

constexpr int N_PHASES = 13;
__global__ void __launch_bounds__(NWAVES * 64, 2) mk_fwd(Args args) {
    extern __shared__ __attribute__((aligned(16))) unsigned char lds[];
    Frame F;
    F.lds = (LAS unsigned char*)lds;
    F.MISC = (volatile LAS unsigned*)(F.lds + MISC_OFF);
    F.tid = threadIdx.x; F.lane = F.tid & 63; F.wave = __builtin_amdgcn_readfirstlane(F.tid >> 6);
    F.G = gridDim.x; { const int bx = blockIdx.x; F.vcu = (F.G % 8 == 0) ? (bx % 8) * (F.G / 8) + bx / 8 : bx; }
    unsigned char* ws = args.ws;
    F.ctl = (gu32*)(ws + WS_CTL);
    for (int u = F.tid; u < (LDS_BYTES - LDSCTL_OFF) / 4; u += NWAVES * 64) ((LAS unsigned*)(F.lds + LDSCTL_OFF))[u] = 0u;
    __syncthreads();
    XcdBarrier bar = xcd_barrier_post((unsigned*)(F.ctl + CW_BAR), F.MISC + 8);
    const int lo = args.ph_lo, hi = args.ph_hi;
#define IN(k) (lo <= (k) && (k) < hi)
#ifndef PROBE_PHASE
#define PROBE_PHASE -1
#endif
#define REPS(k) ((PROBE_PHASE == (k)) ? 2 : 1)
#define SEAM(k) do { if (IN(k) && IN((k) + 1)) xcd_barrier(bar); } while (0)
    bf16* W13A = (bf16*)(ws + WS_W13A); bf16* W2A = (bf16*)(ws + WS_W2A); bf16* WINT = (bf16*)(ws + WS_WIN); bf16* WOUT = (bf16*)(ws + WS_WOUT);
    bf16* W13B = (bf16*)(ws + WS_W13B); bf16* W2B = (bf16*)(ws + WS_W2B); bf16* WADA = (bf16*)(ws + WS_WADA); bf16* CSI = (bf16*)(ws + WS_CSI);
    float* MOD = (float*)(ws + WS_MOD); bf16* X1 = (bf16*)(ws + WS_X1);     bf16* H = (bf16*)(ws + WS_H); bf16* T = (bf16*)(ws + WS_T);
    bf16* PROJ = (bf16*)(ws + WS_PROJ); bf16* MIX = (bf16*)(ws + WS_MIX);
    const int cb = (int)blockIdx.x;

    if (IN(0)) {
#pragma unroll
        for (int rep = 0; rep < REPS(0); ++rep) { if (rep) xcd_barrier(bar);  csilu_phase(F, args); { const int rank = F.vcu * NWAVES + F.wave, nw = F.G * NWAVES; conv_job<JOB_W1A>(F, args, rank, nw); conv_job<JOB_W3A>(F, args, rank, nw); conv_job<JOB_WIN>(F, args, rank, nw); }  } } SEAM(0);
    if (IN(1)) {
#pragma unroll
        for (int rep = 0; rep < REPS(1); ++rep) { if (rep) xcd_barrier(bar); mod_chunk_partials(F, args, 0, F.vcu, F.G); } } SEAM(1);
    if (IN(2)) {
#pragma unroll
        for (int rep = 0; rep < REPS(2); ++rep) { if (rep) xcd_barrier(bar);  normmod_phase<true, false>(F, args.in[I_XP], args.in[I_XS], args.in[I_G1], MOD, 0, 1, H);  } } SEAM(2);
    if (IN(3)) {
#pragma unroll
        for (int rep = 0; rep < REPS(3); ++rep) { if (rep) xcd_barrier(bar);  pg8::Gemm g{H, W13A, M, 2 * FF, D / 2}; pg8::StaticOrder S; S.init(M, 2 * FF, F.G, cb);
        pg8::EpiSwiGLU8 E{(unsigned char*)T, FF, 1.0f / (S_H * S_W13), S_T};
        #if UP_CUT
#pragma unroll 1
        for (int sb = 0; sb < S.nwg; sb += UP_CUT) { if (sb) xcd_barrier(bar); S.sub(sb, (sb + 2 * UP_CUT > S.nwg) ? S.nwg : sb + UP_CUT);
            pg8::gemm_phase<pg8::EpiSwiGLU8, pg8::StaticOrder, PG8_ALIGN, PG8_SP2, true>(F.lds + RING_OFF, g, S, E); if (sb + 2 * UP_CUT > S.nwg) break; }
#else
        pg8::gemm_phase<pg8::EpiSwiGLU8, pg8::StaticOrder, PG8_ALIGN, PG8_SP2, true>(F.lds + RING_OFF, g, S, E);
#endif
#if PROBE_GEMM
        { xcd_barrier(bar); pg8::DegenOrder S2; S2.init(M, 2 * FF, F.G, cb); pg8::EpiNull E2{(float*)(ws + WS_PART)};
          pg8::gemm_phase<pg8::EpiNull, pg8::DegenOrder, PG8_ALIGN, PG8_SP2, true, PROBE_GEMM - 1>(F.lds + RING_OFF, g, S2, E2); xcd_barrier(bar); }
#endif
        if (rep == 0) { const int left = ((M / 256) * (2 * FF / 256)) % F.G;
            if (cb >= left) { const int rank = (cb - left) * NWAVES + F.wave, nw = (F.G - left) * NWAVES; conv_job<JOB_W2A>(F, args, rank, nw); } } } } SEAM(3);
    if (IN(4)) {
#pragma unroll
        for (int rep = 0; rep < REPS(4); ++rep) { if (rep) xcd_barrier(bar);  pg8::Gemm g{T, W2A, M, D, FF / 2}; pg8::StaticOrder S; S.init(M, D, F.G, cb);
        pg8::EpiResid<true, false> E{args.in[I_XP], args.in[I_XS], X1, MOD, D, MODW, 2 * D, SEQ, 0.5f / (S_T * S_W2)};
        pg8::gemm_phase<pg8::EpiResid<true, false>, pg8::StaticOrder, PG8_ALIGN, PG8_SP2, true>(F.lds + RING_OFF, g, S, E);
        if (rep == 0) { const int left = ((M / 256) * (D / 256)) % F.G;
            if (cb >= left) { const int ir = cb - left, ni = F.G - left;
                mod_chunk_partials(F, args, 1, ir, ni); __syncthreads(); {     const int rank = ir * NWAVES + F.wave, nw = ni * NWAVES; conv_job<JOB_W1B>(F, args, rank, nw); } } } } } SEAM(4);
    if (IN(5)) { normmod_phase<false, true>(F, X1, X1 + (size_t)SEQ * D, args.in[I_GM], MOD, 3, 4, H); } SEAM(5);
    if (IN(6)) {
#pragma unroll
        for (int rep = 0; rep < REPS(6); ++rep) { if (rep) xcd_barrier(bar);  pg8::Gemm g{H, WINT, M, NPROJ, D}; pg8::StaticOrder S; S.init(M, NPROJ, F.G, cb);
        pg8::EpiBf16 E{PROJ, NPROJ};
        pg8::gemm_phase<pg8::EpiBf16, pg8::StaticOrder, PG8_ALIGN, PG8_SP2>(F.lds + RING_OFF, g, S, E);
        if (rep == 0) { const int left = ((M / 256) * (NPROJ / 256)) % F.G;
            if (cb >= left) { const int ir = cb - left, ni = F.G - left;
                mod_chunk_partials(F, args, 2, ir, ni); __syncthreads(); { const int rank = ir * NWAVES + F.wave, nw = ni * NWAVES; conv_job<JOB_WOUT>(F, args, rank, nw); conv_job<JOB_W3B>(F, args, rank, nw); } } } } } SEAM(6);
    if (IN(7)) {
#pragma unroll
        for (int rep = 0; rep < REPS(7); ++rep) { if (rep) xcd_barrier(bar);  att::mixer_phase(F, args);  } } SEAM(7);
    if (IN(8)) { pg8::Gemm g{MIX, WOUT, M, D, D}; pg8::StaticOrder S; S.init(M, D, F.G, cb);
        pg8::EpiResid<true, true> E{X1, X1 + (size_t)SEQ * D, X1, MOD, D, MODW, 5 * D, SEQ, 1.0f};
        pg8::gemm_phase<pg8::EpiResid<true, true>, pg8::StaticOrder, PG8_ALIGN, PG8_SP2>(F.lds + RING_OFF, g, S, E);
        { const int left = ((M / 256) * (D / 256)) % F.G;
            if (cb >= left) { const int rank = (cb - left) * NWAVES + F.wave, nw = (F.G - left) * NWAVES; conv_job<JOB_W2B>(F, args, rank, nw); } } } SEAM(8);
    if (IN(9)) { normmod_phase<true, true>(F, X1, X1 + (size_t)SEQ * D, args.in[I_G2], MOD, 6, 7, H); } SEAM(9);
    if (IN(10)) { pg8::Gemm g{H, W13B, M, 2 * FF, D / 2}; pg8::ListOrder S; { pg8::SkOrder K; K.init(M, 2 * FF, D / 2, F.G, cb); S.list = (const LAS int*)(F.lds + SKLIST_OFF); S.n = pg8::sk_build_list(K, (LAS int*)(F.lds + SKLIST_OFF)); }
        S.slots = (float*)(ws + WS_SKS); S.counters = (unsigned*)(F.ctl + CW_SK + 0 * CW_SK_STRIDE);
        pg8::EpiSwiGLU8 E{(unsigned char*)T, FF, 1.0f / (S_H * S_W13), S_T};
        pg8::gemm_phase<pg8::EpiSwiGLU8, pg8::ListOrder, PG8_ALIGN, PG8_SP2, true>(F.lds + RING_OFF, g, S, E); } SEAM(10);
    if (IN(11)) { pg8::Gemm g{T, W2B, M, D, FF / 2}; pg8::ListOrder S; { pg8::SkOrder K; K.init(M, D, FF / 2, F.G, cb); S.list = (const LAS int*)(F.lds + SKLIST_OFF); S.n = pg8::sk_build_list(K, (LAS int*)(F.lds + SKLIST_OFF)); }
        S.slots = (float*)(ws + WS_SKS2); S.counters = (unsigned*)(F.ctl + CW_SK + 1 * CW_SK_STRIDE);
        pg8::EpiResid<false, true> E{X1, X1 + (size_t)SEQ * D, X1, MOD, D, MODW, 8 * D, SEQ, 0.5f / (S_T * S_W2)};
        pg8::gemm_phase<pg8::EpiResid<false, true>, pg8::ListOrder, PG8_ALIGN, PG8_SP2, true>(F.lds + RING_OFF, g, S, E); } SEAM(11);
    if (IN(12)) { final_norm_phase(F, X1, args.in[I_GF], args.out); }
#undef IN
#undef SEAM
}

extern "C" void kernel_launch(void* const* d_in, const int* in_sizes, int n_in, void* d_out, int out_size, void* d_ws, size_t ws_size, hipStream_t stream) {
    static int grid = 0;
    if (grid == 0) {
        if (n_in != N_IN || (size_t)out_size != O_END || ws_size < WS_END) { fprintf(stderr, "kernel_launch: unexpected shapes: n_in %d out %d ws %zu (need %zu)\n", n_in, out_size, ws_size, (size_t)WS_END); grid = -1; return; }
        int dev = 0, cus = 0, per_cu = 0;
        if (hipGetDevice(&dev) != hipSuccess || hipDeviceGetAttribute(&cus, hipDeviceAttributeMultiprocessorCount, dev) != hipSuccess) { grid = -1; return; }
        if (hipFuncSetAttribute((const void*)mk_fwd, hipFuncAttributeMaxDynamicSharedMemorySize, LDS_BYTES) != hipSuccess) { fprintf(stderr, "kernel_launch: hipFuncSetAttribute failed\n"); grid = -1; return; }
        if (hipOccupancyMaxActiveBlocksPerMultiprocessor(&per_cu, (const void*)mk_fwd, NWAVES * 64, LDS_BYTES) != hipSuccess || per_cu < 1) { fprintf(stderr, "kernel_launch: occupancy query says %d\n", per_cu); }
        (void)hipGetLastError();
        grid = cus;
    }
    if (grid < 0) return;
    if (hipMemsetAsync((char*)d_ws + WS_CTL, 0, CTL_ZERO_BYTES, stream) != hipSuccess) return;
    Args a{};
    for (int i = 0; i < N_IN; ++i) a.in[i] = (const float*)d_in[i];
    a.out = (float*)d_out; a.ws = (unsigned char*)d_ws;
#if MK_PER_PHASE
    for (int p = 0; p < N_PHASES; ++p) { a.ph_lo = p; a.ph_hi = p + 1; hipLaunchKernelGGL(mk_fwd, dim3(grid), dim3(NWAVES * 64), LDS_BYTES, stream, a); }
#else
    a.ph_lo = 0; a.ph_hi = N_PHASES;
    hipLaunchKernelGGL(mk_fwd, dim3(grid), dim3(NWAVES * 64), LDS_BYTES, stream, a);
#endif
    const hipError_t le = hipPeekAtLastError();
    if (le != hipSuccess) fprintf(stderr, "kernel_launch: launch failed: %s\n", hipGetErrorName(le));
}
```

```cpp
#include <hip/hip_runtime.h>
#include <cstdio>
#include <cstdint>
#ifndef PG8_LOADPRIO
#define PG8_LOADPRIO 0
#endif
namespace pg8 {
#define PG8_LAS __attribute__((address_space(3)))
typedef unsigned short bf16_t;
typedef short bf16x8 __attribute__((ext_vector_type(8)));
typedef float f32x4 __attribute__((ext_vector_type(4)));
typedef unsigned u32x4 __attribute__((ext_vector_type(4)));
typedef unsigned u32x2 __attribute__((ext_vector_type(2)));
typedef int i32x4 __attribute__((ext_vector_type(4)));
typedef int i32x8 __attribute__((ext_vector_type(8)));
__device__ __forceinline__ i32x8 cat8(bf16x8 lo, bf16x8 hi) { return __builtin_shufflevector(__builtin_bit_cast(i32x4, lo), __builtin_bit_cast(i32x4, hi), 0, 1, 2, 3, 4, 5, 6, 7); }
__device__ __forceinline__ unsigned cvt4_fp8(float a, float b, float c, float d) {
    a = __builtin_fminf(__builtin_fmaxf(a, -448.f), 448.f); b = __builtin_fminf(__builtin_fmaxf(b, -448.f), 448.f);
    c = __builtin_fminf(__builtin_fmaxf(c, -448.f), 448.f); d = __builtin_fminf(__builtin_fmaxf(d, -448.f), 448.f);
    int w = 0; w = __builtin_amdgcn_cvt_pk_fp8_f32(a, b, w, false); w = __builtin_amdgcn_cvt_pk_fp8_f32(c, d, w, true); return (unsigned)w; }
constexpr int BM = 256, BK = 64, HALF = 128, HTB = HALF * BK * 2  , STAGE_BYTES = 8 * HTB, NXCD = 8, WGM = 8;

__host__ __device__ __forceinline__ int lds_byte(int r, int c) { const int st = (r >> 4) * 2 + (c >> 5), rr = r & 15, cc = c & 31, ob = rr * 64 + cc * 2; return st * 1024 + (ob ^ (((ob >> 9) & 1) << 5)); }
__host__ __device__ __forceinline__ void stage_rc(int b, int& R, int& C) { const int st = b / 1024, sb = b % 1024, swz = sb ^ (((sb >> 9) & 1) << 5); R = (st >> 1) * 16 + swz / 64; C = (st & 1) * 32 + (swz % 64) / 2; }
__host__ __device__ __forceinline__ int perm32(int rho) { const int n = rho >> 4, i = rho & 15; return 8 * (i >> 2) + 4 * n + (i & 3); }

struct Unit { int pm, pn, kb, ke, kind, slot; };
struct Gemm { const bf16_t* A; const bf16_t* Bt; int M, N, K; };

struct StaticOrder {
    static constexpr bool SK = false;
    int nM, nN, nwg, G, c, base, lim;
    __host__ __device__ void init(int M, int N, int G_, int c_) { nM = M / BM; nN = N / BM; nwg = nM * nN; G = G_; c = c_; base = 0; lim = nwg; }
    __host__ __device__ void sub(int b, int l) { base = b; lim = l < nwg ? l : nwg; }
    __host__ __device__ bool next(int i, Unit& u) const {
        const long L = (long)base + (long)i * G + c; if (L >= lim) return false;
        int wgid = (int)L; { const int q = nwg / NXCD, r = nwg % NXCD, xcd = wgid % NXCD, off = wgid / NXCD; wgid = (xcd < r ? xcd * (q + 1) : r * (q + 1) + (xcd - r) * q) + off; }
        const int nig = WGM * nN, gid = wgid / nig, fm = gid * WGM, gsz = (nM - fm) < WGM ? (nM - fm) : WGM;
        u.pm = fm + ((wgid % nig) % gsz); u.pn = (wgid % nig) / gsz; return true;
    }
    __device__ __forceinline__ void a_ready(const Unit&) const {}
    __device__ __forceinline__ void done(const Unit&) const {}
};

struct DegenOrder {
    static constexpr bool SK = false;
    int nwg, G, c;
    __device__ __forceinline__ void init(int M, int N, int G_, int c_) { nwg = (M / BM) * (N / BM); G = G_; c = c_; }
    __device__ __forceinline__ bool next(int i, Unit& u) const { if ((long)i * G + c >= nwg) return false; u.pm = 0; u.pn = 0; return true; }
    __device__ __forceinline__ void a_ready(const Unit&) const {}
    __device__ __forceinline__ void done(const Unit&) const {}
};
struct SkOrder {
    int nM, nN, nwg, G, c, Rs, cnt8, qq, nt, np, q, ufirst, ulast, nsk; long s, e;
    __device__ __forceinline__ void init(int M, int N, int Kbf, int G_, int c_) {
        nM = M / BM; nN = N / BM; nwg = nM * nN; G = G_; c = c_; nt = Kbf / BK; np = nt / 2;
        if (G != 256 || (nwg % 8) != 0 || nwg < 2 * G) { Rs = (nwg + G - 1) / G; nsk = 0; qq = nwg / 8; cnt8 = 0; q = 0; s = e = 0; ufirst = ulast = 0; return; }
        Rs = nwg / G - 1; const int usk = nwg - Rs * G; cnt8 = usk / 8; qq = nwg / 8; q = (c % 8) * 32 + c / 8;
        const long P = (long)usk * np; s = (long)q * P / G; e = (long)(q + 1) * P / G;
        ufirst = (int)(s / np); ulast = (int)((e - 1) / np); nsk = ulast - ufirst + 1;
    }
    __device__ __forceinline__ void tile_of(int wgid, Unit& u) const { const int nig = WGM * nN, gid = wgid / nig, fm = gid * WGM, gsz = (nM - fm) < WGM ? (nM - fm) : WGM; u.pm = fm + ((wgid % nig) % gsz); u.pn = (wgid % nig) / gsz; }
    __device__ __forceinline__ bool next(int i, Unit& u) const {
        if (i < Rs) { const long L = (long)i * G + c; if (L >= nwg) return false;
            int wgid = (int)L; { const int qv = nwg / NXCD, r = nwg % NXCD, xcd = wgid % NXCD, off = wgid / NXCD; wgid = (xcd < r ? xcd * (qv + 1) : r * (qv + 1) + (xcd - r) * qv) + off; }
            tile_of(wgid, u); u.kb = 0; u.ke = nt; u.kind = 0; u.slot = 0; return true; }
        const int j = i - Rs; if (j >= nsk) return false;
        const int un = ufirst + j; tile_of((un / cnt8) * qq + 32 * Rs + (un % cnt8), u);
        u.kb = (j == 0) ? 2 * (int)(s - (long)ufirst * np) : 0; u.ke = (un == ulast) ? 2 * (int)(e - (long)ulast * np) : nt;
        u.kind = (u.kb > 0) ? 1 : ((u.ke < nt) ? 2 : 0); u.slot = (u.kind == 1) ? q : q + 1; return true;
    }
    __device__ __forceinline__ int count() const { return Rs + nsk; }
};

struct ListOrder {
    static constexpr bool SK = true;
    const PG8_LAS int* list; int n;
    float* slots; unsigned* counters;
    __device__ __forceinline__ bool next(int i, Unit& u) const {
        if (i >= n) return false; const PG8_LAS int* p = list + 8 * i;
        u.pm = __builtin_amdgcn_readfirstlane(p[0]); u.pn = __builtin_amdgcn_readfirstlane(p[1]); u.kb = __builtin_amdgcn_readfirstlane(p[2]);
        u.ke = __builtin_amdgcn_readfirstlane(p[3]); u.kind = __builtin_amdgcn_readfirstlane(p[4]); u.slot = __builtin_amdgcn_readfirstlane(p[5]); return true;
    }
    __device__ __forceinline__ void a_ready(const Unit&) const {}
    __device__ __forceinline__ void done(const Unit&) const {}
    __device__ __forceinline__ void store_partial(const f32x4 (&acc)[2][2][4][2], const Unit& u, int tid) const {
        const __amdgpu_buffer_rsrc_t rs = __builtin_amdgcn_make_buffer_rsrc((void*)(slots + (size_t)u.slot * 65536), (short)0, 262144, 0x00020000);
#pragma unroll
        for (int a = 0; a < 2; ++a)
#pragma unroll
            for (int b = 0; b < 2; ++b)
#pragma unroll
                for (int m = 0; m < 4; ++m)
#pragma unroll
                    for (int n = 0; n < 2; ++n) __builtin_amdgcn_raw_buffer_store_b128(__builtin_bit_cast(u32x4, acc[a][b][m][n]), rs, ((((a * 2 + b) * 4 + m) * 2 + n) * 512 + tid) * 16, 0, 16);
        asm volatile("s_waitcnt vmcnt(0)" ::: "memory");
        if ((tid & 63) == 0) __hip_atomic_fetch_add(counters + 64 * u.slot, 1u, __ATOMIC_RELAXED, __HIP_MEMORY_SCOPE_AGENT);
    }
    __device__ __forceinline__ void add_partial(f32x4 (&acc)[2][2][4][2], const Unit& u, int tid, int wid) const {
        if (wid == 0) {
            unsigned spins = 0;
            while ((unsigned)__builtin_amdgcn_readfirstlane(__hip_atomic_load(counters + 64 * u.slot, __ATOMIC_RELAXED, __HIP_MEMORY_SCOPE_AGENT)) < 8u) { __builtin_amdgcn_s_sleep(2); if (++spins > (1u << 22)) break; }
            __builtin_amdgcn_fence(__ATOMIC_ACQUIRE, "agent");
            asm volatile("s_waitcnt vmcnt(0)" ::: "memory");
        }
        asm volatile("" ::: "memory"); __builtin_amdgcn_s_barrier(); asm volatile("" ::: "memory");
        const float* sp = slots + (size_t)u.slot * 65536;
#pragma unroll
        for (int a = 0; a < 2; ++a)
#pragma unroll
            for (int b = 0; b < 2; ++b)
#pragma unroll
                for (int m = 0; m < 4; ++m)
                {
#pragma unroll
                  for (int n = 0; n < 2; ++n) acc[a][b][m][n] += *(const f32x4*)(sp + ((size_t)((((a * 2 + b) * 4 + m) * 2 + n) * 512 + tid)) * 4);
                  if (m == 3) asm volatile("" : "+v"(acc[a][b][0][0]), "+v"(acc[a][b][0][1]), "+v"(acc[a][b][1][0]), "+v"(acc[a][b][1][1]), "+v"(acc[a][b][2][0]), "+v"(acc[a][b][2][1]), "+v"(acc[a][b][3][0]), "+v"(acc[a][b][3][1]) :: "memory"); }
    }
};
__device__ __forceinline__ int sk_build_list(const SkOrder& S, PG8_LAS int* list) {
    const int n = S.count();
    if ((int)threadIdx.x < n && threadIdx.x < 32) { Unit u; S.next((int)threadIdx.x, u); PG8_LAS int* p = list + 8 * threadIdx.x; p[0] = u.pm; p[1] = u.pn; p[2] = u.kb; p[3] = u.ke; p[4] = u.kind; p[5] = u.slot; }
    __syncthreads();
    return n < 32 ? n : 32;
}

__device__ __forceinline__ unsigned cvt_pk_bf16(float lo, float hi) { unsigned r; asm volatile("v_cvt_pk_bf16_f32 %0, %1, %2" : "=v"(r) : "v"(lo), "v"(hi)); return r; }
typedef float f32x2 __attribute__((ext_vector_type(2)));

struct EpiNull {
    static constexpr bool PERM = true, AFTER_DRAIN = false;
    float* sink;
    __device__ __forceinline__ void operator()(const f32x4 (&acc)[2][2][4][2], const Unit& u, int wr, int wc, int fr, int fq) const {
        f32x4 s = acc[0][0][0][0];
#pragma unroll
        for (int a = 0; a < 2; ++a)
#pragma unroll
            for (int b = 0; b < 2; ++b)
#pragma unroll
                for (int m = 0; m < 4; ++m)
#pragma unroll
                    for (int n = 0; n < 2; ++n) s += acc[a][b][m][n];
        if (s[0] + s[1] + s[2] + s[3] == 1.2345e37f) *sink = s[0];
    }
};
struct EpiF32 {
    static constexpr bool PERM = false, AFTER_DRAIN = false;
    float* C; int ldc; const float* bias;
    __device__ __forceinline__ void operator()(const f32x4 (&acc)[2][2][4][2], const Unit& u, int wr, int wc, int fr, int fq) const {
        const int row0 = u.pm * BM + wr * 64 + fr, col0 = u.pn * BM + wc * 32 + 4 * fq;
        f32x4 bv[2][2];
#pragma unroll
        for (int bj = 0; bj < 2; ++bj)
#pragma unroll
            for (int n = 0; n < 2; ++n) bv[bj][n] = *(const f32x4*)(bias + col0 + bj * HALF + n * 16);
#pragma unroll
        for (int ai = 0; ai < 2; ++ai)
#pragma unroll
            for (int m = 0; m < 4; ++m) { float* rowp = C + (size_t)(row0 + ai * HALF + m * 16) * ldc + col0;
#pragma unroll
                for (int bj = 0; bj < 2; ++bj)
#pragma unroll
                    for (int n = 0; n < 2; ++n) *(f32x4*)(rowp + bj * HALF + n * 16) = acc[ai][bj][m][n] + bv[bj][n]; }
    }
};
struct EpiBf16 {
    static constexpr bool PERM = true, AFTER_DRAIN = false;
    bf16_t* O; int ldc;
    __device__ __forceinline__ void operator()(const f32x4 (&acc)[2][2][4][2], const Unit& u, int wr, int wc, int fr, int fq) const {
        const int row0 = u.pm * BM + wr * 64 + fr, col0 = u.pn * BM + wc * 32 + 8 * fq;
#pragma unroll
        for (int ai = 0; ai < 2; ++ai)
#pragma unroll
            for (int m = 0; m < 4; ++m) { bf16_t* rowp = O + (size_t)(row0 + ai * HALF + m * 16) * ldc + col0;
#pragma unroll
                for (int bj = 0; bj < 2; ++bj) { const f32x4 v0 = acc[ai][bj][m][0], v1 = acc[ai][bj][m][1];
                    u32x4 w; w.x = cvt_pk_bf16(v0[0], v0[1]); w.y = cvt_pk_bf16(v0[2], v0[3]); w.z = cvt_pk_bf16(v1[0], v1[1]); w.w = cvt_pk_bf16(v1[2], v1[3]);
                    *(u32x4*)(rowp + bj * HALF) = w; } }
    }
};
__device__ __forceinline__ float silu_mul(float a, float b) { return a * b * __builtin_amdgcn_rcpf(1.0f + __expf(-a)); }
struct EpiSwiGLU {
    static constexpr bool PERM = true, AFTER_DRAIN = false;
    bf16_t* O; int ldc;
    __device__ __forceinline__ void operator()(const f32x4 (&acc)[2][2][4][2], const Unit& u, int wr, int wc, int fr, int fq) const {
        const int row0 = u.pm * BM + wr * 64 + fr, col0 = u.pn * HALF + wc * 32 + 8 * fq;
#pragma unroll
        for (int ai = 0; ai < 2; ++ai)
#pragma unroll
            for (int m = 0; m < 4; ++m) { bf16_t* rowp = O + (size_t)(row0 + ai * HALF + m * 16) * ldc + col0;
                const f32x4 a0 = acc[ai][0][m][0], a1 = acc[ai][0][m][1], b0 = acc[ai][1][m][0], b1 = acc[ai][1][m][1];
                u32x4 w;
                w.x = cvt_pk_bf16(silu_mul(a0[0], b0[0]), silu_mul(a0[1], b0[1])); w.y = cvt_pk_bf16(silu_mul(a0[2], b0[2]), silu_mul(a0[3], b0[3]));
                w.z = cvt_pk_bf16(silu_mul(a1[0], b1[0]), silu_mul(a1[1], b1[1])); w.w = cvt_pk_bf16(silu_mul(a1[2], b1[2]), silu_mul(a1[3], b1[3]));
                *(u32x4*)rowp = w; }
    }
};
struct EpiSwiGLU8 {
    static constexpr bool PERM = true, AFTER_DRAIN = false;
    unsigned char* O; int ldc; float inv, st;
    __device__ __forceinline__ void operator()(const f32x4 (&acc)[2][2][4][2], const Unit& u, int wr, int wc, int fr, int fq) const {
        const int row0 = u.pm * BM + wr * 64 + fr, col0 = u.pn * HALF + wc * 32 + 8 * fq;
        const float ib = inv * st;
#pragma unroll
        for (int ai = 0; ai < 2; ++ai)
#pragma unroll
            for (int m = 0; m < 4; ++m) { unsigned char* rowp = O + (size_t)(row0 + ai * HALF + m * 16) * ldc + col0;
                const f32x4 a0 = acc[ai][0][m][0] * inv, a1 = acc[ai][0][m][1] * inv, b0 = acc[ai][1][m][0] * ib, b1 = acc[ai][1][m][1] * ib;
                u32x2 w;
                w.x = cvt4_fp8(silu_mul(a0[0], b0[0]), silu_mul(a0[1], b0[1]), silu_mul(a0[2], b0[2]), silu_mul(a0[3], b0[3]));
                w.y = cvt4_fp8(silu_mul(a1[0], b1[0]), silu_mul(a1[1], b1[1]), silu_mul(a1[2], b1[2]), silu_mul(a1[3], b1[3]));
                *(u32x2*)rowp = w; }
    }
};
template <bool PIPE, bool BASE_BF16> struct EpiResid {
    static constexpr bool PERM = false, AFTER_DRAIN = false;
    const void* base_p; const void* base_s; bf16_t* out; const float* mod; int ldc, modld, goff, split_rows; float gs;
    static __device__ __forceinline__ f32x4 ldb(const void* rowp, int c) {
        if constexpr (BASE_BF16) { const u32x2 q = *(const u32x2*)((const bf16_t*)rowp + c);
            return (f32x4){__builtin_bit_cast(float, q.x << 16), __builtin_bit_cast(float, q.x & 0xffff0000u), __builtin_bit_cast(float, q.y << 16), __builtin_bit_cast(float, q.y & 0xffff0000u)}; }
        else return *(const f32x4*)((const float*)rowp + c);
    }
    static __device__ __forceinline__ const void* rowptr(const void* b, size_t r, int ldc) { if constexpr (BASE_BF16) return (const bf16_t*)b + r * ldc; else return (const float*)b + r * ldc; }
    static __device__ __forceinline__ void stq(bf16_t* p, f32x4 v) { u32x2 w; w.x = cvt_pk_bf16(v[0], v[1]); w.y = cvt_pk_bf16(v[2], v[3]); *(u32x2*)p = w; }
    __device__ __forceinline__ void operator()(const f32x4 (&acc)[2][2][4][2], const Unit& u, int wr, int wc, int fr, int fq) const {
        const int col0 = u.pn * BM + wc * 32 + 4 * fq;
        if (PIPE && u.pm * BM < split_rows) {
            f32x4 gq[2][2], bc[2][2], bn[2][2];
            { const void* rp = rowptr(base_p, (size_t)(u.pm * BM + wr * 64 + fr), ldc);
#pragma unroll
            for (int bj = 0; bj < 2; ++bj)
#pragma unroll
                for (int n = 0; n < 2; ++n) { gq[bj][n] = *(const f32x4*)(mod + goff + col0 + bj * HALF + n * 16) * gs; bc[bj][n] = ldb(rp, col0 + bj * HALF + n * 16); } }
#pragma unroll
            for (int gi = 0; gi < 8; ++gi) { const int ai = gi >> 2, m = gi & 3; const int r = u.pm * BM + ai * HALF + wr * 64 + m * 16 + fr;
                if (gi < 7) { const void* rp = rowptr(base_p, (size_t)(u.pm * BM + ((gi + 1) >> 2) * HALF + wr * 64 + ((gi + 1) & 3) * 16 + fr), ldc);
#pragma unroll
                    for (int bj = 0; bj < 2; ++bj)
#pragma unroll
                        for (int n = 0; n < 2; ++n) bn[bj][n] = ldb(rp, col0 + bj * HALF + n * 16); }
                bf16_t* orow = out + (size_t)r * ldc;
#pragma unroll
                for (int bj = 0; bj < 2; ++bj)
#pragma unroll
                    for (int n = 0; n < 2; ++n) { stq(orow + col0 + bj * HALF + n * 16, bc[bj][n] + gq[bj][n] * acc[ai][bj][m][n]); bc[bj][n] = bn[bj][n]; }
                asm volatile("" ::: "memory"); }
        } else {
#pragma unroll
            for (int ai = 0; ai < 2; ++ai)
#pragma unroll
                for (int m = 0; m < 4; ++m) { const int r = u.pm * BM + ai * HALF + wr * 64 + m * 16 + fr;
                    const void* brow = (r < split_rows) ? rowptr(base_p, (size_t)r, ldc) : rowptr(base_s, (size_t)(r - split_rows), ldc);
                    const float* grow = mod + (size_t)((r < split_rows) ? 0 : 1 + ((r - split_rows) >> 3)) * modld + goff;
                    bf16_t* orow = out + (size_t)r * ldc;
#pragma unroll
                    for (int bj = 0; bj < 2; ++bj)
#pragma unroll
                        for (int n = 0; n < 2; ++n) { const int c = col0 + bj * HALF + n * 16;
                            const f32x4 b = ldb(brow, c), g = *(const f32x4*)(grow + c);
                            stq(orow + c, b + (g * gs) * acc[ai][bj][m][n]); }
                    asm volatile("" ::: "memory"); }
        }
    }
};
template <class Epi, class Sched, bool ALIGN_EPI = false, bool SP2 = false, bool FP8 = false, int DIAG = 0>
__device__ __forceinline__ void gemm_phase(PG8_LAS unsigned char* lds, const Gemm g, const Sched& S, const Epi& E) {
    const int tid = threadIdx.x, wid = __builtin_amdgcn_readfirstlane(tid >> 6), lane = tid & 63, wr = wid >> 2, wc = wid & 3, fr = lane & 15, fq = lane >> 4;
    const int K = g.K, nt = K / BK;
    unsigned voffA[2], voffB[2];
#pragma unroll
    for (int i = 0; i < 2; ++i) { int R, C; stage_rc(tid * 16 + i * 8192, R, C); const int Rb = Epi::PERM ? ((R & ~31) + perm32(R & 31)) : R;
        voffA[i] = (unsigned)(R * K + C) * 2u; voffB[i] = (unsigned)(Rb * K + C) * 2u; }
    const size_t kstep = (size_t)(BK * 2);
    const size_t hstep = (size_t)HALF * K * 2;
    const size_t tstep = 2 * hstep;
    const unsigned ldsw = (unsigned)wid * 1024u;
    const int aoff = lds_byte(wr * 64 + fr, fq * 8), boff = lds_byte(wc * 32 + fr, fq * 8);
#define PG8_SA(b, h) (((b) * 2 + (h)) * HTB)
#define PG8_SB(b, h) ((4 + (b) * 2 + (h)) * HTB)
#define PG8_STAGE(bufoff, gbase, voff) do { if constexpr (DIAG >= 1) break; _Pragma("unroll") for (int _i = 0; _i < 2; ++_i) \
        __builtin_amdgcn_global_load_lds((const unsigned*)((const char*)(gbase) + (voff)[_i]), (PG8_LAS unsigned*)(lds + (bufoff) + ldsw + _i * 8192), 16, 0, 0); } while (0)
#define PG8_LDA(dst, b, h) do { if constexpr (DIAG == 2 || DIAG == 3) break; _Pragma("unroll") for (int m = 0; m < 4; ++m) _Pragma("unroll") for (int k = 0; k < 2; ++k) dst[m][k] = *(const PG8_LAS bf16x8*)(lds + PG8_SA(b, h) + aoff + m * 2048 + k * 1024); } while (0)
#define PG8_LDB(dst, b, h) do { if constexpr (DIAG == 2 || DIAG == 3) break; _Pragma("unroll") for (int n = 0; n < 2; ++n) _Pragma("unroll") for (int k = 0; k < 2; ++k) dst[n][k] = *(const PG8_LAS bf16x8*)(lds + PG8_SB(b, h) + boff + n * 2048 + k * 1024); } while (0)
#define PG8_MMA(ai, bj, At, Bt) do { if constexpr (DIAG == 4) { _Pragma("unroll") for (int m = 0; m < 4; ++m) asm volatile("" :: "v"(cat8(At[m][0], At[m][1]))); _Pragma("unroll") for (int n = 0; n < 2; ++n) asm volatile("" :: "v"(cat8(Bt[n][0], Bt[n][1]))); break; } __builtin_amdgcn_s_setprio(1); _Pragma("unroll") for (int m = 0; m < 4; ++m) _Pragma("unroll") for (int n = 0; n < 2; ++n) { \
        if constexpr (FP8) { asm volatile("v_mfma_f32_16x16x128_f8f6f4 %0, %1, %2, %0" : "+v"(acc[ai][bj][m][n]) : "v"(cat8(Bt[n][0], Bt[n][1])), "v"(cat8(At[m][0], At[m][1]))); } \
        else { _Pragma("unroll") for (int k = 0; k < 2; ++k) acc[ai][bj][m][n] = __builtin_amdgcn_mfma_f32_16x16x32_bf16(Bt[n][k], At[m][k], acc[ai][bj][m][n], 0, 0, 0); } } __builtin_amdgcn_s_setprio(0); } while (0)
#define PG8_WAIT_V(n) asm volatile("s_waitcnt vmcnt(" #n ")" ::: "memory")
#define PG8_WAIT_L(n) asm volatile("s_waitcnt lgkmcnt(" #n ")" ::: "memory")
#define PG8_BAR __builtin_amdgcn_s_barrier()
#if PG8_LOADPRIO
#define PG8_LP_ON __builtin_amdgcn_s_setprio(PG8_LOADPRIO)
#define PG8_LP_OFF __builtin_amdgcn_s_setprio(0)
#else
#define PG8_LP_ON do {} while (0)
#define PG8_LP_OFF do {} while (0)
#endif
#define PG8_SCHED __builtin_amdgcn_sched_barrier(0)
    Unit cur, nxt; int ui = 0;
    if (!S.next(0, cur)) return;
    f32x4 acc[2][2][4][2];
#pragma unroll
    for (int a = 0; a < 2; ++a)
#pragma unroll
        for (int b = 0; b < 2; ++b)
#pragma unroll
            for (int m = 0; m < 4; ++m)
#pragma unroll
                for (int n = 0; n < 2; ++n) acc[a][b][m][n] = (f32x4){0.f, 0.f, 0.f, 0.f};
    bf16x8 At[4][2], B0[2][2], B1[2][2];
    if constexpr (DIAG == 2 || DIAG == 3) { _Pragma("unroll") for (int i = 0; i < 4; ++i) _Pragma("unroll") for (int k = 0; k < 2; ++k) At[i][k] = (bf16x8){0,0,0,0,0,0,0,0}; _Pragma("unroll") for (int i = 0; i < 2; ++i) _Pragma("unroll") for (int k = 0; k < 2; ++k) { B0[i][k] = (bf16x8){0,0,0,0,0,0,0,0}; B1[i][k] = (bf16x8){0,0,0,0,0,0,0,0}; } }
    const char* cA = (const char*)g.A + (size_t)cur.pm * tstep; const char* cB = (const char*)g.Bt + (size_t)cur.pn * tstep;
    int kb = 0, ke = nt; if constexpr (Sched::SK) { kb = cur.kb; ke = cur.ke; }
    const char* pA = cA + (size_t)kb * kstep; const char* pB = cB + (size_t)kb * kstep;
    S.a_ready(cur);
    if constexpr (SP2) {
        PG8_STAGE(PG8_SB(0, 0), pB, voffB); PG8_STAGE(PG8_SB(0, 1), pB + hstep, voffB); PG8_STAGE(PG8_SA(0, 0), pA, voffA); PG8_STAGE(PG8_SA(0, 1), pA + hstep, voffA);
        if (wr == 1) PG8_BAR;
        PG8_WAIT_V(2); PG8_BAR;
        PG8_STAGE(PG8_SB(1, 0), pB + kstep, voffB); PG8_STAGE(PG8_SA(1, 0), pA + kstep, voffA); PG8_STAGE(PG8_SB(1, 1), pB + hstep + kstep, voffB);
        PG8_WAIT_V(6); PG8_BAR;
    } else {
        PG8_STAGE(PG8_SB(0, 0), pB, voffB); PG8_STAGE(PG8_SA(0, 0), pA, voffA); PG8_STAGE(PG8_SB(0, 1), pB + hstep, voffB); PG8_STAGE(PG8_SA(0, 1), pA + hstep, voffA);
        if (wr == 1) PG8_BAR;
        PG8_WAIT_V(4); PG8_BAR;
        PG8_STAGE(PG8_SB(1, 0), pB + kstep, voffB); PG8_STAGE(PG8_SA(1, 0), pA + kstep, voffA); PG8_STAGE(PG8_SB(1, 1), pB + hstep + kstep, voffB);
        PG8_WAIT_V(6); PG8_BAR;
    }
    for (;;) {
        const bool has_next = S.next(ui + 1, nxt);
        const char* nA0 = has_next ? (const char*)g.A + (size_t)nxt.pm * tstep : cA; const char* nB0 = has_next ? (const char*)g.Bt + (size_t)nxt.pn * tstep : cB;
        int nkb = 0; if constexpr (Sched::SK) { if (has_next) nkb = nxt.kb; }
        const char* nA = nA0 + (size_t)nkb * kstep; const char* nB = nB0 + (size_t)nkb * kstep;
        for (int t = kb; t < ke; t += 2) {
            const bool last = (t == ke - 2);
            const char* a1 = cA + (size_t)(t + 1) * kstep;
            const char* a2 = last ? nA : cA + (size_t)(t + 2) * kstep; const char* b2 = last ? nB : cB + (size_t)(t + 2) * kstep;
            const char* a3 = a2 + kstep; const char* b3 = b2 + kstep;
            if (last && has_next) S.a_ready(nxt);
            if constexpr (SP2) {
            PG8_LP_ON; PG8_LDB(B0, 0, 0); PG8_LDB(B1, 0, 1); PG8_SCHED; PG8_LDA(At, 0, 0); PG8_STAGE(PG8_SA(1, 1), a1 + hstep, voffA);
            PG8_LP_OFF; PG8_WAIT_V(8); PG8_WAIT_L(0); PG8_BAR; PG8_MMA(0, 0, At, B0); PG8_MMA(0, 1, At, B1); PG8_BAR; PG8_SCHED;
            PG8_LP_ON; PG8_LDA(At, 0, 1); PG8_STAGE(PG8_SB(0, 0), b2, voffB); PG8_STAGE(PG8_SB(0, 1), b2 + hstep, voffB); PG8_STAGE(PG8_SA(0, 0), a2, voffA);
            PG8_LP_OFF; PG8_WAIT_V(8); PG8_WAIT_L(0); PG8_BAR; PG8_MMA(1, 0, At, B0); PG8_MMA(1, 1, At, B1); PG8_BAR; PG8_SCHED;
            PG8_LP_ON; PG8_LDB(B0, 1, 0); PG8_LDB(B1, 1, 1); PG8_SCHED; PG8_LDA(At, 1, 0); PG8_STAGE(PG8_SA(0, 1), a2 + hstep, voffA);
            PG8_LP_OFF; PG8_WAIT_V(8); PG8_WAIT_L(0); PG8_BAR; PG8_MMA(0, 0, At, B0); PG8_MMA(0, 1, At, B1); PG8_BAR; PG8_SCHED;
            PG8_LP_ON; PG8_LDA(At, 1, 1); PG8_STAGE(PG8_SB(1, 0), b3, voffB); PG8_STAGE(PG8_SB(1, 1), b3 + hstep, voffB); PG8_STAGE(PG8_SA(1, 0), a3, voffA);
            PG8_LP_OFF; PG8_WAIT_V(8); PG8_WAIT_L(0); PG8_BAR; PG8_MMA(1, 0, At, B0); PG8_MMA(1, 1, At, B1); PG8_BAR; PG8_SCHED;
            } else {
            PG8_LDB(B0, 0, 0); PG8_SCHED; PG8_LDA(At, 0, 0); PG8_STAGE(PG8_SA(1, 1), a1 + hstep, voffA);
            PG8_WAIT_L(8); PG8_BAR; PG8_WAIT_L(0); PG8_MMA(0, 0, At, B0); PG8_BAR; PG8_SCHED;
            PG8_LDB(B1, 0, 1); PG8_STAGE(PG8_SB(0, 0), b2, voffB);
            PG8_BAR; PG8_WAIT_L(0); PG8_MMA(0, 1, At, B1); PG8_BAR;
            PG8_LDA(At, 0, 1); PG8_STAGE(PG8_SA(0, 0), a2, voffA);
            PG8_BAR; PG8_WAIT_L(0); PG8_MMA(1, 0, At, B0); PG8_BAR; PG8_SCHED;
            PG8_STAGE(PG8_SB(0, 1), b2 + hstep, voffB);
            PG8_WAIT_V(6); PG8_BAR; PG8_MMA(1, 1, At, B1); PG8_BAR;
            PG8_LDB(B0, 1, 0); PG8_SCHED; PG8_LDA(At, 1, 0); PG8_STAGE(PG8_SA(0, 1), a2 + hstep, voffA);
            PG8_WAIT_L(8); PG8_BAR; PG8_WAIT_L(0); PG8_MMA(0, 0, At, B0); PG8_BAR; PG8_SCHED;
            PG8_LDB(B1, 1, 1); PG8_STAGE(PG8_SB(1, 0), b3, voffB);
            PG8_BAR; PG8_WAIT_L(0); PG8_MMA(0, 1, At, B1); PG8_BAR;
            PG8_LDA(At, 1, 1); PG8_STAGE(PG8_SA(1, 0), a3, voffA);
            PG8_BAR; PG8_WAIT_L(0); PG8_MMA(1, 0, At, B0); PG8_BAR; PG8_SCHED;
            PG8_STAGE(PG8_SB(1, 1), b3 + hstep, voffB);
            PG8_WAIT_V(6); PG8_BAR; PG8_MMA(1, 1, At, B1); PG8_BAR;
            }
        }
        if constexpr (FP8) { asm volatile("s_nop 7\n\ts_nop 7" ::: "memory"); PG8_SCHED; }
        if constexpr (ALIGN_EPI) { if (wr == 0) PG8_BAR; }
        if constexpr (Sched::SK) {
            if (cur.kind == 1) S.store_partial(acc, cur, tid);
            else if (cur.kind == 0) { E(acc, cur, wr, wc, fr, fq); S.done(cur); }
        } else
        if constexpr (!Epi::AFTER_DRAIN) { E(acc, cur, wr, wc, fr, fq); S.done(cur); }
        if (!has_next) break;
#pragma unroll
        for (int a = 0; a < 2; ++a)
#pragma unroll
            for (int b = 0; b < 2; ++b)
#pragma unroll
                for (int m = 0; m < 4; ++m)
#pragma unroll
                    for (int n = 0; n < 2; ++n) acc[a][b][m][n] = (f32x4){0.f, 0.f, 0.f, 0.f};
        cur = nxt; cA = nA0; cB = nB0; ++ui; if constexpr (Sched::SK) { kb = cur.kb; ke = cur.ke; }
        if constexpr (ALIGN_EPI) { if (wr == 1) PG8_BAR; }
    }
    PG8_WAIT_V(0);
    if constexpr (!ALIGN_EPI) { if (wr == 0) PG8_BAR; }
    PG8_BAR;
    if constexpr (Epi::AFTER_DRAIN) { E.fused(acc, cur, wr, wc, fr, fq, lds, wid, lane); S.done(cur); }
    if constexpr (Sched::SK) { if (cur.kind == 2) { S.add_partial(acc, cur, tid, wid); E(acc, cur, wr, wc, fr, fq); S.done(cur); } }
#undef PG8_SA
#undef PG8_SB
#undef PG8_STAGE
#undef PG8_LDA
#undef PG8_LDB
#undef PG8_MMA
#undef PG8_WAIT_V
#undef PG8_WAIT_L
#undef PG8_BAR
#undef PG8_LP_ON
#undef PG8_LP_OFF
#undef PG8_SCHED
}
}

#ifndef PG8_SP2
#define PG8_SP2 true
#endif
#ifndef PG8_ALIGN
#define PG8_ALIGN true
#endif
#ifndef PROBE_GEMM
#define PROBE_GEMM 0
#endif
#ifndef UP_CUT
#define UP_CUT 0
#endif
#ifndef MK_PER_PHASE
#define MK_PER_PHASE 0
#endif

constexpr int NWAVES = 8;
constexpr int D = 4096, SEQ = 8192, DBATCH = 128, DSEQ = 8, MS = DBATCH * DSEQ, M = SEQ + MS;
constexpr int FF = 11008, NPROJ = 9216, NMOD = 9, MODW = NMOD * D, MODROWS = 256;
constexpr int C_K = 2048, C_V = 2560, C_GB = 3072, C_GC = 5120, C_HC = 7168;
constexpr int WIN = 128, NHEAD = 16;
constexpr float EPS = 1e-6f;
constexpr float S_H = 8.f, S_W13 = 512.f, S_T = 8.f, S_W2 = 512.f;
constexpr size_t O_YP = 0, O_YS = 33554432, O_KWP = 37748736, O_VWP = 37814272, O_CP = 37879808, O_KWS = 37883904, O_VWS = 46272512, O_CS = 54661120, O_END = 55185408;
enum { I_XP = 0, I_XS, I_CP, I_CS, I_CK, I_CV, I_SC, I_RB, I_G1, I_W1A, I_W3A, I_W2A, I_GM, I_WIN, I_SINK, I_CW, I_WOUT, I_G2, I_W1B, I_W3B, I_W2B, I_WADA, I_BADA, I_GF, N_IN };

constexpr size_t MiB = 1u << 20;
constexpr size_t al(size_t x) { return (x + MiB - 1) / MiB * MiB; }
constexpr size_t WS_CTL = 0, CTL_ZERO_BYTES = 1 * MiB;
constexpr size_t WS_W13A = 1 * MiB;
constexpr size_t WS_W2A  = WS_W13A + al((size_t)2 * FF * D * 2);
constexpr size_t WS_WIN  = WS_W2A + al((size_t)D * FF * 2);
constexpr size_t WS_WOUT = WS_WIN + al((size_t)NPROJ * D * 2);
constexpr size_t WS_W13B = WS_WOUT + al((size_t)D * D * 2);
constexpr size_t WS_W2B  = WS_W13B + al((size_t)2 * FF * D * 2);
constexpr size_t WS_WADA = WS_W2B + al((size_t)D * FF * 2);
constexpr size_t WS_CSI  = WS_WADA + al((size_t)MODW * D * 2);
constexpr size_t WS_MOD  = WS_CSI + al((size_t)MODROWS * D * 2);
constexpr size_t WS_X1   = WS_MOD + al((size_t)MODROWS * MODW * 4);
constexpr size_t WS_H    = WS_X1 + al((size_t)M * D * 4);
constexpr size_t WS_T    = WS_H + al((size_t)M * D * 2);
constexpr size_t WS_PROJ = WS_T + al((size_t)M * FF * 2);
constexpr size_t WS_MIX  = WS_PROJ + al((size_t)M * NPROJ * 2);
constexpr size_t WS_PART = WS_MIX + al((size_t)M * D * 2);
constexpr size_t WS_SKS  = WS_PART + al((size_t)4 * (DBATCH + 1) * 12288 * 4);
constexpr size_t WS_SKS2 = WS_SKS + (size_t)256 * 262144;
constexpr size_t WS_END  = WS_SKS2 + (size_t)256 * 262144;
constexpr int CW_TMO = 0, CW_CODE = 1, CW_BAR = 4096;
constexpr int CW_SK = 16384, CW_SK_STRIDE = 16384;
constexpr int CW_MODC = CW_SK + 4 * CW_SK_STRIDE;
static_assert((size_t)(CW_SK + 8 * CW_SK_STRIDE) * 4 <= CTL_ZERO_BYTES && CW_MODC + 64 * 144 <= CW_SK + 8 * CW_SK_STRIDE, "stream-K / adaLN counters inside the zeroed control region");

constexpr int RING_OFF = 0, RING_BYTES = 131072;
constexpr int SKLIST_OFF = 131072;
constexpr int LDSCTL_OFF = 143360, MISC_OFF = LDSCTL_OFF + 320;
constexpr int LDS_BYTES = 147456;
static_assert(MISC_OFF + 128 <= LDS_BYTES, "LDS map");

#define GAS __attribute__((address_space(1)))
#define LAS __attribute__((address_space(3)))
typedef unsigned short bf16;
typedef unsigned v4u __attribute__((ext_vector_type(4)));
typedef unsigned v2u __attribute__((ext_vector_type(2)));
typedef float f32x4 __attribute__((ext_vector_type(4)));
typedef float f32x16 __attribute__((ext_vector_type(16)));
typedef short bf16x8 __attribute__((ext_vector_type(8)));
typedef GAS unsigned gu32;
#define RLX_AGENT __ATOMIC_RELAXED, __HIP_MEMORY_SCOPE_AGENT
#define LDS_WAIT() asm volatile("s_waitcnt lgkmcnt(0)" ::: "memory")
#define VM_WAIT() asm volatile("s_waitcnt vmcnt(0)" ::: "memory")
__device__ __forceinline__ unsigned f2bf(float f) { unsigned u = __builtin_bit_cast(unsigned, f); return (u + 0x7fffu + ((u >> 16) & 1u)) >> 16; }
__device__ __forceinline__ unsigned pk2(float lo, float hi) { return f2bf(lo) | (f2bf(hi) << 16); }
__device__ __forceinline__ float bf_lo(unsigned w) { return __builtin_bit_cast(float, w << 16); }
__device__ __forceinline__ float bf_hi(unsigned w) { return __builtin_bit_cast(float, w & 0xffff0000u); }

#define XB_TMO      128
#define XB_XCNT(j)  (256  + 64 * (j))
#define XB_XSUB(j)  (1280 + 64 * (j))
#define XB_XGEN(j)  (2304 + 64 * (j))
#define XB_TOP      3328
#define XB_TOPGEN   3392
#define XCD_BAR_WORDS 3456
#define XB_SPIN_CAP (1u << 18)

__device__ __forceinline__ unsigned xb_ld(unsigned* p)              { return __hip_atomic_load(p, __ATOMIC_RELAXED, __HIP_MEMORY_SCOPE_AGENT); }
__device__ __forceinline__ unsigned xb_add(unsigned* p, unsigned v) { return __hip_atomic_fetch_add(p, v, __ATOMIC_RELAXED, __HIP_MEMORY_SCOPE_AGENT); }
__device__ __forceinline__ unsigned xb_xcc_id() { return (unsigned)__builtin_amdgcn_s_getreg((3 << 11) | 20) & 0xFu; }
#define XB_SPIN(cond, bar) do { unsigned _sp = 0; while (cond) { __builtin_amdgcn_s_sleep(1); \
    if ((++_sp & 255u) == 0u) { if (xb_ld(&(bar)[XB_TMO])) break; if (_sp > XB_SPIN_CAP) { atomicAdd(&(bar)[XB_TMO], 1u); break; } } } } while (0)

struct XcdBarrier {
    unsigned* bar; unsigned x;
    volatile LAS unsigned* st;
};

__device__ __forceinline__ XcdBarrier xcd_barrier_post(unsigned* bar, volatile LAS unsigned* st) {
    XcdBarrier b; b.bar = bar; b.x = xb_xcc_id(); b.st = st;
    if (threadIdx.x == 0) (void)xb_add(&bar[XB_XCNT(b.x)], 1u);
    return b;
}
__device__ __forceinline__ void xcd_barrier_complete(unsigned* bar, unsigned x, unsigned& nloc, unsigned& nx) {
    const unsigned G = gridDim.x * gridDim.y * gridDim.z;
    unsigned sum, cnt, mine, sp = 0u;
    for (;;) {
        sum = 0u; cnt = 0u; mine = 0u;
#pragma unroll
        for (unsigned j = 0; j < 16; ++j) { const unsigned c = xb_ld(&bar[XB_XCNT(j)]); sum += c; cnt += (c > 0u) ? 1u : 0u; mine = (j == x) ? c : mine; }
        if (sum == G) break;
        __builtin_amdgcn_s_sleep(1);
        if ((++sp & 255u) == 0u) { if (xb_ld(&bar[XB_TMO])) break; if (sp > XB_SPIN_CAP) { atomicAdd(&bar[XB_TMO], 1u); break; } }
    }
    nloc = mine > 0u ? mine : 1u; nx = cnt > 0u ? cnt : 1u;
}

__device__ __forceinline__ void xcd_barrier(const XcdBarrier& b) {
    asm volatile("s_waitcnt vmcnt(0)" ::: "memory");
    __syncthreads();
    if (threadIdx.x == 0) {
        unsigned* bar = b.bar;
        __builtin_amdgcn_s_waitcnt(0);
        unsigned nloc = b.st[0], nx = b.st[1];
        if (nloc == 0u) { xcd_barrier_complete(bar, b.x, nloc, nx); b.st[0] = nloc; b.st[1] = nx; }
        const unsigned old = xb_add(&bar[XB_XSUB(b.x)], 1u);
        const unsigned gen = old / nloc;
        if (old + 1u == (gen + 1u) * nloc) {
            __builtin_amdgcn_fence(__ATOMIC_RELEASE, "agent");
            asm volatile("s_waitcnt vmcnt(0)" ::: "memory");
            const unsigned og = xb_add(&bar[XB_TOP], 1u);
            const unsigned tg = og / nx;
            if (og + 1u == (tg + 1u) * nx) xb_add(&bar[XB_TOPGEN], 1u);
            else XB_SPIN(xb_ld(&bar[XB_TOPGEN]) == tg, bar);
            __builtin_amdgcn_fence(__ATOMIC_ACQUIRE, "agent");
            xb_add(&bar[XB_XGEN(b.x)], 1u);
            asm volatile("s_waitcnt vmcnt(0)" ::: "memory");
        } else {
            XB_SPIN(xb_ld(&bar[XB_XGEN(b.x)]) == gen, bar);
            __builtin_amdgcn_fence(__ATOMIC_ACQUIRE, "agent");
            asm volatile("s_waitcnt vmcnt(0)" ::: "memory");
        }
    }
    __syncthreads();
}


struct Frame {
    LAS unsigned char* lds;
    volatile LAS unsigned* MISC;
    gu32* ctl;
    int tid, lane, wave;
    int vcu, G;
};
__device__ __forceinline__ float wave_sum(float v) {
#pragma unroll
    for (int o = 1; o < 64; o <<= 1) v += __shfl_xor(v, o);
    return v;
}
template <int MODE>
__device__ __forceinline__ void p0_transpose_item(const float* W, int K, int N, bf16* WT, LAS float* scr, int item, int lane) {
    const int nblk = N / 32, kb = item / nblk, nb = item % nblk, k0 = 64 * kb, n0 = 32 * nb;
    const GAS float* Wg = (const GAS float*)W;
    float ld[32];
#pragma unroll
    for (int i = 0; i < 32; ++i) { const int kk = 2 * i + (lane >> 5); ld[i] = __builtin_nontemporal_load(&Wg[(size_t)(k0 + kk) * N + n0 + (lane & 31)]); }
#pragma unroll
    for (int i = 0; i < 32; ++i) { const int kk = 2 * i + (lane >> 5); scr[kk * 33 + (lane & 31)] = ld[i]; }
    LDS_WAIT(); asm volatile("" ::: "memory");
    const int c = lane & 7;
    const int r0 = (MODE == 0) ? n0 : (n0 / 128) * 256 + (n0 % 128) + (MODE == 2 ? 128 : 0);
#pragma unroll
    for (int j = 0; j < 4; ++j) { const int n = (lane >> 3) + 8 * j; const LAS float* s = scr + (8 * c) * 33 + n;
        v4u o; o.x = pg8::cvt_pk_bf16(s[0 * 33], s[1 * 33]); o.y = pg8::cvt_pk_bf16(s[2 * 33], s[3 * 33]); o.z = pg8::cvt_pk_bf16(s[4 * 33], s[5 * 33]); o.w = pg8::cvt_pk_bf16(s[6 * 33], s[7 * 33]);
        *(GAS v4u*)(WT + (size_t)(r0 + n) * K + k0 + 8 * c) = o; }
    LDS_WAIT(); asm volatile("" ::: "memory");
}

template <int MODE>
__device__ __forceinline__ void p0_transpose_item8(const float* W, int K, int N, unsigned char* WT, float scale, LAS float* scr, int item, int lane) {
    const int nblk = N / 32, kb = item / nblk, nb = item % nblk, k0 = 128 * kb, n0 = 32 * nb;
    const GAS float* Wg = (const GAS float*)W;
#pragma unroll
    for (int h2 = 0; h2 < 2; ++h2) { float ld[32];
#pragma unroll
        for (int i = 0; i < 32; ++i) { const int kk = 2 * (i + 32 * h2) + (lane >> 5); ld[i] = __builtin_nontemporal_load(&Wg[(size_t)(k0 + kk) * N + n0 + (lane & 31)]); }
#pragma unroll
        for (int i = 0; i < 32; ++i) { const int kk = 2 * (i + 32 * h2) + (lane >> 5); scr[kk * 33 + (lane & 31)] = ld[i]; } }
    LDS_WAIT(); asm volatile("" ::: "memory");
    const int n = lane & 31, hf = lane >> 5;
    const int r0 = (MODE == 0) ? n0 : (n0 / 128) * 256 + (n0 % 128) + (MODE == 2 ? 128 : 0);
#pragma unroll
    for (int p = 0; p < 4; ++p) { const int q = 2 * p + hf; const LAS float* s = scr + (16 * q) * 33 + n;
        v4u o;
        o.x = pg8::cvt4_fp8(s[0 * 33] * scale, s[1 * 33] * scale, s[2 * 33] * scale, s[3 * 33] * scale);
        o.y = pg8::cvt4_fp8(s[4 * 33] * scale, s[5 * 33] * scale, s[6 * 33] * scale, s[7 * 33] * scale);
        o.z = pg8::cvt4_fp8(s[8 * 33] * scale, s[9 * 33] * scale, s[10 * 33] * scale, s[11 * 33] * scale);
        o.w = pg8::cvt4_fp8(s[12 * 33] * scale, s[13 * 33] * scale, s[14 * 33] * scale, s[15 * 33] * scale);
        *(GAS v4u*)(WT + (size_t)(r0 + n) * K + k0 + 16 * q) = o; }
    LDS_WAIT(); asm volatile("" ::: "memory");
}

struct Args { const float* in[N_IN]; float* out; unsigned char* ws; int ph_lo, ph_hi; };

enum { JOB_W1A = 0, JOB_W3A, JOB_W2A, JOB_WIN, JOB_WOUT, JOB_W1B, JOB_W3B, JOB_W2B };
template <int JOB>
__device__ __forceinline__ void conv_job(Frame& F, const Args& A, int rank, int nw) {
    LAS float* scr = (LAS float*)(F.lds + RING_OFF + F.wave * 16896);
    unsigned char* ws = A.ws;
    constexpr int I_13 = (D / 128) * (FF / 32), I_2 = (FF / 128) * (D / 32), I_IN = (D / 64) * (NPROJ / 32), I_OUT = (D / 64) * (D / 32);
    constexpr int N = (JOB == JOB_W1A || JOB == JOB_W3A || JOB == JOB_W1B || JOB == JOB_W3B) ? I_13 : (JOB == JOB_W2A || JOB == JOB_W2B) ? I_2 : (JOB == JOB_WIN) ? I_IN : I_OUT;
    for (int it = rank; it < N; it += nw) {
        if constexpr (JOB == JOB_W1A) p0_transpose_item8<1>(A.in[I_W1A], D, FF, ws + WS_W13A, S_W13, scr, it, F.lane);
        if constexpr (JOB == JOB_W3A) p0_transpose_item8<2>(A.in[I_W3A], D, FF, ws + WS_W13A, S_W13, scr, it, F.lane);
        if constexpr (JOB == JOB_W2A) p0_transpose_item8<0>(A.in[I_W2A], FF, D, ws + WS_W2A, S_W2, scr, it, F.lane);
        if constexpr (JOB == JOB_WIN) p0_transpose_item<0>(A.in[I_WIN], D, NPROJ, (bf16*)(ws + WS_WIN), scr, it, F.lane);
        if constexpr (JOB == JOB_WOUT) p0_transpose_item<0>(A.in[I_WOUT], D, D, (bf16*)(ws + WS_WOUT), scr, it, F.lane);
        if constexpr (JOB == JOB_W1B) p0_transpose_item8<1>(A.in[I_W1B], D, FF, ws + WS_W13B, S_W13, scr, it, F.lane);
        if constexpr (JOB == JOB_W3B) p0_transpose_item8<2>(A.in[I_W3B], D, FF, ws + WS_W13B, S_W13, scr, it, F.lane);
        if constexpr (JOB == JOB_W2B) p0_transpose_item8<0>(A.in[I_W2B], FF, D, ws + WS_W2B, S_W2, scr, it, F.lane);
    }
}
__device__ __forceinline__ void csilu_phase(Frame& F, const Args& A) {
    const int gt = (F.vcu * NWAVES + F.wave) * 64 + F.lane, NGT = F.G * NWAVES * 64;
    bf16* cs = (bf16*)(A.ws + WS_CSI);
    for (int it = gt; it < 144 * D / 8; it += NGT) {
        const int row = it / (D / 8), c8 = (it % (D / 8)) * 8;
        v4u o = (v4u){0u, 0u, 0u, 0u};
        if (row <= DBATCH) {
            const float* src = (row == 0) ? A.in[I_CP] + c8 : A.in[I_CS] + (size_t)(row - 1) * D + c8;
            const f32x4 a = *(const GAS f32x4*)src, b = *(const GAS f32x4*)(src + 4);
            float v[8] = {a[0], a[1], a[2], a[3], b[0], b[1], b[2], b[3]};
#pragma unroll
            for (int j = 0; j < 8; ++j) v[j] = v[j] / (1.0f + __expf(-v[j]));
            o.x = pk2(v[0], v[1]); o.y = pk2(v[2], v[3]); o.z = pk2(v[4], v[5]); o.w = pk2(v[6], v[7]);
        }
        *(GAS v4u*)(cs + ((size_t)((c8 >> 5) * 9 + (row >> 4)) * 64 + ((c8 & 31) >> 3) * 16 + (row & 15)) * 8) = o;
    }
}
constexpr int MODI_SB = 2560, MODI_A_OFF = 8 * MODI_SB, MODI_A_BYTES = 9216;
__device__ __forceinline__ void mod_item256(Frame& F, const Args& A, int cg, int k0, int nsteps, float* dst, int ldd, int dcol0, const float* bias) {
    const int lane = F.lane, w = F.wave, n0 = 256 * cg + 32 * w, tid = F.tid;
    LAS unsigned char* sb = F.lds + w * MODI_SB;
    LAS unsigned char* la = F.lds + MODI_A_OFF;
    const bf16* CS = (const bf16*)(A.ws + WS_CSI);
    const int kp = lane >> 3, a8 = lane & 7, n4 = 4 * a8;
    const GAS char* Wb = (const GAS char*)(A.in[I_WADA] + (size_t)k0 * MODW + n0);
    const unsigned wlo = (unsigned)((2 * kp) * MODW + n4) * 4u;
    const GAS char* Cb = (const GAS char*)CS + (size_t)(k0 / 32) * 9216;
    const unsigned c1 = (unsigned)tid * 16u, c2 = (unsigned)(512 + (tid & 63)) * 16u;
    f32x4 acc[9][2];
#pragma unroll
    for (int mt = 0; mt < 9; ++mt)
#pragma unroll
        for (int j = 0; j < 2; ++j) acc[mt][j] = (f32x4){0.f, 0.f, 0.f, 0.f};
    f32x4 buf[2][4];
    v4u ar[2][2];
#define MODI_LOAD(b, s) do { _Pragma("unroll") for (int i = 0; i < 4; ++i) buf[b][i] = __builtin_nontemporal_load((const GAS f32x4*)(Wb + (size_t)(32 * (s) + 16 * (i >> 1) + (i & 1)) * (MODW * 4) + wlo)); } while (0)
#define MODI_ALOAD(r, s) do { const int s_ = (s) < nsteps ? (s) : nsteps - 1; ar[r][0] = *(const GAS v4u*)(Cb + (size_t)s_ * 9216 + c1); ar[r][1] = *(const GAS v4u*)(Cb + (size_t)s_ * 9216 + c2); } while (0)
#define MODI_AWRITE(r, s) do { *(LAS v4u*)(la + ((s) & 1) * MODI_A_BYTES + c1) = ar[r][0]; *(LAS v4u*)(la + ((s) & 1) * MODI_A_BYTES + c2) = ar[r][1]; } while (0)
    __syncthreads();
    MODI_ALOAD(0, 0); MODI_ALOAD(1, 1);
    MODI_LOAD(0, 0); MODI_LOAD(1, 1);
    MODI_AWRITE(0, 0);
    MODI_ALOAD(0, 2);
    __syncthreads();
#pragma unroll 1
    for (int s4 = 0; s4 < nsteps; s4 += 2) {
#pragma unroll
        for (int b = 0; b < 2; ++b) { const int s = s4 + b;
#pragma unroll
            for (int ip = 0; ip < 2; ++ip)
#pragma unroll
                for (int e = 0; e < 4; ++e) { const int n = n4 + e, k = 2 * kp + 16 * ip;
                    *(LAS unsigned*)(sb + n * 80 + (((k >> 3) ^ (a8 & 3)) * 16) + (k & 7) * 2) = pg8::cvt_pk_bf16(buf[b][2 * ip][e], buf[b][2 * ip + 1][e]); }
            asm volatile("" ::: "memory");
            { const int sn = (s + 2 < nsteps) ? s + 2 : nsteps - 1; MODI_LOAD(b, sn); }
            asm volatile("" ::: "memory");
            bf16x8 bfr[2];
#pragma unroll
            for (int j = 0; j < 2; ++j) { const int n = 16 * j + (lane & 15); bfr[j] = *(const LAS bf16x8*)(sb + n * 80 + (((lane >> 4) ^ ((n >> 2) & 3)) * 16)); }
#pragma unroll
            for (int mg = 0; mg < 3; ++mg) { bf16x8 af[3];
#pragma unroll
                for (int i = 0; i < 3; ++i) af[i] = *(const LAS bf16x8*)(la + (s & 1) * MODI_A_BYTES + (3 * mg + i) * 1024 + lane * 16);
#pragma unroll
                for (int i = 0; i < 3; ++i)
#pragma unroll
                    for (int j = 0; j < 2; ++j) acc[3 * mg + i][j] = __builtin_amdgcn_mfma_f32_16x16x32_bf16(af[i], bfr[j], acc[3 * mg + i][j], 0, 0, 0);
                asm volatile("" ::: "memory"); }
            MODI_AWRITE((b + 1) & 1, s + 1);
            asm volatile("" ::: "memory");
            MODI_ALOAD((b + 1) & 1, s + 3);
            __syncthreads();
        }
    }
#undef MODI_LOAD
#undef MODI_ALOAD
#undef MODI_AWRITE
    const int c0 = 32 * w + (lane & 15);
#pragma unroll
    for (int j = 0; j < 2; ++j) { const float bv = bias ? bias[256 * cg + c0 + 16 * j] : 0.f;
#pragma unroll
        for (int mt = 0; mt < 9; ++mt)
#pragma unroll
            for (int r = 0; r < 4; ++r) { const int row = 16 * mt + 4 * (lane >> 4) + r;
                if (row <= DBATCH) dst[(size_t)row * ldd + dcol0 + c0 + 16 * j] = acc[mt][j][r] + bv; } }
    LDS_WAIT();
}
__device__ __forceinline__ void mod_group_finish(Frame& F, const Args& A, int chunk, int cg) {
    asm volatile("s_waitcnt vmcnt(0)" ::: "memory");
    __syncthreads();
    if (threadIdx.x == 0) {
        __builtin_amdgcn_fence(__ATOMIC_RELEASE, "agent");
        asm volatile("s_waitcnt vmcnt(0)" ::: "memory");
        const unsigned old = __hip_atomic_fetch_add((unsigned*)(F.ctl + CW_MODC + 64 * (48 * chunk + cg)), 1u, __ATOMIC_RELAXED, __HIP_MEMORY_SCOPE_AGENT);
        if (old == 3u) { __builtin_amdgcn_fence(__ATOMIC_ACQUIRE, "agent"); asm volatile("s_waitcnt vmcnt(0)" ::: "memory"); }
        F.MISC[0] = (old == 3u) ? 1u : 0u;
    }
    __syncthreads();
    if (F.MISC[0] != 0u) {
        const float* PART = (const float*)(A.ws + WS_PART); float* MOD = (float*)(A.ws + WS_MOD);
        constexpr size_t PS = (size_t)(DBATCH + 1) * 12288;
#pragma unroll 1
        for (int i = threadIdx.x; i < (DBATCH + 1) * 64; i += NWAVES * 64) { const int r = i >> 6, c = 256 * cg + 4 * (i & 63);
            const float* p = PART + (size_t)r * 12288 + c;
            const f32x4 s = (*(const GAS f32x4*)p + *(const GAS f32x4*)(p + PS)) + (*(const GAS f32x4*)(p + 2 * PS) + *(const GAS f32x4*)(p + 3 * PS));
            *(GAS f32x4*)(MOD + (size_t)r * MODW + 12288 * chunk + c) = s + *(const GAS f32x4*)(A.in[I_BADA] + 12288 * chunk + c); }
    }
    __syncthreads();
}
__device__ __forceinline__ void mod_chunk_partials(Frame& F, const Args& A, int chunk, int rank, int nwg) {
#pragma unroll 1
    for (int it = rank; it < 192; it += nwg) {
        mod_item256(F, A, 48 * chunk + (it >> 2), 1024 * (it & 3), 32, (float*)(A.ws + WS_PART) + (size_t)(it & 3) * ((size_t)(DBATCH + 1) * 12288), 12288, 256 * (it >> 2), nullptr);
        mod_group_finish(F, A, chunk, it >> 2);
    }
}

template <bool FP8OUT>
__device__ __forceinline__ void normmod_store(bf16* H, int m, int lane, int j, f32x4 h) {
    if constexpr (FP8OUT) { ((GAS unsigned*)((unsigned char*)H + (size_t)m * D) + lane)[64 * j] = pg8::cvt4_fp8(h.x * S_H, h.y * S_H, h.z * S_H, h.w * S_H); }
    else { v2u w; w.x = pg8::cvt_pk_bf16(h.x, h.y); w.y = pg8::cvt_pk_bf16(h.z, h.w); ((GAS v2u*)(H + (size_t)m * D) + lane)[64 * j] = w; }
}
template <bool XBF16> __device__ __forceinline__ f32x4 ldx4(const void* rowp, int q) {
    if constexpr (XBF16) { const v2u w = ((const GAS v2u*)rowp)[q]; return (f32x4){bf_lo(w.x), bf_hi(w.x), bf_lo(w.y), bf_hi(w.y)}; }
    else return ((const GAS f32x4*)rowp)[q];
}
template <bool XBF16> __device__ __forceinline__ const void* xrowp(const void* base, size_t r) { if constexpr (XBF16) return (const bf16*)base + r * D; else return (const float*)base + r * D; }
template <bool FP8OUT, bool XBF16>
__device__ __forceinline__ void normmod_phase(Frame& F, const void* xp, const void* xs, const float* g, const float* mod, int ish, int isc, bf16* H) {
    const int gw = F.vcu * NWAVES + F.wave, NGW = F.G * NWAVES, lane = F.lane;
    LAS f32x4* lgs = (LAS f32x4*)F.lds; LAS f32x4* lsh = (LAS f32x4*)(F.lds + D * 4);
    for (int i = F.tid; i < D / 4; i += NWAVES * 64) { const f32x4 gg = *((const GAS f32x4*)g + i), sc = *((const GAS f32x4*)(mod + (size_t)isc * D) + i);
        lgs[i] = gg * (sc + 1.0f); lsh[i] = *((const GAS f32x4*)(mod + (size_t)ish * D) + i); }
    __syncthreads();
    if (gw < SEQ) {
        f32x4 cur[16], nx[16];
#pragma unroll
        for (int j = 0; j < 16; ++j) cur[j] = ldx4<XBF16>(xrowp<XBF16>(xp, (size_t)gw), lane + 64 * j);
#pragma unroll 1
        for (int m = gw; m < SEQ; m += NGW) {
            asm volatile("" ::: "memory");
            const int mn = (m + NGW < SEQ) ? m + NGW : m;
#pragma unroll
            for (int j = 0; j < 16; ++j) nx[j] = ldx4<XBF16>(xrowp<XBF16>(xp, (size_t)mn), lane + 64 * j);
            float s = 0.f;
#pragma unroll
            for (int j = 0; j < 16; ++j) s += (cur[j].x * cur[j].x + cur[j].y * cur[j].y) + (cur[j].z * cur[j].z + cur[j].w * cur[j].w);
            const float rstd = 1.0f / sqrtf(wave_sum(s) * (1.f / D) + EPS);
#pragma unroll
            for (int j = 0; j < 16; ++j) normmod_store<FP8OUT>(H, m, lane, j, (cur[j] * rstd) * lgs[lane + 64 * j] + lsh[lane + 64 * j]);
#pragma unroll
            for (int j = 0; j < 16; ++j) cur[j] = nx[j];
        }
    }
    for (int m = SEQ + gw; m < M; m += NGW) {
        const float* mrow = mod + (size_t)(1 + ((m - SEQ) >> 3)) * MODW;
        const void* xr = xrowp<XBF16>(xs, (size_t)(m - SEQ));
        f32x4 v[16]; float s = 0.f;
#pragma unroll
        for (int j = 0; j < 16; ++j) { v[j] = ldx4<XBF16>(xr, lane + 64 * j); s += (v[j].x * v[j].x + v[j].y * v[j].y) + (v[j].z * v[j].z + v[j].w * v[j].w); }
        const float rstd = 1.0f / sqrtf(wave_sum(s) * (1.f / D) + EPS);
        const GAS f32x4* gr = (const GAS f32x4*)g + lane;
        const GAS f32x4* shr = (const GAS f32x4*)(mrow + (size_t)ish * D) + lane;
        const GAS f32x4* scr = (const GAS f32x4*)(mrow + (size_t)isc * D) + lane;
#pragma unroll
        for (int j = 0; j < 16; ++j) { const f32x4 gg = gr[64 * j], sh = shr[64 * j], sc = scr[64 * j];
            normmod_store<FP8OUT>(H, m, lane, j, (v[j] * rstd) * gg * (sc + 1.0f) + sh); }
    }
    __syncthreads();
}
__device__ __forceinline__ void final_norm_phase(Frame& F, const bf16* X1, const float* g, float* out) {
    const int gw = F.vcu * NWAVES + F.wave, NGW = F.G * NWAVES, lane = F.lane;
    LAS f32x4* lg = (LAS f32x4*)F.lds;
    for (int i = F.tid; i < D / 4; i += NWAVES * 64) lg[i] = *((const GAS f32x4*)g + i);
    __syncthreads();
    if (gw >= M) return;
    f32x4 cur[16], nx[16];
#pragma unroll
    for (int j = 0; j < 16; ++j) cur[j] = ldx4<true>(X1 + (size_t)gw * D, lane + 64 * j);
#pragma unroll 1
    for (int m = gw; m < M; m += NGW) {
        asm volatile("" ::: "memory");
        const int mn = (m + NGW < M) ? m + NGW : m;
#pragma unroll
        for (int j = 0; j < 16; ++j) nx[j] = ldx4<true>(X1 + (size_t)mn * D, lane + 64 * j);
        float s = 0.f;
#pragma unroll
        for (int j = 0; j < 16; ++j) s += (cur[j].x * cur[j].x + cur[j].y * cur[j].y) + (cur[j].z * cur[j].z + cur[j].w * cur[j].w);
        const float rstd = 1.0f / sqrtf(wave_sum(s) * (1.f / D) + EPS);
        GAS f32x4* o = (GAS f32x4*)(out + ((m < SEQ) ? O_YP + (size_t)m * D : O_YS + (size_t)(m - SEQ) * D)) + lane;
#pragma unroll
        for (int j = 0; j < 16; ++j) o[64 * j] = (cur[j] * rstd) * lg[lane + 64 * j];
#pragma unroll
        for (int j = 0; j < 16; ++j) cur[j] = nx[j];
    }
}

namespace att {
constexpr int KROW = 272, VROW = 528;
constexpr int K_OFF = 0, V_OFF = 256 * KROW, LUT_OFF = V_OFF + 128 * VROW, LUT_STRIDE = 132;
constexpr int ATT_LDS = LUT_OFF + 4 * LUT_STRIDE * 4;
static_assert(ATT_LDS <= LDSCTL_OFF, "attention LDS image below the control words");
constexpr float SCALE = 0.08838834764831845f;
__device__ __forceinline__ int t5_bucket(int n) {
    if (n < 16) return n;
    int b = 16;
    b += (n >= 19); b += (n >= 21); b += (n >= 24); b += (n >= 27); b += (n >= 31); b += (n >= 35); b += (n >= 40); b += (n >= 46);
    b += (n >= 52); b += (n >= 59); b += (n >= 67); b += (n >= 77); b += (n >= 87); b += (n >= 99); b += (n >= 113);
    return b;
}
__device__ __forceinline__ int vslot(int kidx) { return (kidx & ~15) | (8 * ((kidx >> 2) & 1) + 4 * ((kidx >> 3) & 1) + (kidx & 3)); }
__device__ __forceinline__ void fill_lut(LAS unsigned char* lds, const float* rel_bias, int hk, int tid) {
    LAS float* lut = (LAS float*)(lds + LUT_OFF);
    for (int i = tid; i < 4 * 129; i += NWAVES * 64) { const int g = i / 129, dist = i % 129; lut[g * LUT_STRIDE + dist] = rel_bias[t5_bucket(dist) * NHEAD + 4 * hk + g]; }
}
template <int NT>
__device__ __forceinline__ void attn_qtile(const LAS unsigned char* lds, int ktile0, const bf16x8 (&Q)[8], int r, int kmin, int kmax, int g, float sink, bf16* orow, int lane) {
    const int c = lane & 31, h = lane >> 5;
    f32x16 X[NT];
#pragma unroll
    for (int t = 0; t < NT; ++t) {
#pragma unroll
        for (int i = 0; i < 16; ++i) X[t][i] = 0.f;
#pragma unroll
        for (int ks = 0; ks < 8; ++ks) { const bf16x8 kf = *(const LAS bf16x8*)(lds + K_OFF + (32 * (ktile0 + t) + c) * KROW + (16 * ks + 8 * h) * 2);
            X[t] = __builtin_amdgcn_mfma_f32_32x32x16_bf16(kf, Q[ks], X[t], 0, 0, 0); }
    }
    const LAS float* lut = (const LAS float*)(lds + LUT_OFF) + g * LUT_STRIDE;
    float mx = sink;
#pragma unroll
    for (int t = 0; t < NT; ++t)
#pragma unroll
        for (int i = 0; i < 16; ++i) { const int kidx = 32 * (ktile0 + t) + (i & 3) + 8 * (i >> 2) + 4 * h; const int dist = 128 + r - kidx;
            const bool valid = (dist >= 0) && (dist <= 128) && (kidx >= kmin) && (kidx < kmax);
            const int di = dist < 0 ? 0 : (dist > 128 ? 128 : dist);
            float s = X[t][i] * SCALE + lut[di]; s = valid ? s : -1e30f; X[t][i] = s; mx = fmaxf(mx, s); }
    mx = fmaxf(mx, __shfl_xor(mx, 32));
    float sum = 0.f;
#pragma unroll
    for (int t = 0; t < NT; ++t)
#pragma unroll
        for (int i = 0; i < 16; ++i) { const float p = __expf(X[t][i] - mx); X[t][i] = p; sum += p; }
    sum += __shfl_xor(sum, 32);
    const float inv = 1.0f / (sum + __expf(sink - mx));
    f32x16 O[4];
#pragma unroll
    for (int dt = 0; dt < 4; ++dt)
#pragma unroll
        for (int i = 0; i < 16; ++i) O[dt][i] = 0.f;
#pragma unroll
    for (int t = 0; t < NT; ++t)
#pragma unroll
        for (int s = 0; s < 2; ++s) {
            v4u pw; pw.x = pg8::cvt_pk_bf16(X[t][8 * s + 0], X[t][8 * s + 1]); pw.y = pg8::cvt_pk_bf16(X[t][8 * s + 2], X[t][8 * s + 3]);
            pw.z = pg8::cvt_pk_bf16(X[t][8 * s + 4], X[t][8 * s + 5]); pw.w = pg8::cvt_pk_bf16(X[t][8 * s + 6], X[t][8 * s + 7]);
            const bf16x8 pf = __builtin_bit_cast(bf16x8, pw);
#pragma unroll
            for (int dt = 0; dt < 4; ++dt) { const bf16x8 vf = *(const LAS bf16x8*)(lds + V_OFF + (32 * dt + c) * VROW + (32 * (ktile0 + t) + 16 * s + 8 * h) * 2);
                O[dt] = __builtin_amdgcn_mfma_f32_32x32x16_bf16(vf, pf, O[dt], 0, 0, 0); }
        }
#pragma unroll
    for (int dt = 0; dt < 4; ++dt)
#pragma unroll
        for (int i = 0; i < 4; ++i) { v2u w; w.x = pk2(O[dt][4 * i + 0] * inv, O[dt][4 * i + 1] * inv); w.y = pk2(O[dt][4 * i + 2] * inv, O[dt][4 * i + 3] * inv);
            *(GAS v2u*)(orow + 32 * dt + 8 * i + 4 * h) = w; }
}
__device__ __forceinline__ void stage_kv(LAS unsigned char* lds, int kidx, int ch, v4u kq, v4u vq) {
    *(LAS v4u*)(lds + K_OFF + kidx * KROW + ch * 16) = kq;
    LAS unsigned short* vt = (LAS unsigned short*)(lds + V_OFF + (8 * ch) * VROW) + vslot(kidx);
    vt[0 * (VROW / 2)] = (unsigned short)(vq.x & 0xffffu); vt[1 * (VROW / 2)] = (unsigned short)(vq.x >> 16);
    vt[2 * (VROW / 2)] = (unsigned short)(vq.y & 0xffffu); vt[3 * (VROW / 2)] = (unsigned short)(vq.y >> 16);
    vt[4 * (VROW / 2)] = (unsigned short)(vq.z & 0xffffu); vt[5 * (VROW / 2)] = (unsigned short)(vq.z >> 16);
    vt[6 * (VROW / 2)] = (unsigned short)(vq.w & 0xffffu); vt[7 * (VROW / 2)] = (unsigned short)(vq.w >> 16);
}
__device__ __forceinline__ void store8_f32(float* dst, v4u q) {
    *(GAS f32x4*)dst = (f32x4){bf_lo(q.x), bf_hi(q.x), bf_lo(q.y), bf_hi(q.y)};
    *(GAS f32x4*)(dst + 4) = (f32x4){bf_lo(q.z), bf_hi(q.z), bf_lo(q.w), bf_hi(q.w)};
}
__device__ __forceinline__ void prompt_unit(Frame& F, const Args& A, int b, int hk) {
    const bf16* PROJ = (const bf16*)(A.ws + WS_PROJ); bf16* MIX = (bf16*)(A.ws + WS_MIX);
    LAS unsigned char* lds = F.lds;
    fill_lut(lds, A.in[I_RB], hk, F.tid);
    v4u kqa[8], vqa[8];
#pragma unroll
    for (int i = 0; i < 8; ++i) { const int cid = F.tid + 512 * i, kidx = cid >> 4, ch = cid & 15; const int row = 128 * (b - 1) + kidx, rowc = row < 0 ? 0 : row;
        const bf16* p = PROJ + (size_t)rowc * NPROJ + 128 * hk + 8 * ch; kqa[i] = *(const GAS v4u*)(p + C_K); vqa[i] = *(const GAS v4u*)(p + C_V); }
#pragma unroll
    for (int i = 0; i < 8; ++i) { const int cid = F.tid + 512 * i, kidx = cid >> 4, ch = cid & 15; const int row = 128 * (b - 1) + kidx;
        v4u kq = kqa[i], vq = vqa[i];
        if (row < 0) { kq = (v4u){0u, 0u, 0u, 0u}; vq = (v4u){0u, 0u, 0u, 0u}; }
        stage_kv(lds, kidx, ch, kq, vq);
        if (b == SEQ / 128 - 1 && kidx >= 128) {
            store8_f32(A.out + O_KWP + (size_t)(kidx - 128) * 512 + 128 * hk + 8 * ch, kq);
            store8_f32(A.out + O_VWP + (size_t)(kidx - 128) * 512 + 128 * hk + 8 * ch, vq); }
    }
    __syncthreads();
    const int g = F.wave >> 1, half = F.wave & 1, c = F.lane & 31, h = F.lane >> 5, head = 4 * hk + g;
    const float sink = A.in[I_SINK][head];
#pragma unroll 1
    for (int qt = 0; qt < 2; ++qt) { const int r = 64 * half + 32 * qt + c, row = 128 * b + r;
        bf16x8 Q[8];
#pragma unroll
        for (int ks = 0; ks < 8; ++ks) Q[ks] = *(const GAS bf16x8*)(PROJ + (size_t)row * NPROJ + 128 * head + 16 * ks + 8 * h);
        attn_qtile<5>(lds, 2 * half + qt, Q, r, b == 0 ? 128 : 0, 256, g, sink, MIX + (size_t)row * D + 128 * head, F.lane);
    }
    __syncthreads();
}
__device__ __forceinline__ void sample_unit(Frame& F, const Args& A, int s, int hk) {
    const bf16* PROJ = (const bf16*)(A.ws + WS_PROJ); bf16* MIX = (bf16*)(A.ws + WS_MIX);
    LAS unsigned char* lds = F.lds;
    fill_lut(lds, A.in[I_RB], hk, F.tid);
    {
        const int ch = F.tid & 15, kb0 = F.tid >> 4;
        f32x4 ck[4][2], cv[4][2];
#pragma unroll
        for (int i = 0; i < 4; ++i) { const size_t off = (((size_t)s * 128 + kb0 + 32 * i) * 4 + hk) * 128 + 8 * ch;
            ck[i][0] = *(const GAS f32x4*)(A.in[I_CK] + off); ck[i][1] = *(const GAS f32x4*)(A.in[I_CK] + off + 4);
            cv[i][0] = *(const GAS f32x4*)(A.in[I_CV] + off); cv[i][1] = *(const GAS f32x4*)(A.in[I_CV] + off + 4); }
        const int kn = 128 + kb0, knc = kn < 136 ? kn : 135;
        const bf16* pn = PROJ + (size_t)(SEQ + 8 * s + (knc - 128)) * NPROJ + 128 * hk + 8 * ch;
        v4u nkq = *(const GAS v4u*)(pn + C_K), nvq = *(const GAS v4u*)(pn + C_V);
#pragma unroll
        for (int i = 0; i < 4; ++i) { const int kidx = kb0 + 32 * i; const f32x4 k0 = ck[i][0], k1 = ck[i][1], v0 = cv[i][0], v1 = cv[i][1];
            const v4u kq = (v4u){pg8::cvt_pk_bf16(k0[0], k0[1]), pg8::cvt_pk_bf16(k0[2], k0[3]), pg8::cvt_pk_bf16(k1[0], k1[1]), pg8::cvt_pk_bf16(k1[2], k1[3])};
            const v4u vq = (v4u){pg8::cvt_pk_bf16(v0[0], v0[1]), pg8::cvt_pk_bf16(v0[2], v0[3]), pg8::cvt_pk_bf16(v1[0], v1[1]), pg8::cvt_pk_bf16(v1[2], v1[3])};
            if (kidx >= 8) {
                float* ko = A.out + O_KWS + (((size_t)s * 128 + (kidx - 8)) * 4 + hk) * 128 + 8 * ch; *(GAS f32x4*)ko = k0; *(GAS f32x4*)(ko + 4) = k1;
                float* vo = A.out + O_VWS + (((size_t)s * 128 + (kidx - 8)) * 4 + hk) * 128 + 8 * ch; *(GAS f32x4*)vo = v0; *(GAS f32x4*)(vo + 4) = v1; }
            stage_kv(lds, kidx, ch, kq, vq); }
        if (kn < 136) {
            store8_f32(A.out + O_KWS + (((size_t)s * 128 + (kn - 8)) * 4 + hk) * 128 + 8 * ch, nkq);
            store8_f32(A.out + O_VWS + (((size_t)s * 128 + (kn - 8)) * 4 + hk) * 128 + 8 * ch, nvq);
        } else { nkq = (v4u){0u, 0u, 0u, 0u}; nvq = (v4u){0u, 0u, 0u, 0u}; }
        stage_kv(lds, kn, ch, nkq, nvq);
    }
    __syncthreads();
    if (F.wave == 0) {
        const int c = F.lane & 31, h = F.lane >> 5, g = c >> 3, t = c & 7, head = 4 * hk + g, row = SEQ + 8 * s + t;
        const float sink = A.in[I_SINK][head];
        bf16x8 Q[8];
#pragma unroll
        for (int ks = 0; ks < 8; ++ks) Q[ks] = *(const GAS bf16x8*)(PROJ + (size_t)row * NPROJ + 128 * head + 16 * ks + 8 * h);
        attn_qtile<5>(lds, 0, Q, t, 0, 136, g, sink, MIX + (size_t)row * D + 128 * head, F.lane);
    }
    __syncthreads();
}
__device__ __forceinline__ f32x4 ld4bf(const bf16* p) { const v2u q = *(const GAS v2u*)p; return (f32x4){bf_lo(q.x), bf_hi(q.x), bf_lo(q.y), bf_hi(q.y)}; }
__device__ __forceinline__ void conv_item(Frame& F, const Args& A, int item) {
    const bf16* PROJ = (const bf16*)(A.ws + WS_PROJ); bf16* MIX = (bf16*)(A.ws + WS_MIX);
    const int sl = item >> 3, r0 = 8 * sl, c0 = 256 * (item & 7) + 4 * F.lane;
    const f32x4 w0 = *(const GAS f32x4*)(A.in[I_CW] + c0), w1 = *(const GAS f32x4*)(A.in[I_CW] + 2048 + c0), w2 = *(const GAS f32x4*)(A.in[I_CW] + 4096 + c0);
#define load4(row, col) ld4bf(PROJ + (size_t)(row) * NPROJ + (col) + c0)
    f32x4 u[10], gb[8];
    if (r0 >= SEQ) { const int s = (r0 - SEQ) >> 3;
        u[0] = *(const GAS f32x4*)(A.in[I_SC] + ((size_t)s * 2 + 0) * 2048 + c0); u[1] = *(const GAS f32x4*)(A.in[I_SC] + ((size_t)s * 2 + 1) * 2048 + c0); }
    else if (r0 == 0) { u[0] = (f32x4){0.f, 0.f, 0.f, 0.f}; u[1] = u[0]; }
    else { u[0] = load4(r0 - 2, C_GC) * load4(r0 - 2, C_HC); u[1] = load4(r0 - 1, C_GC) * load4(r0 - 1, C_HC); }
#pragma unroll
    for (int i = 0; i < 8; ++i) { u[2 + i] = load4(r0 + i, C_GC) * load4(r0 + i, C_HC); gb[i] = load4(r0 + i, C_GB); }
#pragma unroll
    for (int i = 0; i < 8; ++i) { const int row = r0 + i;
        const f32x4 y = gb[i] * (w0 * u[i] + w1 * u[i + 1] + w2 * u[i + 2]);
        v2u w; w.x = pg8::cvt_pk_bf16(y.x, y.y); w.y = pg8::cvt_pk_bf16(y.z, y.w); *(GAS v2u*)(MIX + (size_t)row * D + 2048 + c0) = w;
        if (i >= 6) {
            if (r0 == SEQ - 8) *(GAS f32x4*)(A.out + O_CP + (size_t)(i - 6) * 2048 + c0) = u[2 + i];
            if (r0 >= SEQ) *(GAS f32x4*)(A.out + O_CS + ((size_t)((r0 - SEQ) >> 3) * 2 + (i - 6)) * 2048 + c0) = u[2 + i]; } }
#undef load4
}
__device__ __forceinline__ void mixer_phase(Frame& F, const Args& A) {
#ifndef PROBE_P7
#define PROBE_P7 0
#endif
    for (int u = F.vcu; u < 256 * (PROBE_P7 == 1 ? 2 : 1); u += F.G) prompt_unit(F, A, (u & 255) >> 2, u & 3);
    for (int u = F.vcu; u < 512 * (PROBE_P7 == 2 ? 2 : 1); u += F.G) sample_unit(F, A, (u & 511) >> 2, u & 3);
    for (int u = F.vcu * NWAVES + F.wave; u < (M / 8) * 8 * (PROBE_P7 == 3 ? 2 : 1); u += F.G * NWAVES) conv_item(F, A, u % ((M / 8) * 8));
}
}

constexpr int N_PHASES = 13;
__global__ void __launch_bounds__(NWAVES * 64, 2) mk_fwd(Args args) {
    extern __shared__ __attribute__((aligned(16))) unsigned char lds[];
    Frame F;
    F.lds = (LAS unsigned char*)lds;
    F.MISC = (volatile LAS unsigned*)(F.lds + MISC_OFF);
    F.tid = threadIdx.x; F.lane = F.tid & 63; F.wave = __builtin_amdgcn_readfirstlane(F.tid >> 6);
    F.G = gridDim.x; { const int bx = blockIdx.x; F.vcu = (F.G % 8 == 0) ? (bx % 8) * (F.G / 8) + bx / 8 : bx; }
    unsigned char* ws = args.ws;
    F.ctl = (gu32*)(ws + WS_CTL);
    for (int u = F.tid; u < (LDS_BYTES - LDSCTL_OFF) / 4; u += NWAVES * 64) ((LAS unsigned*)(F.lds + LDSCTL_OFF))[u] = 0u;
    __syncthreads();
    XcdBarrier bar = xcd_barrier_post((unsigned*)(F.ctl + CW_BAR), F.MISC + 8);
    const int lo = args.ph_lo, hi = args.ph_hi;
#define IN(k) (lo <= (k) && (k) < hi)
#ifndef PROBE_PHASE
#define PROBE_PHASE -1
#endif
#define REPS(k) ((PROBE_PHASE == (k)) ? 2 : 1)
#define SEAM(k) do { if (IN(k) && IN((k) + 1)) xcd_barrier(bar); } while (0)
    bf16* W13A = (bf16*)(ws + WS_W13A); bf16* W2A = (bf16*)(ws + WS_W2A); bf16* WINT = (bf16*)(ws + WS_WIN); bf16* WOUT = (bf16*)(ws + WS_WOUT);
    bf16* W13B = (bf16*)(ws + WS_W13B); bf16* W2B = (bf16*)(ws + WS_W2B); bf16* WADA = (bf16*)(ws + WS_WADA); bf16* CSI = (bf16*)(ws + WS_CSI);
    float* MOD = (float*)(ws + WS_MOD); bf16* X1 = (bf16*)(ws + WS_X1);     bf16* H = (bf16*)(ws + WS_H); bf16* T = (bf16*)(ws + WS_T);
    bf16* PROJ = (bf16*)(ws + WS_PROJ); bf16* MIX = (bf16*)(ws + WS_MIX);
    const int cb = (int)blockIdx.x;

    if (IN(0)) {
#pragma unroll
        for (int rep = 0; rep < REPS(0); ++rep) { if (rep) xcd_barrier(bar);  csilu_phase(F, args); { const int rank = F.vcu * NWAVES + F.wave, nw = F.G * NWAVES; conv_job<JOB_W1A>(F, args, rank, nw); conv_job<JOB_W3A>(F, args, rank, nw); conv_job<JOB_WIN>(F, args, rank, nw); }  } } SEAM(0);
    if (IN(1)) {
#pragma unroll
        for (int rep = 0; rep < REPS(1); ++rep) { if (rep) xcd_barrier(bar); mod_chunk_partials(F, args, 0, F.vcu, F.G); } } SEAM(1);
    if (IN(2)) {
#pragma unroll
        for (int rep = 0; rep < REPS(2); ++rep) { if (rep) xcd_barrier(bar);  normmod_phase<true, false>(F, args.in[I_XP], args.in[I_XS], args.in[I_G1], MOD, 0, 1, H);  } } SEAM(2);
    if (IN(3)) {
#pragma unroll
        for (int rep = 0; rep < REPS(3); ++rep) { if (rep) xcd_barrier(bar);  pg8::Gemm g{H, W13A, M, 2 * FF, D / 2}; pg8::StaticOrder S; S.init(M, 2 * FF, F.G, cb);
        pg8::EpiSwiGLU8 E{(unsigned char*)T, FF, 1.0f / (S_H * S_W13), S_T};
        #if UP_CUT
#pragma unroll 1
        for (int sb = 0; sb < S.nwg; sb += UP_CUT) { if (sb) xcd_barrier(bar); S.sub(sb, (sb + 2 * UP_CUT > S.nwg) ? S.nwg : sb + UP_CUT);
            pg8::gemm_phase<pg8::EpiSwiGLU8, pg8::StaticOrder, PG8_ALIGN, PG8_SP2, true>(F.lds + RING_OFF, g, S, E); if (sb + 2 * UP_CUT > S.nwg) break; }
#else
        pg8::gemm_phase<pg8::EpiSwiGLU8, pg8::StaticOrder, PG8_ALIGN, PG8_SP2, true>(F.lds + RING_OFF, g, S, E);
#endif
#if PROBE_GEMM
        { xcd_barrier(bar); pg8::DegenOrder S2; S2.init(M, 2 * FF, F.G, cb); pg8::EpiNull E2{(float*)(ws + WS_PART)};
          pg8::gemm_phase<pg8::EpiNull, pg8::DegenOrder, PG8_ALIGN, PG8_SP2, true, PROBE_GEMM - 1>(F.lds + RING_OFF, g, S2, E2); xcd_barrier(bar); }
#endif
        if (rep == 0) { const int left = ((M / 256) * (2 * FF / 256)) % F.G;
            if (cb >= left) { const int rank = (cb - left) * NWAVES + F.wave, nw = (F.G - left) * NWAVES; conv_job<JOB_W2A>(F, args, rank, nw); } } } } SEAM(3);
    if (IN(4)) {
#pragma unroll
        for (int rep = 0; rep < REPS(4); ++rep) { if (rep) xcd_barrier(bar);  pg8::Gemm g{T, W2A, M, D, FF / 2}; pg8::StaticOrder S; S.init(M, D, F.G, cb);
        pg8::EpiResid<true, false> E{args.in[I_XP], args.in[I_XS], X1, MOD, D, MODW, 2 * D, SEQ, 0.5f / (S_T * S_W2)};
        pg8::gemm_phase<pg8::EpiResid<true, false>, pg8::StaticOrder, PG8_ALIGN, PG8_SP2, true>(F.lds + RING_OFF, g, S, E);
        if (rep == 0) { const int left = ((M / 256) * (D / 256)) % F.G;
            if (cb >= left) { const int ir = cb - left, ni = F.G - left;
                mod_chunk_partials(F, args, 1, ir, ni); __syncthreads(); {     const int rank = ir * NWAVES + F.wave, nw = ni * NWAVES; conv_job<JOB_W1B>(F, args, rank, nw); } } } } } SEAM(4);
    if (IN(5)) { normmod_phase<false, true>(F, X1, X1 + (size_t)SEQ * D, args.in[I_GM], MOD, 3, 4, H); } SEAM(5);
    if (IN(6)) {
#pragma unroll
        for (int rep = 0; rep < REPS(6); ++rep) { if (rep) xcd_barrier(bar);  pg8::Gemm g{H, WINT, M, NPROJ, D}; pg8::StaticOrder S; S.init(M, NPROJ, F.G, cb);
        pg8::EpiBf16 E{PROJ, NPROJ};
        pg8::gemm_phase<pg8::EpiBf16, pg8::StaticOrder, PG8_ALIGN, PG8_SP2>(F.lds + RING_OFF, g, S, E);
        if (rep == 0) { const int left = ((M / 256) * (NPROJ / 256)) % F.G;
            if (cb >= left) { const int ir = cb - left, ni = F.G - left;
                mod_chunk_partials(F, args, 2, ir, ni); __syncthreads(); { const int rank = ir * NWAVES + F.wave, nw = ni * NWAVES; conv_job<JOB_WOUT>(F, args, rank, nw); conv_job<JOB_W3B>(F, args, rank, nw); } } } } } SEAM(6);
    if (IN(7)) {
#pragma unroll
        for (int rep = 0; rep < REPS(7); ++rep) { if (rep) xcd_barrier(bar);  att::mixer_phase(F, args);  } } SEAM(7);
    if (IN(8)) { pg8::Gemm g{MIX, WOUT, M, D, D}; pg8::StaticOrder S; S.init(M, D, F.G, cb);
        pg8::EpiResid<true, true> E{X1, X1 + (size_t)SEQ * D, X1, MOD, D, MODW, 5 * D, SEQ, 1.0f};
        pg8::gemm_phase<pg8::EpiResid<true, true>, pg8::StaticOrder, PG8_ALIGN, PG8_SP2>(F.lds + RING_OFF, g, S, E);
        { const int left = ((M / 256) * (D / 256)) % F.G;
            if (cb >= left) { const int rank = (cb - left) * NWAVES + F.wave, nw = (F.G - left) * NWAVES; conv_job<JOB_W2B>(F, args, rank, nw); } } } SEAM(8);
    if (IN(9)) { normmod_phase<true, true>(F, X1, X1 + (size_t)SEQ * D, args.in[I_G2], MOD, 6, 7, H); } SEAM(9);
    if (IN(10)) { pg8::Gemm g{H, W13B, M, 2 * FF, D / 2}; pg8::ListOrder S; { pg8::SkOrder K; K.init(M, 2 * FF, D / 2, F.G, cb); S.list = (const LAS int*)(F.lds + SKLIST_OFF); S.n = pg8::sk_build_list(K, (LAS int*)(F.lds + SKLIST_OFF)); }
        S.slots = (float*)(ws + WS_SKS); S.counters = (unsigned*)(F.ctl + CW_SK + 0 * CW_SK_STRIDE);
        pg8::EpiSwiGLU8 E{(unsigned char*)T, FF, 1.0f / (S_H * S_W13), S_T};
        pg8::gemm_phase<pg8::EpiSwiGLU8, pg8::ListOrder, PG8_ALIGN, PG8_SP2, true>(F.lds + RING_OFF, g, S, E); } SEAM(10);
    if (IN(11)) { pg8::Gemm g{T, W2B, M, D, FF / 2}; pg8::ListOrder S; { pg8::SkOrder K; K.init(M, D, FF / 2, F.G, cb); S.list = (const LAS int*)(F.lds + SKLIST_OFF); S.n = pg8::sk_build_list(K, (LAS int*)(F.lds + SKLIST_OFF)); }
        S.slots = (float*)(ws + WS_SKS2); S.counters = (unsigned*)(F.ctl + CW_SK + 1 * CW_SK_STRIDE);
        pg8::EpiResid<false, true> E{X1, X1 + (size_t)SEQ * D, X1, MOD, D, MODW, 8 * D, SEQ, 0.5f / (S_T * S_W2)};
        pg8::gemm_phase<pg8::EpiResid<false, true>, pg8::ListOrder, PG8_ALIGN, PG8_SP2, true>(F.lds + RING_OFF, g, S, E); } SEAM(11);
    if (IN(12)) { final_norm_phase(F, X1, args.in[I_GF], args.out); }
#undef IN
#undef SEAM
}

extern "C" void kernel_launch(void* const* d_in, const int* in_sizes, int n_in, void* d_out, int out_size, void* d_ws, size_t ws_size, hipStream_t stream) {
    static int grid = 0;
    if (grid == 0) {
        if (n_in != N_IN || (size_t)out_size != O_END || ws_size < WS_END) { fprintf(stderr, "kernel_launch: unexpected shapes: n_in %d out %d ws %zu (need %zu)\n", n_in, out_size, ws_size, (size_t)WS_END); grid = -1; return; }
        int dev = 0, cus = 0, per_cu = 0;
        if (hipGetDevice(&dev) != hipSuccess || hipDeviceGetAttribute(&cus, hipDeviceAttributeMultiprocessorCount, dev) != hipSuccess) { grid = -1; return; }
        if (hipFuncSetAttribute((const void*)mk_fwd, hipFuncAttributeMaxDynamicSharedMemorySize, LDS_BYTES) != hipSuccess) { fprintf(stderr, "kernel_launch: hipFuncSetAttribute failed\n"); grid = -1; return; }
        if (hipOccupancyMaxActiveBlocksPerMultiprocessor(&per_cu, (const void*)mk_fwd, NWAVES * 64, LDS_BYTES) != hipSuccess || per_cu < 1) { fprintf(stderr, "kernel_launch: occupancy query says %d\n", per_cu); }
        (void)hipGetLastError();
        grid = cus;
    }
    if (grid < 0) return;
    if (hipMemsetAsync((char*)d_ws + WS_CTL, 0, CTL_ZERO_BYTES, stream) != hipSuccess) return;
    Args a{};
    for (int i = 0; i < N_IN; ++i) a.in[i] = (const float*)d_in[i];
    a.out = (float*)d_out; a.ws = (unsigned char*)d_ws;
#if MK_PER_PHASE
    for (int p = 0; p < N_PHASES; ++p) { a.ph_lo = p; a.ph_hi = p + 1; hipLaunchKernelGGL(mk_fwd, dim3(grid), dim3(NWAVES * 64), LDS_BYTES, stream, a); }
#else
    a.ph_lo = 0; a.ph_hi = N_PHASES;
    hipLaunchKernelGGL(mk_fwd, dim3(grid), dim3(NWAVES * 64), LDS_BYTES, stream, a);
#endif
    const hipError_t le = hipPeekAtLastError();
    if (le != hipSuccess) fprintf(stderr, "kernel_launch: launch failed: %s\n", hipGetErrorName(le));
}
```

```cpp
#include <hip/hip_runtime.h>
#include <cstdio>
#include <cstdint>
#ifndef PG8_LOADPRIO
#define PG8_LOADPRIO 0
#endif
namespace pg8 {
#define PG8_LAS __attribute__((address_space(3)))
typedef unsigned short bf16_t;
typedef short bf16x8 __attribute__((ext_vector_type(8)));
typedef float f32x4 __attribute__((ext_vector_type(4)));
typedef unsigned u32x4 __attribute__((ext_vector_type(4)));
typedef unsigned u32x2 __attribute__((ext_vector_type(2)));
typedef int i32x4 __attribute__((ext_vector_type(4)));
typedef int i32x8 __attribute__((ext_vector_type(8)));
__device__ __forceinline__ i32x8 cat8(bf16x8 lo, bf16x8 hi) { return __builtin_shufflevector(__builtin_bit_cast(i32x4, lo), __builtin_bit_cast(i32x4, hi), 0, 1, 2, 3, 4, 5, 6, 7); }
__device__ __forceinline__ unsigned cvt4_fp8(float a, float b, float c, float d) {
    a = __builtin_fminf(__builtin_fmaxf(a, -448.f), 448.f); b = __builtin_fminf(__builtin_fmaxf(b, -448.f), 448.f);
    c = __builtin_fminf(__builtin_fmaxf(c, -448.f), 448.f); d = __builtin_fminf(__builtin_fmaxf(d, -448.f), 448.f);
    int w = 0; w = __builtin_amdgcn_cvt_pk_fp8_f32(a, b, w, false); w = __builtin_amdgcn_cvt_pk_fp8_f32(c, d, w, true); return (unsigned)w; }
constexpr int BM = 256, BK = 64, HALF = 128, HTB = HALF * BK * 2  , STAGE_BYTES = 8 * HTB, NXCD = 8, WGM = 8;

__host__ __device__ __forceinline__ int lds_byte(int r, int c) { const int st = (r >> 4) * 2 + (c >> 5), rr = r & 15, cc = c & 31, ob = rr * 64 + cc * 2; return st * 1024 + (ob ^ (((ob >> 9) & 1) << 5)); }
__host__ __device__ __forceinline__ void stage_rc(int b, int& R, int& C) { const int st = b / 1024, sb = b % 1024, swz = sb ^ (((sb >> 9) & 1) << 5); R = (st >> 1) * 16 + swz / 64; C = (st & 1) * 32 + (swz % 64) / 2; }
__host__ __device__ __forceinline__ int perm32(int rho) { const int n = rho >> 4, i = rho & 15; return 8 * (i >> 2) + 4 * n + (i & 3); }

struct Unit { int pm, pn, kb, ke, kind, slot; };
struct Gemm { const bf16_t* A; const bf16_t* Bt; int M, N, K; };

struct StaticOrder {
    static constexpr bool SK = false;
    int nM, nN, nwg, G, c, base, lim;
    __host__ __device__ void init(int M, int N, int G_, int c_) { nM = M / BM; nN = N / BM; nwg = nM * nN; G = G_; c = c_; base = 0; lim = nwg; }
    __host__ __device__ void sub(int b, int l) { base = b; lim = l < nwg ? l : nwg; }
    __host__ __device__ bool next(int i, Unit& u) const {
        const long L = (long)base + (long)i * G + c; if (L >= lim) return false;
        int wgid = (int)L; { const int q = nwg / NXCD, r = nwg % NXCD, xcd = wgid % NXCD, off = wgid / NXCD; wgid = (xcd < r ? xcd * (q + 1) : r * (q + 1) + (xcd - r) * q) + off; }
        const int nig = WGM * nN, gid = wgid / nig, fm = gid * WGM, gsz = (nM - fm) < WGM ? (nM - fm) : WGM;
        u.pm = fm + ((wgid % nig) % gsz); u.pn = (wgid % nig) / gsz; return true;
    }
    __device__ __forceinline__ void a_ready(const Unit&) const {}
    __device__ __forceinline__ void done(const Unit&) const {}
};

struct DegenOrder {
    static constexpr bool SK = false;
    int nwg, G, c;
    __device__ __forceinline__ void init(int M, int N, int G_, int c_) { nwg = (M / BM) * (N / BM); G = G_; c = c_; }
    __device__ __forceinline__ bool next(int i, Unit& u) const { if ((long)i * G + c >= nwg) return false; u.pm = 0; u.pn = 0; return true; }
    __device__ __forceinline__ void a_ready(const Unit&) const {}
    __device__ __forceinline__ void done(const Unit&) const {}
};
struct SkOrder {
    int nM, nN, nwg, G, c, Rs, cnt8, qq, nt, np, q, ufirst, ulast, nsk; long s, e;
    __device__ __forceinline__ void init(int M, int N, int Kbf, int G_, int c_) {
        nM = M / BM; nN = N / BM; nwg = nM * nN; G = G_; c = c_; nt = Kbf / BK; np = nt / 2;
        if (G != 256 || (nwg % 8) != 0 || nwg < 2 * G) { Rs = (nwg + G - 1) / G; nsk = 0; qq = nwg / 8; cnt8 = 0; q = 0; s = e = 0; ufirst = ulast = 0; return; }
        Rs = nwg / G - 1; const int usk = nwg - Rs * G; cnt8 = usk / 8; qq = nwg / 8; q = (c % 8) * 32 + c / 8;
        const long P = (long)usk * np; s = (long)q * P / G; e = (long)(q + 1) * P / G;
        ufirst = (int)(s / np); ulast = (int)((e - 1) / np); nsk = ulast - ufirst + 1;
    }
    __device__ __forceinline__ void tile_of(int wgid, Unit& u) const { const int nig = WGM * nN, gid = wgid / nig, fm = gid * WGM, gsz = (nM - fm) < WGM ? (nM - fm) : WGM; u.pm = fm + ((wgid % nig) % gsz); u.pn = (wgid % nig) / gsz; }
    __device__ __forceinline__ bool next(int i, Unit& u) const {
        if (i < Rs) { const long L = (long)i * G + c; if (L >= nwg) return false;
            int wgid = (int)L; { const int qv = nwg / NXCD, r = nwg % NXCD, xcd = wgid % NXCD, off = wgid / NXCD; wgid = (xcd < r ? xcd * (qv + 1) : r * (qv + 1) + (xcd - r) * qv) + off; }
            tile_of(wgid, u); u.kb = 0; u.ke = nt; u.kind = 0; u.slot = 0; return true; }
        const int j = i - Rs; if (j >= nsk) return false;
        const int un = ufirst + j; tile_of((un / cnt8) * qq + 32 * Rs + (un % cnt8), u);
        u.kb = (j == 0) ? 2 * (int)(s - (long)ufirst * np) : 0; u.ke = (un == ulast) ? 2 * (int)(e - (long)ulast * np) : nt;
        u.kind = (u.kb > 0) ? 1 : ((u.ke < nt) ? 2 : 0); u.slot = (u.kind == 1) ? q : q + 1; return true;
    }
    __device__ __forceinline__ int count() const { return Rs + nsk; }
};

struct ListOrder {
    static constexpr bool SK = true;
    const PG8_LAS int* list; int n;
    float* slots; unsigned* counters;
    __device__ __forceinline__ bool next(int i, Unit& u) const {
        if (i >= n) return false; const PG8_LAS int* p = list + 8 * i;
        u.pm = __builtin_amdgcn_readfirstlane(p[0]); u.pn = __builtin_amdgcn_readfirstlane(p[1]); u.kb = __builtin_amdgcn_readfirstlane(p[2]);
        u.ke = __builtin_amdgcn_readfirstlane(p[3]); u.kind = __builtin_amdgcn_readfirstlane(p[4]); u.slot = __builtin_amdgcn_readfirstlane(p[5]); return true;
    }
    __device__ __forceinline__ void a_ready(const Unit&) const {}
    __device__ __forceinline__ void done(const Unit&) const {}
    __device__ __forceinline__ void store_partial(const f32x4 (&acc)[2][2][4][2], const Unit& u, int tid) const {
        const __amdgpu_buffer_rsrc_t rs = __builtin_amdgcn_make_buffer_rsrc((void*)(slots + (size_t)u.slot * 65536), (short)0, 262144, 0x00020000);
#pragma unroll
        for (int a = 0; a < 2; ++a)
#pragma unroll
            for (int b = 0; b < 2; ++b)
#pragma unroll
                for (int m = 0; m < 4; ++m)
#pragma unroll
                    for (int n = 0; n < 2; ++n) __builtin_amdgcn_raw_buffer_store_b128(__builtin_bit_cast(u32x4, acc[a][b][m][n]), rs, ((((a * 2 + b) * 4 + m) * 2 + n) * 512 + tid) * 16, 0, 16);
        asm volatile("s_waitcnt vmcnt(0)" ::: "memory");
        if ((tid & 63) == 0) __hip_atomic_fetch_add(counters + 64 * u.slot, 1u, __ATOMIC_RELAXED, __HIP_MEMORY_SCOPE_AGENT);
    }
    __device__ __forceinline__ void add_partial(f32x4 (&acc)[2][2][4][2], const Unit& u, int tid, int wid) const {
        if (wid == 0) {
            unsigned spins = 0;
            while ((unsigned)__builtin_amdgcn_readfirstlane(__hip_atomic_load(counters + 64 * u.slot, __ATOMIC_RELAXED, __HIP_MEMORY_SCOPE_AGENT)) < 8u) { __builtin_amdgcn_s_sleep(2); if (++spins > (1u << 22)) break; }
            __builtin_amdgcn_fence(__ATOMIC_ACQUIRE, "agent");
            asm volatile("s_waitcnt vmcnt(0)" ::: "memory");
        }
        asm volatile("" ::: "memory"); __builtin_amdgcn_s_barrier(); asm volatile("" ::: "memory");
        const float* sp = slots + (size_t)u.slot * 65536;
#pragma unroll
        for (int a = 0; a < 2; ++a)
#pragma unroll
            for (int b = 0; b < 2; ++b)
#pragma unroll
                for (int m = 0; m < 4; ++m)
                {
#pragma unroll
                  for (int n = 0; n < 2; ++n) acc[a][b][m][n] += *(const f32x4*)(sp + ((size_t)((((a * 2 + b) * 4 + m) * 2 + n) * 512 + tid)) * 4);
                  if (m == 3) asm volatile("" : "+v"(acc[a][b][0][0]), "+v"(acc[a][b][0][1]), "+v"(acc[a][b][1][0]), "+v"(acc[a][b][1][1]), "+v"(acc[a][b][2][0]), "+v"(acc[a][b][2][1]), "+v"(acc[a][b][3][0]), "+v"(acc[a][b][3][1]) :: "memory"); }
    }
};
__device__ __forceinline__ int sk_build_list(const SkOrder& S, PG8_LAS int* list) {
    const int n = S.count();
    if ((int)threadIdx.x < n && threadIdx.x < 32) { Unit u; S.next((int)threadIdx.x, u); PG8_LAS int* p = list + 8 * threadIdx.x; p[0] = u.pm; p[1] = u.pn; p[2] = u.kb; p[3] = u.ke; p[4] = u.kind; p[5] = u.slot; }
    __syncthreads();
    return n < 32 ? n : 32;
}

__device__ __forceinline__ unsigned cvt_pk_bf16(float lo, float hi) { unsigned r; asm volatile("v_cvt_pk_bf16_f32 %0, %1, %2" : "=v"(r) : "v"(lo), "v"(hi)); return r; }
typedef float f32x2 __attribute__((ext_vector_type(2)));

struct EpiNull {
    static constexpr bool PERM = true, AFTER_DRAIN = false;
    float* sink;
    __device__ __forceinline__ void operator()(const f32x4 (&acc)[2][2][4][2], const Unit& u, int wr, int wc, int fr, int fq) const {
        f32x4 s = acc[0][0][0][0];
#pragma unroll
        for (int a = 0; a < 2; ++a)
#pragma unroll
            for (int b = 0; b < 2; ++b)
#pragma unroll
                for (int m = 0; m < 4; ++m)
#pragma unroll
                    for (int n = 0; n < 2; ++n) s += acc[a][b][m][n];
        if (s[0] + s[1] + s[2] + s[3] == 1.2345e37f) *sink = s[0];
    }
};
struct EpiF32 {
    static constexpr bool PERM = false, AFTER_DRAIN = false;
    float* C; int ldc; const float* bias;
    __device__ __forceinline__ void operator()(const f32x4 (&acc)[2][2][4][2], const Unit& u, int wr, int wc, int fr, int fq) const {
        const int row0 = u.pm * BM + wr * 64 + fr, col0 = u.pn * BM + wc * 32 + 4 * fq;
        f32x4 bv[2][2];
#pragma unroll
        for (int bj = 0; bj < 2; ++bj)
#pragma unroll
            for (int n = 0; n < 2; ++n) bv[bj][n] = *(const f32x4*)(bias + col0 + bj * HALF + n * 16);
#pragma unroll
        for (int ai = 0; ai < 2; ++ai)
#pragma unroll
            for (int m = 0; m < 4; ++m) { float* rowp = C + (size_t)(row0 + ai * HALF + m * 16) * ldc + col0;
#pragma unroll
                for (int bj = 0; bj < 2; ++bj)
#pragma unroll
                    for (int n = 0; n < 2; ++n) *(f32x4*)(rowp + bj * HALF + n * 16) = acc[ai][bj][m][n] + bv[bj][n]; }
    }
};
struct EpiBf16 {
    static constexpr bool PERM = true, AFTER_DRAIN = false;
    bf16_t* O; int ldc;
    __device__ __forceinline__ void operator()(const f32x4 (&acc)[2][2][4][2], const Unit& u, int wr, int wc, int fr, int fq) const {
        const int row0 = u.pm * BM + wr * 64 + fr, col0 = u.pn * BM + wc * 32 + 8 * fq;
#pragma unroll
        for (int ai = 0; ai < 2; ++ai)
#pragma unroll
            for (int m = 0; m < 4; ++m) { bf16_t* rowp = O + (size_t)(row0 + ai * HALF + m * 16) * ldc + col0;
#pragma unroll
                for (int bj = 0; bj < 2; ++bj) { const f32x4 v0 = acc[ai][bj][m][0], v1 = acc[ai][bj][m][1];
                    u32x4 w; w.x = cvt_pk_bf16(v0[0], v0[1]); w.y = cvt_pk_bf16(v0[2], v0[3]); w.z = cvt_pk_bf16(v1[0], v1[1]); w.w = cvt_pk_bf16(v1[2], v1[3]);
                    *(u32x4*)(rowp + bj * HALF) = w; } }
    }
};
__device__ __forceinline__ float silu_mul(float a, float b) { return a * b * __builtin_amdgcn_rcpf(1.0f + __expf(-a)); }
struct EpiSwiGLU {
    static constexpr bool PERM = true, AFTER_DRAIN = false;
    bf16_t* O; int ldc;
    __device__ __forceinline__ void operator()(const f32x4 (&acc)[2][2][4][2], const Unit& u, int wr, int wc, int fr, int fq) const {
        const int row0 = u.pm * BM + wr * 64 + fr, col0 = u.pn * HALF + wc * 32 + 8 * fq;
#pragma unroll
        for (int ai = 0; ai < 2; ++ai)
#pragma unroll
            for (int m = 0; m < 4; ++m) { bf16_t* rowp = O + (size_t)(row0 + ai * HALF + m * 16) * ldc + col0;
                const f32x4 a0 = acc[ai][0][m][0], a1 = acc[ai][0][m][1], b0 = acc[ai][1][m][0], b1 = acc[ai][1][m][1];
                u32x4 w;
                w.x = cvt_pk_bf16(silu_mul(a0[0], b0[0]), silu_mul(a0[1], b0[1])); w.y = cvt_pk_bf16(silu_mul(a0[2], b0[2]), silu_mul(a0[3], b0[3]));
                w.z = cvt_pk_bf16(silu_mul(a1[0], b1[0]), silu_mul(a1[1], b1[1])); w.w = cvt_pk_bf16(silu_mul(a1[2], b1[2]), silu_mul(a1[3], b1[3]));
                *(u32x4*)rowp = w; }
    }
};
struct EpiSwiGLU8 {
    static constexpr bool PERM = true, AFTER_DRAIN = false;
    unsigned char* O; int ldc; float inv, st;
    __device__ __forceinline__ void operator()(const f32x4 (&acc)[2][2][4][2], const Unit& u, int wr, int wc, int fr, int fq) const {
        const int row0 = u.pm * BM + wr * 64 + fr, col0 = u.pn * HALF + wc * 32 + 8 * fq;
        const float ib = inv * st;
#pragma unroll
        for (int ai = 0; ai < 2; ++ai)
#pragma unroll
            for (int m = 0; m < 4; ++m) { unsigned char* rowp = O + (size_t)(row0 + ai * HALF + m * 16) * ldc + col0;
                const f32x4 a0 = acc[ai][0][m][0] * inv, a1 = acc[ai][0][m][1] * inv, b0 = acc[ai][1][m][0] * ib, b1 = acc[ai][1][m][1] * ib;
                u32x2 w;
                w.x = cvt4_fp8(silu_mul(a0[0], b0[0]), silu_mul(a0[1], b0[1]), silu_mul(a0[2], b0[2]), silu_mul(a0[3], b0[3]));
                w.y = cvt4_fp8(silu_mul(a1[0], b1[0]), silu_mul(a1[1], b1[1]), silu_mul(a1[2], b1[2]), silu_mul(a1[3], b1[3]));
                *(u32x2*)rowp = w; }
    }
};
template <bool PIPE, bool BASE_BF16> struct EpiResid {
    static constexpr bool PERM = false, AFTER_DRAIN = false;
    const void* base_p; const void* base_s; bf16_t* out; const float* mod; int ldc, modld, goff, split_rows; float gs;
    static __device__ __forceinline__ f32x4 ldb(const void* rowp, int c) {
        if constexpr (BASE_BF16) { const u32x2 q = *(const u32x2*)((const bf16_t*)rowp + c);
            return (f32x4){__builtin_bit_cast(float, q.x << 16), __builtin_bit_cast(float, q.x & 0xffff0000u), __builtin_bit_cast(float, q.y << 16), __builtin_bit_cast(float, q.y & 0xffff0000u)}; }
        else return *(const f32x4*)((const float*)rowp + c);
    }
    static __device__ __forceinline__ const void* rowptr(const void* b, size_t r, int ldc) { if constexpr (BASE_BF16) return (const bf16_t*)b + r * ldc; else return (const float*)b + r * ldc; }
    static __device__ __forceinline__ void stq(bf16_t* p, f32x4 v) { u32x2 w; w.x = cvt_pk_bf16(v[0], v[1]); w.y = cvt_pk_bf16(v[2], v[3]); *(u32x2*)p = w; }
    __device__ __forceinline__ void operator()(const f32x4 (&acc)[2][2][4][2], const Unit& u, int wr, int wc, int fr, int fq) const {
        const int col0 = u.pn * BM + wc * 32 + 4 * fq;
        if (PIPE && u.pm * BM < split_rows) {
            f32x4 gq[2][2], bc[2][2], bn[2][2];
            { const void* rp = rowptr(base_p, (size_t)(u.pm * BM + wr * 64 + fr), ldc);
#pragma unroll
            for (int bj = 0; bj < 2; ++bj)
#pragma unroll
                for (int n = 0; n < 2; ++n) { gq[bj][n] = *(const f32x4*)(mod + goff + col0 + bj * HALF + n * 16) * gs; bc[bj][n] = ldb(rp, col0 + bj * HALF + n * 16); } }
#pragma unroll
            for (int gi = 0; gi < 8; ++gi) { const int ai = gi >> 2, m = gi & 3; const int r = u.pm * BM + ai * HALF + wr * 64 + m * 16 + fr;
                if (gi < 7) { const void* rp = rowptr(base_p, (size_t)(u.pm * BM + ((gi + 1) >> 2) * HALF + wr * 64 + ((gi + 1) & 3) * 16 + fr), ldc);
#pragma unroll
                    for (int bj = 0; bj < 2; ++bj)
#pragma unroll
                        for (int n = 0; n < 2; ++n) bn[bj][n] = ldb(rp, col0 + bj * HALF + n * 16); }
                bf16_t* orow = out + (size_t)r * ldc;
#pragma unroll
                for (int bj = 0; bj < 2; ++bj)
#pragma unroll
                    for (int n = 0; n < 2; ++n) { stq(orow + col0 + bj * HALF + n * 16, bc[bj][n] + gq[bj][n] * acc[ai][bj][m][n]); bc[bj][n] = bn[bj][n]; }
                asm volatile("" ::: "memory"); }
        } else {
#pragma unroll
            for (int ai = 0; ai < 2; ++ai)
#pragma unroll
                for (int m = 0; m < 4; ++m) { const int r = u.pm * BM + ai * HALF + wr * 64 + m * 16 + fr;
                    const void* brow = (r < split_rows) ? rowptr(base_p, (size_t)r, ldc) : rowptr(base_s, (size_t)(r - split_rows), ldc);
                    const float* grow = mod + (size_t)((r < split_rows) ? 0 : 1 + ((r - split_rows) >> 3)) * modld + goff;
                    bf16_t* orow = out + (size_t)r * ldc;
#pragma unroll
                    for (int bj = 0; bj < 2; ++bj)
#pragma unroll
                        for (int n = 0; n < 2; ++n) { const int c = col0 + bj * HALF + n * 16;
                            const f32x4 b = ldb(brow, c), g = *(const f32x4*)(grow + c);
                            stq(orow + c, b + (g * gs) * acc[ai][bj][m][n]); }
                    asm volatile("" ::: "memory"); }
        }
    }
};
template <class Epi, class Sched, bool ALIGN_EPI = false, bool SP2 = false, bool FP8 = false, int DIAG = 0>
__device__ __forceinline__ void gemm_phase(PG8_LAS unsigned char* lds, const Gemm g, const Sched& S, const Epi& E) {
    const int tid = threadIdx.x, wid = __builtin_amdgcn_readfirstlane(tid >> 6), lane = tid & 63, wr = wid >> 2, wc = wid & 3, fr = lane & 15, fq = lane >> 4;
    const int K = g.K, nt = K / BK;
    unsigned voffA[2], voffB[2];
#pragma unroll
    for (int i = 0; i < 2; ++i) { int R, C; stage_rc(tid * 16 + i * 8192, R, C); const int Rb = Epi::PERM ? ((R & ~31) + perm32(R & 31)) : R;
        voffA[i] = (unsigned)(R * K + C) * 2u; voffB[i] = (unsigned)(Rb * K + C) * 2u; }
    const size_t kstep = (size_t)(BK * 2);
    const size_t hstep = (size_t)HALF * K * 2;
    const size_t tstep = 2 * hstep;
    const unsigned ldsw = (unsigned)wid * 1024u;
    const int aoff = lds_byte(wr * 64 + fr, fq * 8), boff = lds_byte(wc * 32 + fr, fq * 8);
#define PG8_SA(b, h) (((b) * 2 + (h)) * HTB)
#define PG8_SB(b, h) ((4 + (b) * 2 + (h)) * HTB)
#define PG8_STAGE(bufoff, gbase, voff) do { if constexpr (DIAG >= 1) break; _Pragma("unroll") for (int _i = 0; _i < 2; ++_i) \
        __builtin_amdgcn_global_load_lds((const unsigned*)((const char*)(gbase) + (voff)[_i]), (PG8_LAS unsigned*)(lds + (bufoff) + ldsw + _i * 8192), 16, 0, 0); } while (0)
#define PG8_LDA(dst, b, h) do { if constexpr (DIAG == 2 || DIAG == 3) break; _Pragma("unroll") for (int m = 0; m < 4; ++m) _Pragma("unroll") for (int k = 0; k < 2; ++k) dst[m][k] = *(const PG8_LAS bf16x8*)(lds + PG8_SA(b, h) + aoff + m * 2048 + k * 1024); } while (0)
#define PG8_LDB(dst, b, h) do { if constexpr (DIAG == 2 || DIAG == 3) break; _Pragma("unroll") for (int n = 0; n < 2; ++n) _Pragma("unroll") for (int k = 0; k < 2; ++k) dst[n][k] = *(const PG8_LAS bf16x8*)(lds + PG8_SB(b, h) + boff + n * 2048 + k * 1024); } while (0)
#define PG8_MMA(ai, bj, At, Bt) do { if constexpr (DIAG == 4) { _Pragma("unroll") for (int m = 0; m < 4; ++m) asm volatile("" :: "v"(cat8(At[m][0], At[m][1]))); _Pragma("unroll") for (int n = 0; n < 2; ++n) asm volatile("" :: "v"(cat8(Bt[n][0], Bt[n][1]))); break; } __builtin_amdgcn_s_setprio(1); _Pragma("unroll") for (int m = 0; m < 4; ++m) _Pragma("unroll") for (int n = 0; n < 2; ++n) { \
        if constexpr (FP8) { asm volatile("v_mfma_f32_16x16x128_f8f6f4 %0, %1, %2, %0" : "+v"(acc[ai][bj][m][n]) : "v"(cat8(Bt[n][0], Bt[n][1])), "v"(cat8(At[m][0], At[m][1]))); } \
        else { _Pragma("unroll") for (int k = 0; k < 2; ++k) acc[ai][bj][m][n] = __builtin_amdgcn_mfma_f32_16x16x32_bf16(Bt[n][k], At[m][k], acc[ai][bj][m][n], 0, 0, 0); } } __builtin_amdgcn_s_setprio(0); } while (0)
#define PG8_WAIT_V(n) asm volatile("s_waitcnt vmcnt(" #n ")" ::: "memory")
#define PG8_WAIT_L(n) asm volatile("s_waitcnt lgkmcnt(" #n ")" ::: "memory")
#define PG8_BAR __builtin_amdgcn_s_barrier()
#if PG8_LOADPRIO
#define PG8_LP_ON __builtin_amdgcn_s_setprio(PG8_LOADPRIO)
#define PG8_LP_OFF __builtin_amdgcn_s_setprio(0)
#else
#define PG8_LP_ON do {} while (0)
#define PG8_LP_OFF do {} while (0)
#endif
#define PG8_SCHED __builtin_amdgcn_sched_barrier(0)
    Unit cur, nxt; int ui = 0;
    if (!S.next(0, cur)) return;
    f32x4 acc[2][2][4][2];
#pragma unroll
    for (int a = 0; a < 2; ++a)
#pragma unroll
        for (int b = 0; b < 2; ++b)
#pragma unroll
            for (int m = 0; m < 4; ++m)
#pragma unroll
                for (int n = 0; n < 2; ++n) acc[a][b][m][n] = (f32x4){0.f, 0.f, 0.f, 0.f};
    bf16x8 At[4][2], B0[2][2], B1[2][2];
    if constexpr (DIAG == 2 || DIAG == 3) { _Pragma("unroll") for (int i = 0; i < 4; ++i) _Pragma("unroll") for (int k = 0; k < 2; ++k) At[i][k] = (bf16x8){0,0,0,0,0,0,0,0}; _Pragma("unroll") for (int i = 0; i < 2; ++i) _Pragma("unroll") for (int k = 0; k < 2; ++k) { B0[i][k] = (bf16x8){0,0,0,0,0,0,0,0}; B1[i][k] = (bf16x8){0,0,0,0,0,0,0,0}; } }
    const char* cA = (const char*)g.A + (size_t)cur.pm * tstep; const char* cB = (const char*)g.Bt + (size_t)cur.pn * tstep;
    int kb = 0, ke = nt; if constexpr (Sched::SK) { kb = cur.kb; ke = cur.ke; }
    const char* pA = cA + (size_t)kb * kstep; const char* pB = cB + (size_t)kb * kstep;
    S.a_ready(cur);
    if constexpr (SP2) {
        PG8_STAGE(PG8_SB(0, 0), pB, voffB); PG8_STAGE(PG8_SB(0, 1), pB + hstep, voffB); PG8_STAGE(PG8_SA(0, 0), pA, voffA); PG8_STAGE(PG8_SA(0, 1), pA + hstep, voffA);
        if (wr == 1) PG8_BAR;
        PG8_WAIT_V(2); PG8_BAR;
        PG8_STAGE(PG8_SB(1, 0), pB + kstep, voffB); PG8_STAGE(PG8_SA(1, 0), pA + kstep, voffA); PG8_STAGE(PG8_SB(1, 1), pB + hstep + kstep, voffB);
        PG8_WAIT_V(6); PG8_BAR;
    } else {
        PG8_STAGE(PG8_SB(0, 0), pB, voffB); PG8_STAGE(PG8_SA(0, 0), pA, voffA); PG8_STAGE(PG8_SB(0, 1), pB + hstep, voffB); PG8_STAGE(PG8_SA(0, 1), pA + hstep, voffA);
        if (wr == 1) PG8_BAR;
        PG8_WAIT_V(4); PG8_BAR;
        PG8_STAGE(PG8_SB(1, 0), pB + kstep, voffB); PG8_STAGE(PG8_SA(1, 0), pA + kstep, voffA); PG8_STAGE(PG8_SB(1, 1), pB + hstep + kstep, voffB);
        PG8_WAIT_V(6); PG8_BAR;
    }
    for (;;) {
        const bool has_next = S.next(ui + 1, nxt);
        const char* nA0 = has_next ? (const char*)g.A + (size_t)nxt.pm * tstep : cA; const char* nB0 = has_next ? (const char*)g.Bt + (size_t)nxt.pn * tstep : cB;
        int nkb = 0; if constexpr (Sched::SK) { if (has_next) nkb = nxt.kb; }
        const char* nA = nA0 + (size_t)nkb * kstep; const char* nB = nB0 + (size_t)nkb * kstep;
        for (int t = kb; t < ke; t += 2) {
            const bool last = (t == ke - 2);
            const char* a1 = cA + (size_t)(t + 1) * kstep;
            const char* a2 = last ? nA : cA + (size_t)(t + 2) * kstep; const char* b2 = last ? nB : cB + (size_t)(t + 2) * kstep;
            const char* a3 = a2 + kstep; const char* b3 = b2 + kstep;
            if (last && has_next) S.a_ready(nxt);
            if constexpr (SP2) {
            PG8_LP_ON; PG8_LDB(B0, 0, 0); PG8_LDB(B1, 0, 1); PG8_SCHED; PG8_LDA(At, 0, 0); PG8_STAGE(PG8_SA(1, 1), a1 + hstep, voffA);
            PG8_LP_OFF; PG8_WAIT_V(8); PG8_WAIT_L(0); PG8_BAR; PG8_MMA(0, 0, At, B0); PG8_MMA(0, 1, At, B1); PG8_BAR; PG8_SCHED;
            PG8_LP_ON; PG8_LDA(At, 0, 1); PG8_STAGE(PG8_SB(0, 0), b2, voffB); PG8_STAGE(PG8_SB(0, 1), b2 + hstep, voffB); PG8_STAGE(PG8_SA(0, 0), a2, voffA);
            PG8_LP_OFF; PG8_WAIT_V(8); PG8_WAIT_L(0); PG8_BAR; PG8_MMA(1, 0, At, B0); PG8_MMA(1, 1, At, B1); PG8_BAR; PG8_SCHED;
            PG8_LP_ON; PG8_LDB(B0, 1, 0); PG8_LDB(B1, 1, 1); PG8_SCHED; PG8_LDA(At, 1, 0); PG8_STAGE(PG8_SA(0, 1), a2 + hstep, voffA);
            PG8_LP_OFF; PG8_WAIT_V(8); PG8_WAIT_L(0); PG8_BAR; PG8_MMA(0, 0, At, B0); PG8_MMA(0, 1, At, B1); PG8_BAR; PG8_SCHED;
            PG8_LP_ON; PG8_LDA(At, 1, 1); PG8_STAGE(PG8_SB(1, 0), b3, voffB); PG8_STAGE(PG8_SB(1, 1), b3 + hstep, voffB); PG8_STAGE(PG8_SA(1, 0), a3, voffA);
            PG8_LP_OFF; PG8_WAIT_V(8); PG8_WAIT_L(0); PG8_BAR; PG8_MMA(1, 0, At, B0); PG8_MMA(1, 1, At, B1); PG8_BAR; PG8_SCHED;
            } else {
            PG8_LDB(B0, 0, 0); PG8_SCHED; PG8_LDA(At, 0, 0); PG8_STAGE(PG8_SA(1, 1), a1 + hstep, voffA);
            PG8_WAIT_L(8); PG8_BAR; PG8_WAIT_L(0); PG8_MMA(0, 0, At, B0); PG8_BAR; PG8_SCHED;
            PG8_LDB(B1, 0, 1); PG8_STAGE(PG8_SB(0, 0), b2, voffB);
            PG8_BAR; PG8_WAIT_L(0); PG8_MMA(0, 1, At, B1); PG8_BAR;
            PG8_LDA(At, 0, 1); PG8_STAGE(PG8_SA(0, 0), a2, voffA);
            PG8_BAR; PG8_WAIT_L(0); PG8_MMA(1, 0, At, B0); PG8_BAR; PG8_SCHED;
            PG8_STAGE(PG8_SB(0, 1), b2 + hstep, voffB);
            PG8_WAIT_V(6); PG8_BAR; PG8_MMA(1, 1, At, B1); PG8_BAR;
            PG8_LDB(B0, 1, 0); PG8_SCHED; PG8_LDA(At, 1, 0); PG8_STAGE(PG8_SA(0, 1), a2 + hstep, voffA);
            PG8_WAIT_L(8); PG8_BAR; PG8_WAIT_L(0); PG8_MMA(0, 0, At, B0); PG8_BAR; PG8_SCHED;
            PG8_LDB(B1, 1, 1); PG8_STAGE(PG8_SB(1, 0), b3, voffB);
            PG8_BAR; PG8_WAIT_L(0); PG8_MMA(0, 1, At, B1); PG8_BAR;
            PG8_LDA(At, 1, 1); PG8_STAGE(PG8_SA(1, 0), a3, voffA);
            PG8_BAR; PG8_WAIT_L(0); PG8_MMA(1, 0, At, B0); PG8_BAR; PG8_SCHED;
            PG8_STAGE(PG8_SB(1, 1), b3 + hstep, voffB);
            PG8_WAIT_V(6); PG8_BAR; PG8_MMA(1, 1, At, B1); PG8_BAR;
            }
        }
        if constexpr (FP8) { asm volatile("s_nop 7\n\ts_nop 7" ::: "memory"); PG8_SCHED; }
        if constexpr (ALIGN_EPI) { if (wr == 0) PG8_BAR; }
        if constexpr (Sched::SK) {
            if (cur.kind == 1) S.store_partial(acc, cur, tid);
            else if (cur.kind == 0) { E(acc, cur, wr, wc, fr, fq); S.done(cur); }
        } else
        if constexpr (!Epi::AFTER_DRAIN) { E(acc, cur, wr, wc, fr, fq); S.done(cur); }
        if (!has_next) break;
#pragma unroll
        for (int a = 0; a < 2; ++a)
#pragma unroll
            for (int b = 0; b < 2; ++b)
#pragma unroll
                for (int m = 0; m < 4; ++m)
#pragma unroll
                    for (int n = 0; n < 2; ++n) acc[a][b][m][n] = (f32x4){0.f, 0.f, 0.f, 0.f};
        cur = nxt; cA = nA0; cB = nB0; ++ui; if constexpr (Sched::SK) { kb = cur.kb; ke = cur.ke; }
        if constexpr (ALIGN_EPI) { if (wr == 1) PG8_BAR; }
    }
    PG8_WAIT_V(0);
    if constexpr (!ALIGN_EPI) { if (wr == 0) PG8_BAR; }
    PG8_BAR;
    if constexpr (Epi::AFTER_DRAIN) { E.fused(acc, cur, wr, wc, fr, fq, lds, wid, lane); S.done(cur); }
    if constexpr (Sched::SK) { if (cur.kind == 2) { S.add_partial(acc, cur, tid, wid); E(acc, cur, wr, wc, fr, fq); S.done(cur); } }
#undef PG8_SA
#undef PG8_SB
#undef PG8_STAGE
#undef PG8_LDA
#undef PG8_LDB
#undef PG8_MMA
#undef PG8_WAIT_V
#undef PG8_WAIT_L
#undef PG8_BAR
#undef PG8_LP_ON
#undef PG8_LP_OFF
#undef PG8_SCHED
}
}

#ifndef PG8_SP2
#define PG8_SP2 true
#endif
#ifndef PG8_ALIGN
#define PG8_ALIGN true
#endif
#ifndef PROBE_GEMM
#define PROBE_GEMM 0
#endif
#ifndef UP_CUT
#define UP_CUT 0
#endif
#ifndef MK_PER_PHASE
#define MK_PER_PHASE 0
#endif

constexpr int NWAVES = 8;
constexpr int D = 4096, SEQ = 8192, DBATCH = 128, DSEQ = 8, MS = DBATCH * DSEQ, M = SEQ + MS;
constexpr int FF = 11008, NPROJ = 9216, NMOD = 9, MODW = NMOD * D, MODROWS = 256;
constexpr int C_K = 2048, C_V = 2560, C_GB = 3072, C_GC = 5120, C_HC = 7168;
constexpr int WIN = 128, NHEAD = 16;
constexpr float EPS = 1e-6f;
constexpr float S_H = 8.f, S_W13 = 512.f, S_T = 8.f, S_W2 = 512.f;
constexpr size_t O_YP = 0, O_YS = 33554432, O_KWP = 37748736, O_VWP = 37814272, O_CP = 37879808, O_KWS = 37883904, O_VWS = 46272512, O_CS = 54661120, O_END = 55185408;
enum { I_XP = 0, I_XS, I_CP, I_CS, I_CK, I_CV, I_SC, I_RB, I_G1, I_W1A, I_W3A, I_W2A, I_GM, I_WIN, I_SINK, I_CW, I_WOUT, I_G2, I_W1B, I_W3B, I_W2B, I_WADA, I_BADA, I_GF, N_IN };

constexpr size_t MiB = 1u << 20;
constexpr size_t al(size_t x) { return (x + MiB - 1) / MiB * MiB; }
constexpr size_t WS_CTL = 0, CTL_ZERO_BYTES = 1 * MiB;
constexpr size_t WS_W13A = 1 * MiB;
constexpr size_t WS_W2A  = WS_W13A + al((size_t)2 * FF * D * 2);
constexpr size_t WS_WIN  = WS_W2A + al((size_t)D * FF * 2);
constexpr size_t WS_WOUT = WS_WIN + al((size_t)NPROJ * D * 2);
constexpr size_t WS_W13B = WS_WOUT + al((size_t)D * D * 2);
constexpr size_t WS_W2B  = WS_W13B + al((size_t)2 * FF * D * 2);
constexpr size_t WS_WADA = WS_W2B + al((size_t)D * FF * 2);
constexpr size_t WS_CSI  = WS_WADA + al((size_t)MODW * D * 2);
constexpr size_t WS_MOD  = WS_CSI + al((size_t)MODROWS * D * 2);
constexpr size_t WS_X1   = WS_MOD + al((size_t)MODROWS * MODW * 4);
constexpr size_t WS_H    = WS_X1 + al((size_t)M * D * 4);
constexpr size_t WS_T    = WS_H + al((size_t)M * D * 2);
constexpr size_t WS_PROJ = WS_T + al((size_t)M * FF * 2);
constexpr size_t WS_MIX  = WS_PROJ + al((size_t)M * NPROJ * 2);
constexpr size_t WS_PART = WS_MIX + al((size_t)M * D * 2);
constexpr size_t WS_SKS  = WS_PART + al((size_t)4 * (DBATCH + 1) * 12288 * 4);
constexpr size_t WS_SKS2 = WS_SKS + (size_t)256 * 262144;
constexpr size_t WS_END  = WS_SKS2 + (size_t)256 * 262144;
constexpr int CW_TMO = 0, CW_CODE = 1, CW_BAR = 4096;
constexpr int CW_SK = 16384, CW_SK_STRIDE = 16384;
constexpr int CW_MODC = CW_SK + 4 * CW_SK_STRIDE;
static_assert((size_t)(CW_SK + 8 * CW_SK_STRIDE) * 4 <= CTL_ZERO_BYTES && CW_MODC + 64 * 144 <= CW_SK + 8 * CW_SK_STRIDE, "stream-K / adaLN counters inside the zeroed control region");

constexpr int RING_OFF = 0, RING_BYTES = 131072;
constexpr int SKLIST_OFF = 131072;
constexpr int LDSCTL_OFF = 143360, MISC_OFF = LDSCTL_OFF + 320;
constexpr int LDS_BYTES = 147456;
static_assert(MISC_OFF + 128 <= LDS_BYTES, "LDS map");

#define GAS __attribute__((address_space(1)))
#define LAS __attribute__((address_space(3)))
typedef unsigned short bf16;
typedef unsigned v4u __attribute__((ext_vector_type(4)));
typedef unsigned v2u __attribute__((ext_vector_type(2)));
typedef float f32x4 __attribute__((ext_vector_type(4)));
typedef float f32x16 __attribute__((ext_vector_type(16)));
typedef short bf16x8 __attribute__((ext_vector_type(8)));
typedef GAS unsigned gu32;
#define RLX_AGENT __ATOMIC_RELAXED, __HIP_MEMORY_SCOPE_AGENT
#define LDS_WAIT() asm volatile("s_waitcnt lgkmcnt(0)" ::: "memory")
#define VM_WAIT() asm volatile("s_waitcnt vmcnt(0)" ::: "memory")
__device__ __forceinline__ unsigned f2bf(float f) { unsigned u = __builtin_bit_cast(unsigned, f); return (u + 0x7fffu + ((u >> 16) & 1u)) >> 16; }
__device__ __forceinline__ unsigned pk2(float lo, float hi) { return f2bf(lo) | (f2bf(hi) << 16); }
__device__ __forceinline__ float bf_lo(unsigned w) { return __builtin_bit_cast(float, w << 16); }
__device__ __forceinline__ float bf_hi(unsigned w) { return __builtin_bit_cast(float, w & 0xffff0000u); }

#define XB_TMO      128
#define XB_XCNT(j)  (256  + 64 * (j))
#define XB_XSUB(j)  (1280 + 64 * (j))
#define XB_XGEN(j)  (2304 + 64 * (j))
#define XB_TOP      3328
#define XB_TOPGEN   3392
#define XCD_BAR_WORDS 3456
#define XB_SPIN_CAP (1u << 18)

__device__ __forceinline__ unsigned xb_ld(unsigned* p)              { return __hip_atomic_load(p, __ATOMIC_RELAXED, __HIP_MEMORY_SCOPE_AGENT); }
__device__ __forceinline__ unsigned xb_add(unsigned* p, unsigned v) { return __hip_atomic_fetch_add(p, v, __ATOMIC_RELAXED, __HIP_MEMORY_SCOPE_AGENT); }
__device__ __forceinline__ unsigned xb_xcc_id() { return (unsigned)__builtin_amdgcn_s_getreg((3 << 11) | 20) & 0xFu; }
#define XB_SPIN(cond, bar) do { unsigned _sp = 0; while (cond) { __builtin_amdgcn_s_sleep(1); \
    if ((++_sp & 255u) == 0u) { if (xb_ld(&(bar)[XB_TMO])) break; if (_sp > XB_SPIN_CAP) { atomicAdd(&(bar)[XB_TMO], 1u); break; } } } } while (0)

struct XcdBarrier {
    unsigned* bar; unsigned x;
    volatile LAS unsigned* st;
};

__device__ __forceinline__ XcdBarrier xcd_barrier_post(unsigned* bar, volatile LAS unsigned* st) {
    XcdBarrier b; b.bar = bar; b.x = xb_xcc_id(); b.st = st;
    if (threadIdx.x == 0) (void)xb_add(&bar[XB_XCNT(b.x)], 1u);
    return b;
}
__device__ __forceinline__ void xcd_barrier_complete(unsigned* bar, unsigned x, unsigned& nloc, unsigned& nx) {
    const unsigned G = gridDim.x * gridDim.y * gridDim.z;
    unsigned sum, cnt, mine, sp = 0u;
    for (;;) {
        sum = 0u; cnt = 0u; mine = 0u;
#pragma unroll
        for (unsigned j = 0; j < 16; ++j) { const unsigned c = xb_ld(&bar[XB_XCNT(j)]); sum += c; cnt += (c > 0u) ? 1u : 0u; mine = (j == x) ? c : mine; }
        if (sum == G) break;
        __builtin_amdgcn_s_sleep(1);
        if ((++sp & 255u) == 0u) { if (xb_ld(&bar[XB_TMO])) break; if (sp > XB_SPIN_CAP) { atomicAdd(&bar[XB_TMO], 1u); break; } }
    }
    nloc = mine > 0u ? mine : 1u; nx = cnt > 0u ? cnt : 1u;
}

__device__ __forceinline__ void xcd_barrier(const XcdBarrier& b) {
    asm volatile("s_waitcnt vmcnt(0)" ::: "memory");
    __syncthreads();
    if (threadIdx.x == 0) {
        unsigned* bar = b.bar;
        __builtin_amdgcn_s_waitcnt(0);
        unsigned nloc = b.st[0], nx = b.st[1];
        if (nloc == 0u) { xcd_barrier_complete(bar, b.x, nloc, nx); b.st[0] = nloc; b.st[1] = nx; }
        const unsigned old = xb_add(&bar[XB_XSUB(b.x)], 1u);
        const unsigned gen = old / nloc;
        if (old + 1u == (gen + 1u) * nloc) {
            __builtin_amdgcn_fence(__ATOMIC_RELEASE, "agent");
            asm volatile("s_waitcnt vmcnt(0)" ::: "memory");
            const unsigned og = xb_add(&bar[XB_TOP], 1u);
            const unsigned tg = og / nx;
            if (og + 1u == (tg + 1u) * nx) xb_add(&bar[XB_TOPGEN], 1u);
            else XB_SPIN(xb_ld(&bar[XB_TOPGEN]) == tg, bar);
            __builtin_amdgcn_fence(__ATOMIC_ACQUIRE, "agent");
            xb_add(&bar[XB_XGEN(b.x)], 1u);
            asm volatile("s_waitcnt vmcnt(0)" ::: "memory");
        } else {
            XB_SPIN(xb_ld(&bar[XB_XGEN(b.x)]) == gen, bar);
            __builtin_amdgcn_fence(__ATOMIC_ACQUIRE, "agent");
            asm volatile("s_waitcnt vmcnt(0)" ::: "memory");
        }
    }
    __syncthreads();
}


struct Frame {
    LAS unsigned char* lds;
    volatile LAS unsigned* MISC;
    gu32* ctl;
    int tid, lane, wave;
    int vcu, G;
};
__device__ __forceinline__ float wave_sum(float v) {
#pragma unroll
    for (int o = 1; o < 64; o <<= 1) v += __shfl_xor(v, o);
    return v;
}
template <int MODE>
__device__ __forceinline__ void p0_transpose_item(const float* W, int K, int N, bf16* WT, LAS float* scr, int item, int lane) {
    const int nblk = N / 32, kb = item / nblk, nb = item % nblk, k0 = 64 * kb, n0 = 32 * nb;
    const GAS float* Wg = (const GAS float*)W;
    float ld[32];
#pragma unroll
    for (int i = 0; i < 32; ++i) { const int kk = 2 * i + (lane >> 5); ld[i] = __builtin_nontemporal_load(&Wg[(size_t)(k0 + kk) * N + n0 + (lane & 31)]); }
#pragma unroll
    for (int i = 0; i < 32; ++i) { const int kk = 2 * i + (lane >> 5); scr[kk * 33 + (lane & 31)] = ld[i]; }
    LDS_WAIT(); asm volatile("" ::: "memory");
    const int c = lane & 7;
    const int r0 = (MODE == 0) ? n0 : (n0 / 128) * 256 + (n0 % 128) + (MODE == 2 ? 128 : 0);
#pragma unroll
    for (int j = 0; j < 4; ++j) { const int n = (lane >> 3) + 8 * j; const LAS float* s = scr + (8 * c) * 33 + n;
        v4u o; o.x = pg8::cvt_pk_bf16(s[0 * 33], s[1 * 33]); o.y = pg8::cvt_pk_bf16(s[2 * 33], s[3 * 33]); o.z = pg8::cvt_pk_bf16(s[4 * 33], s[5 * 33]); o.w = pg8::cvt_pk_bf16(s[6 * 33], s[7 * 33]);
        *(GAS v4u*)(WT + (size_t)(r0 + n) * K + k0 + 8 * c) = o; }
    LDS_WAIT(); asm volatile("" ::: "memory");
}

template <int MODE>
__device__ __forceinline__ void p0_transpose_item8(const float* W, int K, int N, unsigned char* WT, float scale, LAS float* scr, int item, int lane) {
    const int nblk = N / 32, kb = item / nblk, nb = item % nblk, k0 = 128 * kb, n0 = 32 * nb;
    const GAS float* Wg = (const GAS float*)W;
#pragma unroll
    for (int h2 = 0; h2 < 2; ++h2) { float ld[32];
#pragma unroll
        for (int i = 0; i < 32; ++i) { const int kk = 2 * (i + 32 * h2) + (lane >> 5); ld[i] = __builtin_nontemporal_load(&Wg[(size_t)(k0 + kk) * N + n0 + (lane & 31)]); }
#pragma unroll
        for (int i = 0; i < 32; ++i) { const int kk = 2 * (i + 32 * h2) + (lane >> 5); scr[kk * 33 + (lane & 31)] = ld[i]; } }
    LDS_WAIT(); asm volatile("" ::: "memory");
    const int n = lane & 31, hf = lane >> 5;
    const int r0 = (MODE == 0) ? n0 : (n0 / 128) * 256 + (n0 % 128) + (MODE == 2 ? 128 : 0);
#pragma unroll
    for (int p = 0; p < 4; ++p) { const int q = 2 * p + hf; const LAS float* s = scr + (16 * q) * 33 + n;
        v4u o;
        o.x = pg8::cvt4_fp8(s[0 * 33] * scale, s[1 * 33] * scale, s[2 * 33] * scale, s[3 * 33] * scale);
        o.y = pg8::cvt4_fp8(s[4 * 33] * scale, s[5 * 33] * scale, s[6 * 33] * scale, s[7 * 33] * scale);
        o.z = pg8::cvt4_fp8(s[8 * 33] * scale, s[9 * 33] * scale, s[10 * 33] * scale, s[11 * 33] * scale);
        o.w = pg8::cvt4_fp8(s[12 * 33] * scale, s[13 * 33] * scale, s[14 * 33] * scale, s[15 * 33] * scale);
        *(GAS v4u*)(WT + (size_t)(r0 + n) * K + k0 + 16 * q) = o; }
    LDS_WAIT(); asm volatile("" ::: "memory");
}

struct Args { const float* in[N_IN]; float* out; unsigned char* ws; int ph_lo, ph_hi; };

enum { JOB_W1A = 0, JOB_W3A, JOB_W2A, JOB_WIN, JOB_WOUT, JOB_W1B, JOB_W3B, JOB_W2B };
template <int JOB>
__device__ __forceinline__ void conv_job(Frame& F, const Args& A, int rank, int nw) {
    LAS float* scr = (LAS float*)(F.lds + RING_OFF + F.wave * 16896);
    unsigned char* ws = A.ws;
    constexpr int I_13 = (D / 128) * (FF / 32), I_2 = (FF / 128) * (D / 32), I_IN = (D / 64) * (NPROJ / 32), I_OUT = (D / 64) * (D / 32);
    constexpr int N = (JOB == JOB_W1A || JOB == JOB_W3A || JOB == JOB_W1B || JOB == JOB_W3B) ? I_13 : (JOB == JOB_W2A || JOB == JOB_W2B) ? I_2 : (JOB == JOB_WIN) ? I_IN : I_OUT;
    for (int it = rank; it < N; it += nw) {
        if constexpr (JOB == JOB_W1A) p0_transpose_item8<1>(A.in[I_W1A], D, FF, ws + WS_W13A, S_W13, scr, it, F.lane);
        if constexpr (JOB == JOB_W3A) p0_transpose_item8<2>(A.in[I_W3A], D, FF, ws + WS_W13A, S_W13, scr, it, F.lane);
        if constexpr (JOB == JOB_W2A) p0_transpose_item8<0>(A.in[I_W2A], FF, D, ws + WS_W2A, S_W2, scr, it, F.lane);
        if constexpr (JOB == JOB_WIN) p0_transpose_item<0>(A.in[I_WIN], D, NPROJ, (bf16*)(ws + WS_WIN), scr, it, F.lane);
        if constexpr (JOB == JOB_WOUT) p0_transpose_item<0>(A.in[I_WOUT], D, D, (bf16*)(ws + WS_WOUT), scr, it, F.lane);
        if constexpr (JOB == JOB_W1B) p0_transpose_item8<1>(A.in[I_W1B], D, FF, ws + WS_W13B, S_W13, scr, it, F.lane);
        if constexpr (JOB == JOB_W3B) p0_transpose_item8<2>(A.in[I_W3B], D, FF, ws + WS_W13B, S_W13, scr, it, F.lane);
        if constexpr (JOB == JOB_W2B) p0_transpose_item8<0>(A.in[I_W2B], FF, D, ws + WS_W2B, S_W2, scr, it, F.lane);
    }
}
__device__ __forceinline__ void csilu_phase(Frame& F, const Args& A) {
    const int gt = (F.vcu * NWAVES + F.wave) * 64 + F.lane, NGT = F.G * NWAVES * 64;
    bf16* cs = (bf16*)(A.ws + WS_CSI);
    for (int it = gt; it < 144 * D / 8; it += NGT) {
        const int row = it / (D / 8), c8 = (it % (D / 8)) * 8;
        v4u o = (v4u){0u, 0u, 0u, 0u};
        if (row <= DBATCH) {
            const float* src = (row == 0) ? A.in[I_CP] + c8 : A.in[I_CS] + (size_t)(row - 1) * D + c8;
            const f32x4 a = *(const GAS f32x4*)src, b = *(const GAS f32x4*)(src + 4);
            float v[8] = {a[0], a[1], a[2], a[3], b[0], b[1], b[2], b[3]};
#pragma unroll
            for (int j = 0; j < 8; ++j) v[j] = v[j] / (1.0f + __expf(-v[j]));
            o.x = pk2(v[0], v[1]); o.y = pk2(v[2], v[3]); o.z = pk2(v[4], v[5]); o.w = pk2(v[6], v[7]);
        }
        *(GAS v4u*)(cs + ((size_t)((c8 >> 5) * 9 + (row >> 4)) * 64 + ((c8 & 31) >> 3) * 16 + (row & 15)) * 8) = o;
    }
}
constexpr int MODI_SB = 2560, MODI_A_OFF = 8 * MODI_SB, MODI_A_BYTES = 9216;
__device__ __forceinline__ void mod_item256(Frame& F, const Args& A, int cg, int k0, int nsteps, float* dst, int ldd, int dcol0, const float* bias) {
    const int lane = F.lane, w = F.wave, n0 = 256 * cg + 32 * w, tid = F.tid;
    LAS unsigned char* sb = F.lds + w * MODI_SB;
    LAS unsigned char* la = F.lds + MODI_A_OFF;
    const bf16* CS = (const bf16*)(A.ws + WS_CSI);
    const int kp = lane >> 3, a8 = lane & 7, n4 = 4 * a8;
    const GAS char* Wb = (const GAS char*)(A.in[I_WADA] + (size_t)k0 * MODW + n0);
    const unsigned wlo = (unsigned)((2 * kp) * MODW + n4) * 4u;
    const GAS char* Cb = (const GAS char*)CS + (size_t)(k0 / 32) * 9216;
    const unsigned c1 = (unsigned)tid * 16u, c2 = (unsigned)(512 + (tid & 63)) * 16u;
    f32x4 acc[9][2];
#pragma unroll
    for (int mt = 0; mt < 9; ++mt)
#pragma unroll
        for (int j = 0; j < 2; ++j) acc[mt][j] = (f32x4){0.f, 0.f, 0.f, 0.f};
    f32x4 buf[2][4];
    v4u ar[2][2];
#define MODI_LOAD(b, s) do { _Pragma("unroll") for (int i = 0; i < 4; ++i) buf[b][i] = __builtin_nontemporal_load((const GAS f32x4*)(Wb + (size_t)(32 * (s) + 16 * (i >> 1) + (i & 1)) * (MODW * 4) + wlo)); } while (0)
#define MODI_ALOAD(r, s) do { const int s_ = (s) < nsteps ? (s) : nsteps - 1; ar[r][0] = *(const GAS v4u*)(Cb + (size_t)s_ * 9216 + c1); ar[r][1] = *(const GAS v4u*)(Cb + (size_t)s_ * 9216 + c2); } while (0)
#define MODI_AWRITE(r, s) do { *(LAS v4u*)(la + ((s) & 1) * MODI_A_BYTES + c1) = ar[r][0]; *(LAS v4u*)(la + ((s) & 1) * MODI_A_BYTES + c2) = ar[r][1]; } while (0)
    __syncthreads();
    MODI_ALOAD(0, 0); MODI_ALOAD(1, 1);
    MODI_LOAD(0, 0); MODI_LOAD(1, 1);
    MODI_AWRITE(0, 0);
    MODI_ALOAD(0, 2);
    __syncthreads();
#pragma unroll 1
    for (int s4 = 0; s4 < nsteps; s4 += 2) {
#pragma unroll
        for (int b = 0; b < 2; ++b) { const int s = s4 + b;
#pragma unroll
            for (int ip = 0; ip < 2; ++ip)
#pragma unroll
                for (int e = 0; e < 4; ++e) { const int n = n4 + e, k = 2 * kp + 16 * ip;
                    *(LAS unsigned*)(sb + n * 80 + (((k >> 3) ^ (a8 & 3)) * 16) + (k & 7) * 2) = pg8::cvt_pk_bf16(buf[b][2 * ip][e], buf[b][2 * ip + 1][e]); }
            asm volatile("" ::: "memory");
            { const int sn = (s + 2 < nsteps) ? s + 2 : nsteps - 1; MODI_LOAD(b, sn); }
            asm volatile("" ::: "memory");
            bf16x8 bfr[2];
#pragma unroll
            for (int j = 0; j < 2; ++j) { const int n = 16 * j + (lane & 15); bfr[j] = *(const LAS bf16x8*)(sb + n * 80 + (((lane >> 4) ^ ((n >> 2) & 3)) * 16)); }
#pragma unroll
            for (int mg = 0; mg < 3; ++mg) { bf16x8 af[3];
#pragma unroll
                for (int i = 0; i < 3; ++i) af[i] = *(const LAS bf16x8*)(la + (s & 1) * MODI_A_BYTES + (3 * mg + i) * 1024 + lane * 16);
#pragma unroll
                for (int i = 0; i < 3; ++i)
#pragma unroll
                    for (int j = 0; j < 2; ++j) acc[3 * mg + i][j] = __builtin_amdgcn_mfma_f32_16x16x32_bf16(af[i], bfr[j], acc[3 * mg + i][j], 0, 0, 0);
                asm volatile("" ::: "memory"); }
            MODI_AWRITE((b + 1) & 1, s + 1);
            asm volatile("" ::: "memory");
            MODI_ALOAD((b + 1) & 1, s + 3);
            __syncthreads();
        }
    }
#undef MODI_LOAD
#undef MODI_ALOAD
#undef MODI_AWRITE
    const int c0 = 32 * w + (lane & 15);
#pragma unroll
    for (int j = 0; j < 2; ++j) { const float bv = bias ? bias[256 * cg + c0 + 16 * j] : 0.f;
#pragma unroll
        for (int mt = 0; mt < 9; ++mt)
#pragma unroll
            for (int r = 0; r < 4; ++r) { const int row = 16 * mt + 4 * (lane >> 4) + r;
                if (row <= DBATCH) dst[(size_t)row * ldd + dcol0 + c0 + 16 * j] = acc[mt][j][r] + bv; } }
    LDS_WAIT();
}
__device__ __forceinline__ void mod_group_finish(Frame& F, const Args& A, int chunk, int cg) {
    asm volatile("s_waitcnt vmcnt(0)" ::: "memory");
    __syncthreads();
    if (threadIdx.x == 0) {
        __builtin_amdgcn_fence(__ATOMIC_RELEASE, "agent");
        asm volatile("s_waitcnt vmcnt(0)" ::: "memory");
        const unsigned old = __hip_atomic_fetch_add((unsigned*)(F.ctl + CW_MODC + 64 * (48 * chunk + cg)), 1u, __ATOMIC_RELAXED, __HIP_MEMORY_SCOPE_AGENT);
        if (old == 3u) { __builtin_amdgcn_fence(__ATOMIC_ACQUIRE, "agent"); asm volatile("s_waitcnt vmcnt(0)" ::: "memory"); }
        F.MISC[0] = (old == 3u) ? 1u : 0u;
    }
    __syncthreads();
    if (F.MISC[0] != 0u) {
        const float* PART = (const float*)(A.ws + WS_PART); float* MOD = (float*)(A.ws + WS_MOD);
        constexpr size_t PS = (size_t)(DBATCH + 1) * 12288;
#pragma unroll 1
        for (int i = threadIdx.x; i < (DBATCH + 1) * 64; i += NWAVES * 64) { const int r = i >> 6, c = 256 * cg + 4 * (i & 63);
            const float* p = PART + (size_t)r * 12288 + c;
            const f32x4 s = (*(const GAS f32x4*)p + *(const GAS f32x4*)(p + PS)) + (*(const GAS f32x4*)(p + 2 * PS) + *(const GAS f32x4*)(p + 3 * PS));
            *(GAS f32x4*)(MOD + (size_t)r * MODW + 12288 * chunk + c) = s + *(const GAS f32x4*)(A.in[I_BADA] + 12288 * chunk + c); }
    }
    __syncthreads();
}
__device__ __forceinline__ void mod_chunk_partials(Frame& F, const Args& A, int chunk, int rank, int nwg) {
#pragma unroll 1
    for (int it = rank; it < 192; it += nwg) {
        mod_item256(F, A, 48 * chunk + (it >> 2), 1024 * (it & 3), 32, (float*)(A.ws + WS_PART) + (size_t)(it & 3) * ((size_t)(DBATCH + 1) * 12288), 12288, 256 * (it >> 2), nullptr);
        mod_group_finish(F, A, chunk, it >> 2);
    }
}

template <bool FP8OUT>
__device__ __forceinline__ void normmod_store(bf16* H, int m, int lane, int j, f32x4 h) {
    if constexpr (FP8OUT) { ((GAS unsigned*)((unsigned char*)H + (size_t)m * D) + lane)[64 * j] = pg8::cvt4_fp8(h.x * S_H, h.y * S_H, h.z * S_H, h.w * S_H); }
    else { v2u w; w.x = pg8::cvt_pk_bf16(h.x, h.y); w.y = pg8::cvt_pk_bf16(h.z, h.w); ((GAS v2u*)(H + (size_t)m * D) + lane)[64 * j] = w; }
}
template <bool XBF16> __device__ __forceinline__ f32x4 ldx4(const void* rowp, int q) {
    if constexpr (XBF16) { const v2u w = ((const GAS v2u*)rowp)[q]; return (f32x4){bf_lo(w.x), bf_hi(w.x), bf_lo(w.y), bf_hi(w.y)}; }
    else return ((const GAS f32x4*)rowp)[q];
}
template <bool XBF16> __device__ __forceinline__ const void* xrowp(const void* base, size_t r) { if constexpr (XBF16) return (const bf16*)base + r * D; else return (const float*)base + r * D; }
template <bool FP8OUT, bool XBF16>
__device__ __forceinline__ void normmod_phase(Frame& F, const void* xp, const void* xs, const float* g, const float* mod, int ish, int isc, bf16* H) {
    const int gw = F.vcu * NWAVES + F.wave, NGW = F.G * NWAVES, lane = F.lane;
    LAS f32x4* lgs = (LAS f32x4*)F.lds; LAS f32x4* lsh = (LAS f32x4*)(F.lds + D * 4);
    for (int i = F.tid; i < D / 4; i += NWAVES * 64) { const f32x4 gg = *((const GAS f32x4*)g + i), sc = *((const GAS f32x4*)(mod + (size_t)isc * D) + i);
        lgs[i] = gg * (sc + 1.0f); lsh[i] = *((const GAS f32x4*)(mod + (size_t)ish * D) + i); }
    __syncthreads();
    if (gw < SEQ) {
        f32x4 cur[16], nx[16];
#pragma unroll
        for (int j = 0; j < 16; ++j) cur[j] = ldx4<XBF16>(xrowp<XBF16>(xp, (size_t)gw), lane + 64 * j);
#pragma unroll 1
        for (int m = gw; m < SEQ; m += NGW) {
            asm volatile("" ::: "memory");
            const int mn = (m + NGW < SEQ) ? m + NGW : m;
#pragma unroll
            for (int j = 0; j < 16; ++j) nx[j] = ldx4<XBF16>(xrowp<XBF16>(xp, (size_t)mn), lane + 64 * j);
            float s = 0.f;
#pragma unroll
            for (int j = 0; j < 16; ++j) s += (cur[j].x * cur[j].x + cur[j].y * cur[j].y) + (cur[j].z * cur[j].z + cur[j].w * cur[j].w);
            const float rstd = 1.0f / sqrtf(wave_sum(s) * (1.f / D) + EPS);
#pragma unroll
            for (int j = 0; j < 16; ++j) normmod_store<FP8OUT>(H, m, lane, j, (cur[j] * rstd) * lgs[lane + 64 * j] + lsh[lane + 64 * j]);
#pragma unroll
            for (int j = 0; j < 16; ++j) cur[j] = nx[j];
        }
    }
    for (int m = SEQ + gw; m < M; m += NGW) {
        const float* mrow = mod + (size_t)(1 + ((m - SEQ) >> 3)) * MODW;
        const void* xr = xrowp<XBF16>(xs, (size_t)(m - SEQ));
        f32x4 v[16]; float s = 0.f;
#pragma unroll
        for (int j = 0; j < 16; ++j) { v[j] = ldx4<XBF16>(xr, lane + 64 * j); s += (v[j].x * v[j].x + v[j].y * v[j].y) + (v[j].z * v[j].z + v[j].w * v[j].w); }
        const float rstd = 1.0f / sqrtf(wave_sum(s) * (1.f / D) + EPS);
        const GAS f32x4* gr = (const GAS f32x4*)g + lane;
        const GAS f32x4* shr = (const GAS f32x4*)(mrow + (size_t)ish * D) + lane;
        const GAS f32x4* scr = (const GAS f32x4*)(mrow + (size_t)isc * D) + lane;
#pragma unroll
        for (int j = 0; j < 16; ++j) { const f32x4 gg = gr[64 * j], sh = shr[64 * j], sc = scr[64 * j];
            normmod_store<FP8OUT>(H, m, lane, j, (v[j] * rstd) * gg * (sc + 1.0f) + sh); }
    }
    __syncthreads();
}
__device__ __forceinline__ void final_norm_phase(Frame& F, const bf16* X1, const float* g, float* out) {
    const int gw = F.vcu * NWAVES + F.wave, NGW = F.G * NWAVES, lane = F.lane;
    LAS f32x4* lg = (LAS f32x4*)F.lds;
    for (int i = F.tid; i < D / 4; i += NWAVES * 64) lg[i] = *((const GAS f32x4*)g + i);
    __syncthreads();
    if (gw >= M) return;
    f32x4 cur[16], nx[16];
#pragma unroll
    for (int j = 0; j < 16; ++j) cur[j] = ldx4<true>(X1 + (size_t)gw * D, lane + 64 * j);
#pragma unroll 1
    for (int m = gw; m < M; m += NGW) {
        asm volatile("" ::: "memory");
        const int mn = (m + NGW < M) ? m + NGW : m;
#pragma unroll
        for (int j = 0; j < 16; ++j) nx[j] = ldx4<true>(X1 + (size_t)mn * D, lane + 64 * j);
        float s = 0.f;
#pragma unroll
        for (int j = 0; j < 16; ++j) s += (cur[j].x * cur[j].x + cur[j].y * cur[j].y) + (cur[j].z * cur[j].z + cur[j].w * cur[j].w);
        const float rstd = 1.0f / sqrtf(wave_sum(s) * (1.f / D) + EPS);
        GAS f32x4* o = (GAS f32x4*)(out + ((m < SEQ) ? O_YP + (size_t)m * D : O_YS + (size_t)(m - SEQ) * D)) + lane;
#pragma unroll
        for (int j = 0; j < 16; ++j) o[64 * j] = (cur[j] * rstd) * lg[lane + 64 * j];
#pragma unroll
        for (int j = 0; j < 16; ++j) cur[j] = nx[j];
    }
}

namespace att {
constexpr int KROW = 272, VROW = 528;
constexpr int K_OFF = 0, V_OFF = 256 * KROW, LUT_OFF = V_OFF + 128 * VROW, LUT_STRIDE = 132;
constexpr int ATT_LDS = LUT_OFF + 4 * LUT_STRIDE * 4;
static_assert(ATT_LDS <= LDSCTL_OFF, "attention LDS image below the control words");
constexpr float SCALE = 0.08838834764831845f;
__device__ __forceinline__ int t5_bucket(int n) {
    if (n < 16) return n;
    int b = 16;
    b += (n >= 19); b += (n >= 21); b += (n >= 24); b += (n >= 27); b += (n >= 31); b += (n >= 35); b += (n >= 40); b += (n >= 46);
    b += (n >= 52); b += (n >= 59); b += (n >= 67); b += (n >= 77); b += (n >= 87); b += (n >= 99); b += (n >= 113);
    return b;
}
__device__ __forceinline__ int vslot(int kidx) { return (kidx & ~15) | (8 * ((kidx >> 2) & 1) + 4 * ((kidx >> 3) & 1) + (kidx & 3)); }
__device__ __forceinline__ void fill_lut(LAS unsigned char* lds, const float* rel_bias, int hk, int tid) {
    LAS float* lut = (LAS float*)(lds + LUT_OFF);
    for (int i = tid; i < 4 * 129; i += NWAVES * 64) { const int g = i / 129, dist = i % 129; lut[g * LUT_STRIDE + dist] = rel_bias[t5_bucket(dist) * NHEAD + 4 * hk + g]; }
}
template <int NT>
__device__ __forceinline__ void attn_qtile(const LAS unsigned char* lds, int ktile0, const bf16x8 (&Q)[8], int r, int kmin, int kmax, int g, float sink, bf16* orow, int lane) {
    const int c = lane & 31, h = lane >> 5;
    f32x16 X[NT];
#pragma unroll
    for (int t = 0; t < NT; ++t) {
#pragma unroll
        for (int i = 0; i < 16; ++i) X[t][i] = 0.f;
#pragma unroll
        for (int ks = 0; ks < 8; ++ks) { const bf16x8 kf = *(const LAS bf16x8*)(lds + K_OFF + (32 * (ktile0 + t) + c) * KROW + (16 * ks + 8 * h) * 2);
            X[t] = __builtin_amdgcn_mfma_f32_32x32x16_bf16(kf, Q[ks], X[t], 0, 0, 0); }
    }
    const LAS float* lut = (const LAS float*)(lds + LUT_OFF) + g * LUT_STRIDE;
    float mx = sink;
#pragma unroll
    for (int t = 0; t < NT; ++t)
#pragma unroll
        for (int i = 0; i < 16; ++i) { const int kidx = 32 * (ktile0 + t) + (i & 3) + 8 * (i >> 2) + 4 * h; const int dist = 128 + r - kidx;
            const bool valid = (dist >= 0) && (dist <= 128) && (kidx >= kmin) && (kidx < kmax);
            const int di = dist < 0 ? 0 : (dist > 128 ? 128 : dist);
            float s = X[t][i] * SCALE + lut[di]; s = valid ? s : -1e30f; X[t][i] = s; mx = fmaxf(mx, s); }
    mx = fmaxf(mx, __shfl_xor(mx, 32));
    float sum = 0.f;
#pragma unroll
    for (int t = 0; t < NT; ++t)
#pragma unroll
        for (int i = 0; i < 16; ++i) { const float p = __expf(X[t][i] - mx); X[t][i] = p; sum += p; }
    sum += __shfl_xor(sum, 32);
    const float inv = 1.0f / (sum + __expf(sink - mx));
    f32x16 O[4];
#pragma unroll
    for (int dt = 0; dt < 4; ++dt)
#pragma unroll
        for (int i = 0; i < 16; ++i) O[dt][i] = 0.f;
#pragma unroll
    for (int t = 0; t < NT; ++t)
#pragma unroll
        for (int s = 0; s < 2; ++s) {
            v4u pw; pw.x = pg8::cvt_pk_bf16(X[t][8 * s + 0], X[t][8 * s + 1]); pw.y = pg8::cvt_pk_bf16(X[t][8 * s + 2], X[t][8 * s + 3]);
            pw.z = pg8::cvt_pk_bf16(X[t][8 * s + 4], X[t][8 * s + 5]); pw.w = pg8::cvt_pk_bf16(X[t][8 * s + 6], X[t][8 * s + 7]);
            const bf16x8 pf = __builtin_bit_cast(bf16x8, pw);
#pragma unroll
            for (int dt = 0; dt < 4; ++dt) { const bf16x8 vf = *(const LAS bf16x8*)(lds + V_OFF + (32 * dt + c) * VROW + (32 * (ktile0 + t) + 16 * s + 8 * h) * 2);
                O[dt] = __builtin_amdgcn_mfma_f32_32x32x16_bf16(vf, pf, O[dt], 0, 0, 0); }
        }
#pragma unroll
    for (int dt = 0; dt < 4; ++dt)
#pragma unroll
        for (int i = 0; i < 4; ++i) { v2u w; w.x = pk2(O[dt][4 * i + 0] * inv, O[dt][4 * i + 1] * inv); w.y = pk2(O[dt][4 * i + 2] * inv, O[dt][4 * i + 3] * inv);
            *(GAS v2u*)(orow + 32 * dt + 8 * i + 4 * h) = w; }
}
__device__ __forceinline__ void stage_kv(LAS unsigned char* lds, int kidx, int ch, v4u kq, v4u vq) {
    *(LAS v4u*)(lds + K_OFF + kidx * KROW + ch * 16) = kq;
    LAS unsigned short* vt = (LAS unsigned short*)(lds + V_OFF + (8 * ch) * VROW) + vslot(kidx);
    vt[0 * (VROW / 2)] = (unsigned short)(vq.x & 0xffffu); vt[1 * (VROW / 2)] = (unsigned short)(vq.x >> 16);
    vt[2 * (VROW / 2)] = (unsigned short)(vq.y & 0xffffu); vt[3 * (VROW / 2)] = (unsigned short)(vq.y >> 16);
    vt[4 * (VROW / 2)] = (unsigned short)(vq.z & 0xffffu); vt[5 * (VROW / 2)] = (unsigned short)(vq.z >> 16);
    vt[6 * (VROW / 2)] = (unsigned short)(vq.w & 0xffffu); vt[7 * (VROW / 2)] = (unsigned short)(vq.w >> 16);
}
__device__ __forceinline__ void store8_f32(float* dst, v4u q) {
    *(GAS f32x4*)dst = (f32x4){bf_lo(q.x), bf_hi(q.x), bf_lo(q.y), bf_hi(q.y)};
    *(GAS f32x4*)(dst + 4) = (f32x4){bf_lo(q.z), bf_hi(q.z), bf_lo(q.w), bf_hi(q.w)};
}
__device__ __forceinline__ void prompt_unit(Frame& F, const Args& A, int b, int hk) {
    const bf16* PROJ = (const bf16*)(A.ws + WS_PROJ); bf16* MIX = (bf16*)(A.ws + WS_MIX);
    LAS unsigned char* lds = F.lds;
    fill_lut(lds, A.in[I_RB], hk, F.tid);
    v4u kqa[8], vqa[8];
#pragma unroll
    for (int i = 0; i < 8; ++i) { const int cid = F.tid + 512 * i, kidx = cid >> 4, ch = cid & 15; const int row = 128 * (b - 1) + kidx, rowc = row < 0 ? 0 : row;
        const bf16* p = PROJ + (size_t)rowc * NPROJ + 128 * hk + 8 * ch; kqa[i] = *(const GAS v4u*)(p + C_K); vqa[i] = *(const GAS v4u*)(p + C_V); }
#pragma unroll
    for (int i = 0; i < 8; ++i) { const int cid = F.tid + 512 * i, kidx = cid >> 4, ch = cid & 15; const int row = 128 * (b - 1) + kidx;
        v4u kq = kqa[i], vq = vqa[i];
        if (row < 0) { kq = (v4u){0u, 0u, 0u, 0u}; vq = (v4u){0u, 0u, 0u, 0u}; }
        stage_kv(lds, kidx, ch, kq, vq);
        if (b == SEQ / 128 - 1 && kidx >= 128) {
            store8_f32(A.out + O_KWP + (size_t)(kidx - 128) * 512 + 128 * hk + 8 * ch, kq);
            store8_f32(A.out + O_VWP + (size_t)(kidx - 128) * 512 + 128 * hk + 8 * ch, vq); }
    }
    __syncthreads();
    const int g = F.wave >> 1, half = F.wave & 1, c = F.lane & 31, h = F.lane >> 5, head = 4 * hk + g;
    const float sink = A.in[I_SINK][head];
#pragma unroll 1
    for (int qt = 0; qt < 2; ++qt) { const int r = 64 * half + 32 * qt + c, row = 128 * b + r;
        bf16x8 Q[8];
#pragma unroll
        for (int ks = 0; ks < 8; ++ks) Q[ks] = *(const GAS bf16x8*)(PROJ + (size_t)row * NPROJ + 128 * head + 16 * ks + 8 * h);
        attn_qtile<5>(lds, 2 * half + qt, Q, r, b == 0 ? 128 : 0, 256, g, sink, MIX + (size_t)row * D + 128 * head, F.lane);
    }
    __syncthreads();
}
__device__ __forceinline__ void sample_unit(Frame& F, const Args& A, int s, int hk) {
    const bf16* PROJ = (const bf16*)(A.ws + WS_PROJ); bf16* MIX = (bf16*)(A.ws + WS_MIX);
    LAS unsigned char* lds = F.lds;
    fill_lut(lds, A.in[I_RB], hk, F.tid);
    {
        const int ch = F.tid & 15, kb0 = F.tid >> 4;
        f32x4 ck[4][2], cv[4][2];
#pragma unroll
        for (int i = 0; i < 4; ++i) { const size_t off = (((size_t)s * 128 + kb0 + 32 * i) * 4 + hk) * 128 + 8 * ch;
            ck[i][0] = *(const GAS f32x4*)(A.in[I_CK] + off); ck[i][1] = *(const GAS f32x4*)(A.in[I_CK] + off + 4);
            cv[i][0] = *(const GAS f32x4*)(A.in[I_CV] + off); cv[i][1] = *(const GAS f32x4*)(A.in[I_CV] + off + 4); }
        const int kn = 128 + kb0, knc = kn < 136 ? kn : 135;
        const bf16* pn = PROJ + (size_t)(SEQ + 8 * s + (knc - 128)) * NPROJ + 128 * hk + 8 * ch;
        v4u nkq = *(const GAS v4u*)(pn + C_K), nvq = *(const GAS v4u*)(pn + C_V);
#pragma unroll
        for (int i = 0; i < 4; ++i) { const int kidx = kb0 + 32 * i; const f32x4 k0 = ck[i][0], k1 = ck[i][1], v0 = cv[i][0], v1 = cv[i][1];
            const v4u kq = (v4u){pg8::cvt_pk_bf16(k0[0], k0[1]), pg8::cvt_pk_bf16(k0[2], k0[3]), pg8::cvt_pk_bf16(k1[0], k1[1]), pg8::cvt_pk_bf16(k1[2], k1[3])};
            const v4u vq = (v4u){pg8::cvt_pk_bf16(v0[0], v0[1]), pg8::cvt_pk_bf16(v0[2], v0[3]), pg8::cvt_pk_bf16(v1[0], v1[1]), pg8::cvt_pk_bf16(v1[2], v1[3])};
            if (kidx >= 8) {
                float* ko = A.out + O_KWS + (((size_t)s * 128 + (kidx - 8)) * 4 + hk) * 128 + 8 * ch; *(GAS f32x4*)ko = k0; *(GAS f32x4*)(ko + 4) = k1;
                float* vo = A.out + O_VWS + (((size_t)s * 128 + (kidx - 8)) * 4 + hk) * 128 + 8 * ch; *(GAS f32x4*)vo = v0; *(GAS f32x4*)(vo + 4) = v1; }
            stage_kv(lds, kidx, ch, kq, vq); }
        if (kn < 136) {
            store8_f32(A.out + O_KWS + (((size_t)s * 128 + (kn - 8)) * 4 + hk) * 128 + 8 * ch, nkq);
            store8_f32(A.out + O_VWS + (((size_t)s * 128 + (kn - 8)) * 4 + hk) * 128 + 8 * ch, nvq);
        } else { nkq = (v4u){0u, 0u, 0u, 0u}; nvq = (v4u){0u, 0u, 0u, 0u}; }
        stage_kv(lds, kn, ch, nkq, nvq);
    }
    __syncthreads();
    if (F.wave == 0) {
        const int c = F.lane & 31, h = F.lane >> 5, g = c >> 3, t = c & 7, head = 4 * hk + g, row = SEQ + 8 * s + t;
        const float sink = A.in[I_SINK][head];
        bf16x8 Q[8];
#pragma unroll
        for (int ks = 0; ks < 8; ++ks) Q[ks] = *(const GAS bf16x8*)(PROJ + (size_t)row * NPROJ + 128 * head + 16 * ks + 8 * h);
        attn_qtile<5>(lds, 0, Q, t, 0, 136, g, sink, MIX + (size_t)row * D + 128 * head, F.lane);
    }
    __syncthreads();
}
__device__ __forceinline__ f32x4 ld4bf(const bf16* p) { const v2u q = *(const GAS v2u*)p; return (f32x4){bf_lo(q.x), bf_hi(q.x), bf_lo(q.y), bf_hi(q.y)}; }
__device__ __forceinline__ void conv_item(Frame& F, const Args& A, int item) {
    const bf16* PROJ = (const bf16*)(A.ws + WS_PROJ); bf16* MIX = (bf16*)(A.ws + WS_MIX);
    const int sl = item >> 3, r0 = 8 * sl, c0 = 256 * (item & 7) + 4 * F.lane;
    const f32x4 w0 = *(const GAS f32x4*)(A.in[I_CW] + c0), w1 = *(const GAS f32x4*)(A.in[I_CW] + 2048 + c0), w2 = *(const GAS f32x4*)(A.in[I_CW] + 4096 + c0);
#define load4(row, col) ld4bf(PROJ + (size_t)(row) * NPROJ + (col) + c0)
    f32x4 u[10], gb[8];
    if (r0 >= SEQ) { const int s = (r0 - SEQ) >> 3;
        u[0] = *(const GAS f32x4*)(A.in[I_SC] + ((size_t)s * 2 + 0) * 2048 + c0); u[1] = *(const GAS f32x4*)(A.in[I_SC] + ((size_t)s * 2 + 1) * 2048 + c0); }
    else if (r0 == 0) { u[0] = (f32x4){0.f, 0.f, 0.f, 0.f}; u[1] = u[0]; }
    else { u[0] = load4(r0 - 2, C_GC) * load4(r0 - 2, C_HC); u[1] = load4(r0 - 1, C_GC) * load4(r0 - 1, C_HC); }
#pragma unroll
    for (int i = 0; i < 8; ++i) { u[2 + i] = load4(r0 + i, C_GC) * load4(r0 + i, C_HC); gb[i] = load4(r0 + i, C_GB); }
#pragma unroll
    for (int i = 0; i < 8; ++i) { const int row = r0 + i;
        const f32x4 y = gb[i] * (w0 * u[i] + w1 * u[i + 1] + w2 * u[i + 2]);
        v2u w; w.x = pg8::cvt_pk_bf16(y.x, y.y); w.y = pg8::cvt_pk_bf16(y.z, y.w); *(GAS v2u*)(MIX + (size_t)row * D + 2048 + c0) = w;
        if (i >= 6) {
            if (r0 == SEQ - 8) *(GAS f32x4*)(A.out + O_CP + (size_t)(i - 6) * 2048 + c0) = u[2 + i];
            if (r0 >= SEQ) *(GAS f32x4*)(A.out + O_CS + ((size_t)((r0 - SEQ) >> 3) * 2 + (i - 6)) * 2048 + c0) = u[2 + i]; } }
#undef load4
}
__device__ __forceinline__ void mixer_phase(Frame& F, const Args& A) {
#ifndef PROBE_P7
#define PROBE_P7 0
#endif
    for (int u = F.vcu; u < 256 * (PROBE_P7 == 1 ? 2 : 1); u += F.G) prompt_unit(F, A, (u & 255) >> 2, u & 3);
    for (int u = F.vcu; u < 512 * (PROBE_P7 == 2 ? 2 : 1); u += F.G) sample_unit(F, A, (u & 511) >> 2, u & 3);
    for (int u = F.vcu * NWAVES + F.wave; u < (M / 8) * 8 * (PROBE_P7 == 3 ? 2 : 1); u += F.G * NWAVES) conv_item(F, A, u % ((M / 8) * 8));
}
}

constexpr int N_PHASES = 13;
__global__ void __launch_bounds__(NWAVES * 64, 2) mk_fwd(Args args) {
    extern __shared__ __attribute__((aligned(16))) unsigned char lds[];
    Frame F;
    F.lds = (LAS unsigned char*)lds;
    F.MISC = (volatile LAS unsigned*)(F.lds + MISC_OFF);
    F.tid = threadIdx.x; F.lane = F.tid & 63; F.wave = __builtin_amdgcn_readfirstlane(F.tid >> 6);
    F.G = gridDim.x; { const int bx = blockIdx.x; F.vcu = (F.G % 8 == 0) ? (bx % 8) * (F.G / 8) + bx / 8 : bx; }
    unsigned char* ws = args.ws;
    F.ctl = (gu32*)(ws + WS_CTL);
    for (int u = F.tid; u < (LDS_BYTES - LDSCTL_OFF) / 4; u += NWAVES * 64) ((LAS unsigned*)(F.lds + LDSCTL_OFF))[u] = 0u;
    __syncthreads();
    XcdBarrier bar = xcd_barrier_post((unsigned*)(F.ctl + CW_BAR), F.MISC + 8);
    const int lo = args.ph_lo, hi = args.ph_hi;
#define IN(k) (lo <= (k) && (k) < hi)
#ifndef PROBE_PHASE
#define PROBE_PHASE -1
#endif
#define REPS(k) ((PROBE_PHASE == (k)) ? 2 : 1)
#define SEAM(k) do { if (IN(k) && IN((k) + 1)) xcd_barrier(bar); } while (0)
    bf16* W13A = (bf16*)(ws + WS_W13A); bf16* W2A = (bf16*)(ws + WS_W2A); bf16* WINT = (bf16*)(ws + WS_WIN); bf16* WOUT = (bf16*)(ws + WS_WOUT);
    bf16* W13B = (bf16*)(ws + WS_W13B); bf16* W2B = (bf16*)(ws + WS_W2B); bf16* WADA = (bf16*)(ws + WS_WADA); bf16* CSI = (bf16*)(ws + WS_CSI);
    float* MOD = (float*)(ws + WS_MOD); bf16* X1 = (bf16*)(ws + WS_X1);     bf16* H = (bf16*)(ws + WS_H); bf16* T = (bf16*)(ws + WS_T);
    bf16* PROJ = (bf16*)(ws + WS_PROJ); bf16* MIX = (bf16*)(ws + WS_MIX);
    const int cb = (int)blockIdx.x;

    if (IN(0)) {
#pragma unroll
        for (int rep = 0; rep < REPS(0); ++rep) { if (rep) xcd_barrier(bar);  csilu_phase(F, args); { const int rank = F.vcu * NWAVES + F.wave, nw = F.G * NWAVES; conv_job<JOB_W1A>(F, args, rank, nw); conv_job<JOB_W3A>(F, args, rank, nw); }  } } SEAM(0);
    if (IN(1)) {
#pragma unroll
        for (int rep = 0; rep < REPS(1); ++rep) { if (rep) xcd_barrier(bar); mod_chunk_partials(F, args, 0, F.vcu, F.G); } } SEAM(1);
    if (IN(2)) {
#pragma unroll
        for (int rep = 0; rep < REPS(2); ++rep) { if (rep) xcd_barrier(bar);  normmod_phase<true, false>(F, args.in[I_XP], args.in[I_XS], args.in[I_G1], MOD, 0, 1, H);  } } SEAM(2);
    if (IN(3)) {
#pragma unroll
        for (int rep = 0; rep < REPS(3); ++rep) { if (rep) xcd_barrier(bar);  pg8::Gemm g{H, W13A, M, 2 * FF, D / 2}; pg8::StaticOrder S; S.init(M, 2 * FF, F.G, cb);
        pg8::EpiSwiGLU8 E{(unsigned char*)T, FF, 1.0f / (S_H * S_W13), S_T};
        #if UP_CUT
#pragma unroll 1
        for (int sb = 0; sb < S.nwg; sb += UP_CUT) { if (sb) xcd_barrier(bar); S.sub(sb, (sb + 2 * UP_CUT > S.nwg) ? S.nwg : sb + UP_CUT);
            pg8::gemm_phase<pg8::EpiSwiGLU8, pg8::StaticOrder, PG8_ALIGN, PG8_SP2, true>(F.lds + RING_OFF, g, S, E); if (sb + 2 * UP_CUT > S.nwg) break; }
#else
        pg8::gemm_phase<pg8::EpiSwiGLU8, pg8::StaticOrder, PG8_ALIGN, PG8_SP2, true>(F.lds + RING_OFF, g, S, E);
#endif
#if PROBE_GEMM
        { xcd_barrier(bar); pg8::DegenOrder S2; S2.init(M, 2 * FF, F.G, cb); pg8::EpiNull E2{(float*)(ws + WS_PART)};
          pg8::gemm_phase<pg8::EpiNull, pg8::DegenOrder, PG8_ALIGN, PG8_SP2, true, PROBE_GEMM - 1>(F.lds + RING_OFF, g, S2, E2); xcd_barrier(bar); }
#endif
        if (rep == 0) { const int left = ((M / 256) * (2 * FF / 256)) % F.G;
            if (cb >= left) { const int rank = (cb - left) * NWAVES + F.wave, nw = (F.G - left) * NWAVES; conv_job<JOB_W2A>(F, args, rank, nw); } } } } SEAM(3);
    if (IN(4)) {
#pragma unroll
        for (int rep = 0; rep < REPS(4); ++rep) { if (rep) xcd_barrier(bar);  pg8::Gemm g{T, W2A, M, D, FF / 2}; pg8::StaticOrder S; S.init(M, D, F.G, cb);
        pg8::EpiResid<true, false> E{args.in[I_XP], args.in[I_XS], X1, MOD, D, MODW, 2 * D, SEQ, 0.5f / (S_T * S_W2)};
        pg8::gemm_phase<pg8::EpiResid<true, false>, pg8::StaticOrder, PG8_ALIGN, PG8_SP2, true>(F.lds + RING_OFF, g, S, E);
        if (rep == 0) { const int left = ((M / 256) * (D / 256)) % F.G;
            if (cb >= left) { const int ir = cb - left, ni = F.G - left;
                mod_chunk_partials(F, args, 1, ir, ni); __syncthreads(); {     const int rank = ir * NWAVES + F.wave, nw = ni * NWAVES; conv_job<JOB_WIN>(F, args, rank, nw); } } } } } SEAM(4);
    if (IN(5)) { normmod_phase<false, true>(F, X1, X1 + (size_t)SEQ * D, args.in[I_GM], MOD, 3, 4, H); } SEAM(5);
    if (IN(6)) {
#pragma unroll
        for (int rep = 0; rep < REPS(6); ++rep) { if (rep) xcd_barrier(bar);  pg8::Gemm g{H, WINT, M, NPROJ, D}; pg8::StaticOrder S; S.init(M, NPROJ, F.G, cb);
        pg8::EpiBf16 E{PROJ, NPROJ};
        pg8::gemm_phase<pg8::EpiBf16, pg8::StaticOrder, PG8_ALIGN, PG8_SP2>(F.lds + RING_OFF, g, S, E);
        if (rep == 0) { const int left = ((M / 256) * (NPROJ / 256)) % F.G;
            if (cb >= left) { const int ir = cb - left, ni = F.G - left;
                mod_chunk_partials(F, args, 2, ir, ni); __syncthreads(); { const int rank = ir * NWAVES + F.wave, nw = ni * NWAVES; conv_job<JOB_WOUT>(F, args, rank, nw); conv_job<JOB_W3B>(F, args, rank, nw); } } } } } SEAM(6);
    if (IN(7)) {
#pragma unroll
        for (int rep = 0; rep < REPS(7); ++rep) { if (rep) xcd_barrier(bar);  att::mixer_phase(F, args);  } } SEAM(7);
    if (IN(8)) { pg8::Gemm g{MIX, WOUT, M, D, D}; pg8::StaticOrder S; S.init(M, D, F.G, cb);
        pg8::EpiResid<true, true> E{X1, X1 + (size_t)SEQ * D, X1, MOD, D, MODW, 5 * D, SEQ, 1.0f};
        pg8::gemm_phase<pg8::EpiResid<true, true>, pg8::StaticOrder, PG8_ALIGN, PG8_SP2>(F.lds + RING_OFF, g, S, E);
        { const int left = ((M / 256) * (D / 256)) % F.G;
            if (cb >= left) { const int rank = (cb - left) * NWAVES + F.wave, nw = (F.G - left) * NWAVES; conv_job<JOB_W2B>(F, args, rank, nw); conv_job<JOB_W1B>(F, args, rank, nw); } } } SEAM(8);
    if (IN(9)) { normmod_phase<true, true>(F, X1, X1 + (size_t)SEQ * D, args.in[I_G2], MOD, 6, 7, H); } SEAM(9);
    if (IN(10)) { pg8::Gemm g{H, W13B, M, 2 * FF, D / 2}; pg8::ListOrder S; { pg8::SkOrder K; K.init(M, 2 * FF, D / 2, F.G, cb); S.list = (const LAS int*)(F.lds + SKLIST_OFF); S.n = pg8::sk_build_list(K, (LAS int*)(F.lds + SKLIST_OFF)); }
        S.slots = (float*)(ws + WS_SKS); S.counters = (unsigned*)(F.ctl + CW_SK + 0 * CW_SK_STRIDE);
        pg8::EpiSwiGLU8 E{(unsigned char*)T, FF, 1.0f / (S_H * S_W13), S_T};
        pg8::gemm_phase<pg8::EpiSwiGLU8, pg8::ListOrder, PG8_ALIGN, PG8_SP2, true>(F.lds + RING_OFF, g, S, E); } SEAM(10);
    if (IN(11)) { pg8::Gemm g{T, W2B, M, D, FF / 2}; pg8::ListOrder S; { pg8::SkOrder K; K.init(M, D, FF / 2, F.G, cb); S.list = (const LAS int*)(F.lds + SKLIST_OFF); S.n = pg8::sk_build_list(K, (LAS int*)(F.lds + SKLIST_OFF)); }
        S.slots = (float*)(ws + WS_SKS2); S.counters = (unsigned*)(F.ctl + CW_SK + 1 * CW_SK_STRIDE);
        pg8::EpiResid<false, true> E{X1, X1 + (size_t)SEQ * D, X1, MOD, D, MODW, 8 * D, SEQ, 0.5f / (S_T * S_W2)};
        pg8::gemm_phase<pg8::EpiResid<false, true>, pg8::ListOrder, PG8_ALIGN, PG8_SP2, true>(F.lds + RING_OFF, g, S, E); } SEAM(11);
    if (IN(12)) { final_norm_phase(F, X1, args.in[I_GF], args.out); }
#undef IN
#undef SEAM
}

extern "C" void kernel_launch(void* const* d_in, const int* in_sizes, int n_in, void* d_out, int out_size, void* d_ws, size_t ws_size, hipStream_t stream) {
    static int grid = 0;
    if (grid == 0) {
        if (n_in != N_IN || (size_t)out_size != O_END || ws_size < WS_END) { fprintf(stderr, "kernel_launch: unexpected shapes: n_in %d out %d ws %zu (need %zu)\n", n_in, out_size, ws_size, (size_t)WS_END); grid = -1; return; }
        int dev = 0, cus = 0, per_cu = 0;
        if (hipGetDevice(&dev) != hipSuccess || hipDeviceGetAttribute(&cus, hipDeviceAttributeMultiprocessorCount, dev) != hipSuccess) { grid = -1; return; }
        if (hipFuncSetAttribute((const void*)mk_fwd, hipFuncAttributeMaxDynamicSharedMemorySize, LDS_BYTES) != hipSuccess) { fprintf(stderr, "kernel_launch: hipFuncSetAttribute failed\n"); grid = -1; return; }
        if (hipOccupancyMaxActiveBlocksPerMultiprocessor(&per_cu, (const void*)mk_fwd, NWAVES * 64, LDS_BYTES) != hipSuccess || per_cu < 1) { fprintf(stderr, "kernel_launch: occupancy query says %d\n", per_cu); }
        (void)hipGetLastError();
        grid = cus;
    }
    if (grid < 0) return;
    if (hipMemsetAsync((char*)d_ws + WS_CTL, 0, CTL_ZERO_BYTES, stream) != hipSuccess) return;
    Args a{};
    for (int i = 0; i < N_IN; ++i) a.in[i] = (const float*)d_in[i];
    a.out = (float*)d_out; a.ws = (unsigned char*)d_ws;
#if MK_PER_PHASE
    for (int p = 0; p < N_PHASES; ++p) { a.ph_lo = p; a.ph_hi = p + 1; hipLaunchKernelGGL(mk_fwd, dim3(grid), dim3(NWAVES * 64), LDS_BYTES, stream, a); }
#else
    a.ph_lo = 0; a.ph_hi = N_PHASES;
    hipLaunchKernelGGL(mk_fwd, dim3(grid), dim3(NWAVES * 64), LDS_BYTES, stream, a);
#endif
    const hipError_t le = hipPeekAtLastError();
    if (le != hipSuccess) fprintf(stderr, "kernel_launch: launch failed: %s\n", hipGetErrorName(le));
}
```
